# Optimizing an MI355X kernel written in HIP

```python
import jax
import jax.numpy as jnp
from jax import lax
import numpy as np

D_MODEL = 1024
BATCH = 16
SEQ = 2048
DEPTH = 1

D_MIX = D_MODEL
ATT_HEADS = 8
ATT_KV_HEADS = 2
ATT_HEAD_DIM = D_MIX // 16
ATT_WIDTH = ATT_HEADS * ATT_HEAD_DIM
ATT_KV_WIDTH = ATT_KV_HEADS * ATT_HEAD_DIM
WINDOW = 128
MLSTM_HEADS = 4
MLSTM_WIDTH = D_MIX - ATT_WIDTH
MLSTM_HEAD_DIM = MLSTM_WIDTH // MLSTM_HEADS
MLSTM_CHUNK = 64
QK_CONV_WIDTH = 4
IN_COLS = ATT_WIDTH + 2 * ATT_KV_WIDTH + 4 * MLSTM_WIDTH + 2 * MLSTM_HEADS
X_HEADS = 4
X_HEAD_DIM = D_MODEL // X_HEADS
MEM_LEN = 256
D_FF = 2816
FFN_CONV_WIDTH = 3
RMS_EPS = 1e-6
NEG_BIG = -1e30

kernel_name = 'hybrid_swa_mlstm_convffn_block'


def rmsnorm(x, g):
    xf = x.astype(jnp.float32)
    y = xf * lax.rsqrt(jnp.mean(xf * xf, axis=-1, keepdims=True) + RMS_EPS)
    return (y * g.astype(jnp.float32)).astype(x.dtype)


def causal_depthwise_conv(x, w, b):
    K, C = w.shape
    y = lax.conv_general_dilated(
        x, w.astype(x.dtype)[:, None, :], window_strides=(1,),
        padding=[(K - 1, 0)], dimension_numbers=('NWC', 'WIO', 'NWC'),
        feature_group_count=C)
    return y + b.astype(x.dtype)


def alibi_slopes(n_heads):
    return 2.0 ** (-8.0 * jnp.arange(1, n_heads + 1, dtype=jnp.float32) / n_heads)


def sliding_window_attention(q, k, v, sinks, slopes):
    B, S, _, D = q.shape
    W = WINDOW
    nb = S // W
    G = ATT_HEADS // ATT_KV_HEADS
    qb = q.reshape(B, nb, W, ATT_KV_HEADS, G, D)
    kb = k.reshape(B, nb, W, ATT_KV_HEADS, D)
    vb = v.reshape(B, nb, W, ATT_KV_HEADS, D)
    pad = ((0, 0), (1, 0), (0, 0), (0, 0), (0, 0))
    kk = jnp.concatenate([jnp.pad(kb, pad)[:, :-1], kb], axis=2)
    vv = jnp.concatenate([jnp.pad(vb, pad)[:, :-1], vb], axis=2)
    s = jnp.einsum('bnqhgd,bnkhd->bnhgqk', qb, kk,
                   preferred_element_type=jnp.float32) * (D ** -0.5)
    qi = jnp.arange(W)[:, None]
    kj = jnp.arange(2 * W)[None, :]
    dist = qi + W - kj
    in_band = (dist >= 0) & (dist < W)
    valid = in_band[None] & ((jnp.arange(nb)[:, None, None] > 0) | (kj >= W)[None])
    bias = -slopes.reshape(ATT_KV_HEADS, G)[:, :, None, None] * dist.astype(jnp.float32)
    s = jnp.where(valid[None, :, None, None], s + bias[None, None], NEG_BIG)
    sink = sinks.astype(jnp.float32).reshape(ATT_KV_HEADS, G)[None, None, :, :, None, None]
    m = jnp.maximum(jnp.max(s, axis=-1, keepdims=True), sink)
    p = jnp.exp(s - m)
    p = p / (jnp.sum(p, axis=-1, keepdims=True) + jnp.exp(sink - m))
    o = jnp.einsum('bnhgqk,bnkhd->bnqhgd', p.astype(vv.dtype), vv)
    return o.reshape(B, S, ATT_HEADS * D)


def mlstm_chunkwise(q, k, v, i_pre, f_pre):
    B, S, H, D = q.shape
    L = MLSTM_CHUNK
    nc = S // L
    q = q * (D ** -0.5)

    def to_chunks(a):
        return a.reshape(B, nc, L, H, D).transpose(1, 0, 3, 2, 4)

    def gate_chunks(a):
        return a.reshape(B, nc, L, H).transpose(1, 0, 3, 2)

    causal = jnp.tril(jnp.ones((L, L), dtype=bool))

    def step(carry, inp):
        C, n, m = carry
        qc, kc, vc, igc, lfc = inp
        b = jnp.cumsum(lfc, axis=-1)
        dmat = jnp.where(causal, b[..., :, None] - b[..., None, :] + igc[..., None, :], NEG_BIG)
        inter = b + m[..., None]
        m_t = jnp.maximum(inter, jnp.max(dmat, axis=-1))
        w_inter = jnp.exp(inter - m_t)
        sc = jnp.einsum('bhtd,bhsd->bhts', qc, kc) * jnp.exp(dmat - m_t[..., None])
        num = (w_inter[..., None] * jnp.einsum('bhtd,bhde->bhte', qc, C)
               + jnp.einsum('bhts,bhse->bhte', sc, vc))
        den = w_inter * jnp.einsum('bhtd,bhd->bht', qc, n) + jnp.sum(sc, axis=-1)
        h = num / jnp.maximum(jnp.abs(den), jnp.exp(-m_t))[..., None]
        b_end = b[..., -1]
        g = b_end[..., None] - b + igc
        m_new = jnp.maximum(b_end + m, jnp.max(g, axis=-1))
        decay = jnp.exp(b_end + m - m_new)
        ws = jnp.exp(g - m_new[..., None])
        C_new = decay[..., None, None] * C + jnp.einsum('bhs,bhsd,bhse->bhde', ws, kc, vc)
        n_new = decay[..., None] * n + jnp.einsum('bhs,bhsd->bhd', ws, kc)
        return (C_new, n_new, m_new), h

    init = (jnp.zeros((B, H, D, D), jnp.float32),
            jnp.zeros((B, H, D), jnp.float32),
            jnp.zeros((B, H), jnp.float32))
    xs = (to_chunks(q), to_chunks(k), to_chunks(v),
          gate_chunks(i_pre), gate_chunks(jax.nn.log_sigmoid(f_pre)))
    _, h = lax.scan(step, init, xs)
    return h.transpose(1, 0, 3, 2, 4).reshape(B, S, H * D)


def cross_attention(hq, hm, wq, wkv, wo):
    B, S, _ = hq.shape
    M = hm.shape[1]
    q = (hq @ wq).reshape(B, S, X_HEADS, X_HEAD_DIM)
    kv = hm @ wkv
    k = kv[..., :D_MODEL].reshape(B, M, X_HEADS, X_HEAD_DIM)
    v = kv[..., D_MODEL:].reshape(B, M, X_HEADS, X_HEAD_DIM)
    s = jnp.einsum('bshd,bmhd->bhsm', q, k,
                   preferred_element_type=jnp.float32) * (X_HEAD_DIM ** -0.5)
    a = jax.nn.softmax(s, axis=-1).astype(v.dtype)
    o = jnp.einsum('bhsm,bmhd->bshd', a, v).reshape(B, S, X_HEADS * X_HEAD_DIM)
    return o @ wo


def setup_inputs(seed: int = 0) -> dict:
    key = jax.random.key(seed)
    ks = jax.random.split(key, 22)
    f32 = jnp.float32

    def nrm(k, shape, scale):
        return jax.random.normal(k, shape, f32) * scale

    def gain(k, shape):
        return 1.0 + 0.02 * jax.random.normal(k, shape, f32)

    L = DEPTH
    f_bias = jnp.linspace(3.0, 6.0, MLSTM_HEADS, dtype=f32)
    return {
        'x': nrm(ks[0], (BATCH, SEQ, D_MODEL), 1.0),
        'mem': nrm(ks[1], (BATCH, MEM_LEN, D_MODEL), 1.0),
        'norm_mix_g': gain(ks[2], (L, D_MODEL)),
        'w_in': nrm(ks[3], (L, D_MODEL, IN_COLS), D_MODEL ** -0.5),
        'b_gate_if': jnp.concatenate(
            [nrm(ks[4], (L, MLSTM_HEADS), 0.1),
             f_bias[None] + nrm(ks[5], (L, MLSTM_HEADS), 0.1)], axis=-1),
        'conv_qk_w': nrm(ks[6], (L, QK_CONV_WIDTH, 2 * MLSTM_WIDTH), QK_CONV_WIDTH ** -0.5),
        'conv_qk_b': nrm(ks[7], (L, 2 * MLSTM_WIDTH), 0.02),
        'attn_sinks': nrm(ks[8], (L, ATT_HEADS), 0.5),
        'w_out': nrm(ks[9], (L, D_MIX, D_MODEL), D_MIX ** -0.5),
        'norm_xattn_g': gain(ks[10], (L, D_MODEL)),
        'norm_mem_g': gain(ks[11], (L, D_MODEL)),
        'wq_x': nrm(ks[12], (L, D_MODEL, X_HEADS * X_HEAD_DIM), D_MODEL ** -0.5),
        'wkv_x': nrm(ks[13], (L, D_MODEL, 2 * X_HEADS * X_HEAD_DIM), D_MODEL ** -0.5),
        'wo_x': nrm(ks[14], (L, X_HEADS * X_HEAD_DIM, D_MODEL), D_MODEL ** -0.5),
        'norm_ffn_g': gain(ks[15], (L, D_MODEL)),
        'w_up': nrm(ks[16], (L, D_MODEL, 2 * D_FF), D_MODEL ** -0.5),
        'conv_ffn_w': nrm(ks[17], (L, FFN_CONV_WIDTH, D_FF), FFN_CONV_WIDTH ** -0.5),
        'conv_ffn_b': nrm(ks[18], (L, D_FF), 0.02),
        'w_down': nrm(ks[19], (L, D_FF, D_MODEL), D_FF ** -0.5),
        'norm_final_g': gain(ks[20], (D_MODEL,)),
    }


def reference(x, mem, norm_mix_g, w_in, b_gate_if, conv_qk_w, conv_qk_b, attn_sinks,
              w_out, norm_xattn_g, norm_mem_g, wq_x, wkv_x, wo_x, norm_ffn_g, w_up,
              conv_ffn_w, conv_ffn_b, w_down, norm_final_g):
    B, S, _ = x.shape
    H = MLSTM_HEADS
    slopes = alibi_slopes(ATT_HEADS)
    o0 = ATT_WIDTH
    o1 = o0 + ATT_KV_WIDTH
    o2 = o1 + ATT_KV_WIDTH
    o3 = o2 + 2 * MLSTM_WIDTH
    o4 = o3 + MLSTM_WIDTH
    o5 = o4 + MLSTM_WIDTH
    for l in range(DEPTH):
        h = rmsnorm(x, norm_mix_g[l])
        p = h @ w_in[l]
        aq = p[..., :o0].reshape(B, S, ATT_HEADS, ATT_HEAD_DIM)
        ak = p[..., o0:o1].reshape(B, S, ATT_KV_HEADS, ATT_HEAD_DIM)
        av = p[..., o1:o2].reshape(B, S, ATT_KV_HEADS, ATT_HEAD_DIM)
        attn_out = sliding_window_attention(aq, ak, av, attn_sinks[l], slopes)

        mqk = jax.nn.silu(causal_depthwise_conv(p[..., o2:o3], conv_qk_w[l], conv_qk_b[l]))
        mq = mqk[..., :MLSTM_WIDTH].reshape(B, S, H, MLSTM_HEAD_DIM).astype(jnp.float32)
        mk = mqk[..., MLSTM_WIDTH:].reshape(B, S, H, MLSTM_HEAD_DIM).astype(jnp.float32)
        mv = p[..., o3:o4].reshape(B, S, H, MLSTM_HEAD_DIM).astype(jnp.float32)
        mo = p[..., o4:o5].astype(jnp.float32)
        gif = p[..., o5:].astype(jnp.float32) + b_gate_if[l].astype(jnp.float32)
        m_h = mlstm_chunkwise(mq, mk, mv, gif[..., :H], gif[..., H:])
        mlstm_out = (jax.nn.sigmoid(mo) * m_h).astype(x.dtype)

        x = x + jnp.concatenate([attn_out, mlstm_out], axis=-1) @ w_out[l]

        x = x + cross_attention(rmsnorm(x, norm_xattn_g[l]), rmsnorm(mem, norm_mem_g[l]),
                                wq_x[l], wkv_x[l], wo_x[l])

        hf = rmsnorm(x, norm_ffn_g[l])
        u = hf @ w_up[l]
        g = causal_depthwise_conv(u[..., :D_FF], conv_ffn_w[l], conv_ffn_b[l])
        x = x + (jax.nn.silu(g) * u[..., D_FF:]) @ w_down[l]
    return rmsnorm(x, norm_final_g)
```

```cpp
#include <hip/hip_runtime.h>
#include <cstdio>
#include <cstdint>

namespace nv {
constexpr int B = 16, S = 2048, D = 1024, M = B * S;
constexpr int IN_COLS = 2824;
constexpr int O0 = 512, O1 = 640, O2 = 768, O3 = 1792, O4 = 2304, O5 = 2816;
constexpr int MEM = 256, MM = B * MEM;
constexpr int FF = 2816;
constexpr float EPS = 1e-6f;

__global__ void rmsnorm_k(const float* x, const float* __restrict__ g, float* out) {
    const int row = blockIdx.x, t = threadIdx.x;
    const float4 v = ((const float4*)(x + (size_t)row * D))[t];
    float s = v.x * v.x + v.y * v.y + v.z * v.z + v.w * v.w;
    __shared__ float red[4];
    for (int o = 32; o > 0; o >>= 1) s += __shfl_xor(s, o);
    if ((t & 63) == 0) red[t >> 6] = s;
    __syncthreads();
    const float tot = red[0] + red[1] + red[2] + red[3];
    const float r = 1.0f / sqrtf(tot * (1.0f / D) + EPS);
    const float4 gg = ((const float4*)g)[t];
    float4 o; o.x = v.x * r * gg.x; o.y = v.y * r * gg.y; o.z = v.z * r * gg.z; o.w = v.w * r * gg.w;
    ((float4*)(out + (size_t)row * D))[t] = o;
}

template <bool RES>
__global__ void gemm_k(const float* __restrict__ A, int lda, const float* __restrict__ W, int ldw, const float* R, float* C, int ldc, int N, int K) {
    __shared__ float As[16][65];
    __shared__ float Ws[16][65];
    const int tx = threadIdx.x & 15, ty = threadIdx.x >> 4;
    const int m0 = blockIdx.y * 64, n0 = blockIdx.x * 64;
    float acc[4][4] = {};
    for (int k0 = 0; k0 < K; k0 += 16) {
        for (int i = threadIdx.x; i < 64 * 16; i += 256) {
            const int r = i >> 4, c = i & 15;
            As[c][r] = A[(size_t)(m0 + r) * lda + k0 + c];
        }
        for (int i = threadIdx.x; i < 16 * 64; i += 256) {
            const int r = i >> 6, c = i & 63;
            Ws[r][c] = (n0 + c < N) ? W[(size_t)(k0 + r) * ldw + n0 + c] : 0.f;
        }
        __syncthreads();
#pragma unroll
        for (int k = 0; k < 16; ++k) {
            float a[4], b[4];
#pragma unroll
            for (int i = 0; i < 4; ++i) { a[i] = As[k][ty * 4 + i]; b[i] = Ws[k][tx * 4 + i]; }
#pragma unroll
            for (int i = 0; i < 4; ++i)
#pragma unroll
                for (int j = 0; j < 4; ++j) acc[i][j] += a[i] * b[j];
        }
        __syncthreads();
    }
#pragma unroll
    for (int i = 0; i < 4; ++i)
#pragma unroll
        for (int j = 0; j < 4; ++j) {
            const int m = m0 + ty * 4 + i, n = n0 + tx * 4 + j;
            if (n < N) { const size_t o = (size_t)m * ldc + n; C[o] = (RES ? R[o] : 0.f) + acc[i][j]; }
        }
}

__global__ void __launch_bounds__(256) swa_k(const float* __restrict__ p, const float* __restrict__ sinks, float* mix) {
    const int idx = blockIdx.x * blockDim.x + threadIdx.x;
    if (idx >= M * 8) return;
    const int h = idx & 7, row = idx >> 3, b = row / S, t = row % S, hk = h >> 2;
    const float slope = exp2f(-8.0f * (float)(h + 1) / 8.0f);
    const float* q = p + (size_t)row * IN_COLS + h * 64;
    float qr[64];
#pragma unroll
    for (int d = 0; d < 64; ++d) qr[d] = q[d];
    const float sink = sinks[h];
    float m = sink, l = 1.0f;
    float o[64];
#pragma unroll
    for (int d = 0; d < 64; ++d) o[d] = 0.f;
    const int s_lo = (t - 127 > 0) ? t - 127 : 0;
    for (int s = s_lo; s <= t; ++s) {
        const float* kp = p + (size_t)(b * S + s) * IN_COLS + O0 + hk * 64;
        const float* vp = p + (size_t)(b * S + s) * IN_COLS + O1 + hk * 64;
        float sc = 0.f;
#pragma unroll
        for (int d = 0; d < 64; ++d) sc += qr[d] * kp[d];
        sc = sc * 0.125f - slope * (float)(t - s);
        const float mn = fmaxf(m, sc);
        const float f = expf(m - mn), e = expf(sc - mn);
        l = l * f + e;
#pragma unroll
        for (int d = 0; d < 64; ++d) o[d] = o[d] * f + e * vp[d];
        m = mn;
    }
    const float inv = 1.0f / l;
    float* op = mix + (size_t)row * D + h * 64;
#pragma unroll
    for (int d = 0; d < 64; ++d) op[d] = o[d] * inv;
}

__global__ void __launch_bounds__(128) mlstm_k(const float* __restrict__ p, const float* __restrict__ bg, const float* __restrict__ cw, const float* __restrict__ cb, float* mix) {
    const int b = blockIdx.x >> 2, h = blockIdx.x & 3, j = threadIdx.x;
    __shared__ float qs[128], ks[128], red[2];
    __shared__ float ns[128];
    float C[128];
#pragma unroll
    for (int d = 0; d < 128; ++d) C[d] = 0.f;
    ns[j] = 0.f;
    float mprev = 0.f;
    const int cq = h * 128 + j, ck = 512 + h * 128 + j;
    float wq[4], wk[4];
    for (int i = 0; i < 4; ++i) { wq[i] = cw[i * 1024 + cq]; wk[i] = cw[i * 1024 + ck]; }
    const float bq = cb[cq], bk = cb[ck];
    const float bi = bg[h], bf = bg[4 + h];
    __syncthreads();
    for (int t = 0; t < S; ++t) {
        const size_t row = (size_t)b * S + t;
        float aq = bq, ak = bk;
        for (int i = 0; i < 4; ++i) { const int tt = t - 3 + i; if (tt >= 0) { const float* pr = p + ((size_t)b * S + tt) * IN_COLS + O2; aq += wq[i] * pr[cq]; ak += wk[i] * pr[ck]; } }
        const float qv = aq / (1.0f + expf(-aq)) * 0.08838834764831845f;
        const float kv = ak / (1.0f + expf(-ak));
        const float* pr = p + row * IN_COLS;
        const float vv = pr[O3 + h * 128 + j], ov = pr[O4 + h * 128 + j];
        const float ipre = pr[O5 + h] + bi, fpre = pr[O5 + 4 + h] + bf;
        const float lf = fminf(fpre, 0.f) - log1pf(expf(-fabsf(fpre)));
        const float mt = fmaxf(lf + mprev, ipre);
        const float fg = expf(lf + mprev - mt), ig = expf(ipre - mt);
        __syncthreads();
        qs[j] = qv; ks[j] = kv;
        ns[j] = fg * ns[j] + ig * kv;
        __syncthreads();
        float num = 0.f, den = 0.f;
#pragma unroll
        for (int d = 0; d < 128; ++d) { C[d] = fg * C[d] + ig * ks[d] * vv; num += qs[d] * C[d]; den += qs[d] * ns[d]; }
        const float hh = num / fmaxf(fabsf(den), expf(-mt));
        mix[row * D + 512 + h * 128 + j] = hh / (1.0f + expf(-ov));
        mprev = mt;
    }
}

__global__ void xattn_k(const float* __restrict__ qx, const float* __restrict__ kv, float* xo) {
    const int row = blockIdx.x, b = row / S, t = threadIdx.x;
    __shared__ float q[1024];
    __shared__ float a[256];
    __shared__ float red[8];
    for (int i = t; i < 1024; i += 256) q[i] = qx[(size_t)row * 1024 + i];
    __syncthreads();
    for (int h = 0; h < 4; ++h) {
        const float* kp = kv + (size_t)(b * MEM + t) * 2048 + h * 256;
        float s = 0.f;
        for (int d = 0; d < 256; ++d) s += q[h * 256 + d] * kp[d];
        s *= 0.0625f;
        float mx = s;
        for (int o = 32; o > 0; o >>= 1) mx = fmaxf(mx, __shfl_xor(mx, o));
        if ((t & 63) == 0) red[t >> 6] = mx;
        __syncthreads();
        mx = fmaxf(fmaxf(red[0], red[1]), fmaxf(red[2], red[3]));
        const float e = expf(s - mx);
        float sm = e;
        for (int o = 32; o > 0; o >>= 1) sm += __shfl_xor(sm, o);
        if ((t & 63) == 0) red[4 + (t >> 6)] = sm;
        a[t] = e;
        __syncthreads();
        sm = red[4] + red[5] + red[6] + red[7];
        float o = 0.f;
        for (int m2 = 0; m2 < 256; ++m2) o += a[m2] * kv[(size_t)(b * MEM + m2) * 2048 + 1024 + h * 256 + t];
        xo[(size_t)row * 1024 + h * 256 + t] = o / sm;
        __syncthreads();
    }
}

__global__ void ffn_act_k(const float* __restrict__ ug, float* uv, const float* __restrict__ cw, const float* __restrict__ cb, int c0, int NC) {
    const size_t idx = (size_t)blockIdx.x * blockDim.x + threadIdx.x;
    if (idx >= (size_t)M * NC) return;
    const int c = (int)(idx % NC); const size_t row = idx / NC; const int t = (int)(row % S);
    float g = cb[c0 + c] + cw[2 * FF + c0 + c] * ug[row * NC + c];
    if (t >= 1) g += cw[1 * FF + c0 + c] * ug[(row - 1) * NC + c];
    if (t >= 2) g += cw[0 * FF + c0 + c] * ug[(row - 2) * NC + c];
    uv[idx] = g / (1.0f + expf(-g)) * uv[idx];
}
}

extern "C" void kernel_launch(void* const* d_in, const int* in_sizes, int n_in, void* d_out, int out_size, void* d_ws, size_t ws_size, hipStream_t stream) {
    using namespace nv;
    const float* x = (const float*)d_in[0]; const float* mem = (const float*)d_in[1]; const float* g_mix = (const float*)d_in[2]; const float* w_in = (const float*)d_in[3];
    const float* b_gate = (const float*)d_in[4]; const float* cqk_w = (const float*)d_in[5]; const float* cqk_b = (const float*)d_in[6]; const float* sinks = (const float*)d_in[7];
    const float* w_out = (const float*)d_in[8]; const float* g_x = (const float*)d_in[9]; const float* g_mem = (const float*)d_in[10]; const float* wq = (const float*)d_in[11];
    const float* wkv = (const float*)d_in[12]; const float* wo = (const float*)d_in[13]; const float* g_ffn = (const float*)d_in[14]; const float* w_up = (const float*)d_in[15];
    const float* cf_w = (const float*)d_in[16]; const float* cf_b = (const float*)d_in[17]; const float* w_down = (const float*)d_in[18]; const float* g_fin = (const float*)d_in[19];
    float* out = (float*)d_out;
    char* ws = (char*)d_ws;
    const size_t MiB = 1u << 20;
    float* bufA = (float*)(ws);
    float* P = (float*)(ws + 128 * MiB);
    float* hq = (float*)(ws + 128 * MiB); float* qx = (float*)(ws + 256 * MiB); float* hm = (float*)(ws + 384 * MiB); float* kvb = (float*)(ws + 400 * MiB);
    float* ug = (float*)(ws + 128 * MiB); float* uv = (float*)(ws + 304 * MiB);

    rmsnorm_k<<<M, 256, 0, stream>>>(x, g_mix, bufA);
    gemm_k<false><<<dim3((IN_COLS + 63) / 64, M / 64), 256, 0, stream>>>(bufA, D, w_in, IN_COLS, nullptr, P, IN_COLS, IN_COLS, D);
    swa_k<<<M * 8 / 256, 256, 0, stream>>>(P, sinks, bufA);
    mlstm_k<<<B * 4, 128, 0, stream>>>(P, b_gate, cqk_w, cqk_b, bufA);
    gemm_k<true><<<dim3(D / 64, M / 64), 256, 0, stream>>>(bufA, D, w_out, D, x, out, D, D, D);
    rmsnorm_k<<<M, 256, 0, stream>>>(out, g_x, hq);
    rmsnorm_k<<<MM, 256, 0, stream>>>(mem, g_mem, hm);
    gemm_k<false><<<dim3(D / 64, M / 64), 256, 0, stream>>>(hq, D, wq, D, nullptr, qx, D, D, D);
    gemm_k<false><<<dim3(2048 / 64, MM / 64), 256, 0, stream>>>(hm, D, wkv, 2048, nullptr, kvb, 2048, 2048, D);
    xattn_k<<<M, 256, 0, stream>>>(qx, kvb, bufA);
    gemm_k<true><<<dim3(D / 64, M / 64), 256, 0, stream>>>(bufA, D, wo, D, out, out, D, D, D);
    rmsnorm_k<<<M, 256, 0, stream>>>(out, g_ffn, bufA);
    for (int ch = 0; ch < 2; ++ch) {
        const int c0 = ch * 1408, NC = 1408;
        gemm_k<false><<<dim3(NC / 64, M / 64), 256, 0, stream>>>(bufA, D, w_up + c0, 2 * FF, nullptr, ug, NC, NC, D);
        gemm_k<false><<<dim3(NC / 64, M / 64), 256, 0, stream>>>(bufA, D, w_up + FF + c0, 2 * FF, nullptr, uv, NC, NC, D);
        ffn_act_k<<<(unsigned)(((size_t)M * NC + 255) / 256), 256, 0, stream>>>(ug, uv, cf_w, cf_b, c0, NC);
        gemm_k<true><<<dim3(D / 64, M / 64), 256, 0, stream>>>(uv, NC, w_down + (size_t)c0 * D, D, out, out, D, D, NC);
    }
    rmsnorm_k<<<M, 256, 0, stream>>>(out, g_fin, out);
}
```

```cpp
#include <hip/hip_runtime.h>
#include <cstdio>
#include <cstdint>
namespace pg8 {
#define PG8_LAS __attribute__((address_space(3)))
typedef unsigned short bf16_t;
typedef short bf16x8 __attribute__((ext_vector_type(8)));
typedef float f32x4 __attribute__((ext_vector_type(4)));
typedef unsigned u32x4 __attribute__((ext_vector_type(4)));
constexpr int BM = 256, BK = 64, HALF = 128, HTB = HALF * BK * 2  , STAGE_BYTES = 8 * HTB, NXCD = 8, WGM = 8;

__host__ __device__ __forceinline__ int lds_byte(int r, int c) { const int st = (r >> 4) * 2 + (c >> 5), rr = r & 15, cc = c & 31, ob = rr * 64 + cc * 2; return st * 1024 + (ob ^ (((ob >> 9) & 1) << 5)); }
__host__ __device__ __forceinline__ void stage_rc(int b, int& R, int& C) { const int st = b / 1024, sb = b % 1024, swz = sb ^ (((sb >> 9) & 1) << 5); R = (st >> 1) * 16 + swz / 64; C = (st & 1) * 32 + (swz % 64) / 2; }
__host__ __device__ __forceinline__ int perm32(int rho) { const int n = rho >> 4, i = rho & 15; return 8 * (i >> 2) + 4 * n + (i & 3); }

struct Unit { int pm, pn; };
struct Gemm { const bf16_t* A; int lda; const bf16_t* Bt; int M, N, K; };

struct StaticOrder {
    int nM, nN, nwg, G, c;
    __host__ __device__ void init(int M, int N, int G_, int c_) { nM = M / BM; nN = N / BM; nwg = nM * nN; G = G_; c = c_; }
    __host__ __device__ bool next(int i, Unit& u) const {
        const long L = (long)i * G + c; if (L >= nwg) return false;
        int wgid = (int)L; { const int q = nwg / NXCD, r = nwg % NXCD, xcd = wgid % NXCD, off = wgid / NXCD; wgid = (xcd < r ? xcd * (q + 1) : r * (q + 1) + (xcd - r) * q) + off; }
        const int nig = WGM * nN, gid = wgid / nig, fm = gid * WGM, gsz = (nM - fm) < WGM ? (nM - fm) : WGM;
        u.pm = fm + ((wgid % nig) % gsz); u.pn = (wgid % nig) / gsz; return true;
    }
    __device__ __forceinline__ void a_ready(const Unit&) const {}
    __device__ __forceinline__ void done(const Unit&) const {}
};

__device__ __forceinline__ unsigned cvt_pk_bf16(float lo, float hi) { unsigned r; asm volatile("v_cvt_pk_bf16_f32 %0, %1, %2" : "=v"(r) : "v"(lo), "v"(hi)); return r; }
typedef float f32x2 __attribute__((ext_vector_type(2)));
constexpr float RMS_EPS = 1e-6f;
struct RsOne   { __device__ __forceinline__ float get(int) const { return 1.0f; } };
struct RsArr   { const float* r; __device__ __forceinline__ float get(int row) const { return r[row]; } };
struct RsParts { const float* p;
    __device__ __forceinline__ float get(int row) const { const f32x4* q = (const f32x4*)(p + (size_t)row * 16); const f32x4 a = q[0], b = q[1], c = q[2], d = q[3];
        const float s = ((a[0] + a[1]) + (a[2] + a[3])) + ((b[0] + b[1]) + (b[2] + b[3])) + ((c[0] + c[1]) + (c[2] + c[3])) + ((d[0] + d[1]) + (d[2] + d[3]));
        return 1.0f / sqrtf(s * (1.0f / 1024.0f) + RMS_EPS); } };
template <class RS> struct EpiScaleBf16 {
    static constexpr bool PERM = true, AFTER_DRAIN = false;
    bf16_t* O; int ldc; RS rs;
    __device__ __forceinline__ void operator()(const f32x4 (&acc)[2][2][4][2], const Unit& u, int wr, int wc, int fr, int fq) const {
        const int row0 = u.pm * BM + wr * 64 + fr, col0 = u.pn * BM + wc * 32 + 8 * fq;
#pragma unroll
        for (int ai = 0; ai < 2; ++ai)
#pragma unroll
            for (int m = 0; m < 4; ++m) { const int row = row0 + ai * HALF + m * 16; const float sc = rs.get(row); bf16_t* rowp = O + (size_t)row * ldc + col0;
#pragma unroll
                for (int bj = 0; bj < 2; ++bj) { const f32x4 v0 = acc[ai][bj][m][0] * sc, v1 = acc[ai][bj][m][1] * sc;
                    u32x4 w; w.x = cvt_pk_bf16(v0[0], v0[1]); w.y = cvt_pk_bf16(v0[2], v0[3]); w.z = cvt_pk_bf16(v1[0], v1[1]); w.w = cvt_pk_bf16(v1[2], v1[3]);
                    *(u32x4*)(rowp + bj * HALF) = w; } }
    }
};
template <bool WRITE_BF16> struct EpiResid {
    static constexpr bool PERM = false, AFTER_DRAIN = false;
    const float* base; float* out; bf16_t* xb; float* ssq; int ldc;
    __device__ __forceinline__ void operator()(const f32x4 (&acc)[2][2][4][2], const Unit& u, int wr, int wc, int fr, int fq) const {
        typedef unsigned u32x2v __attribute__((ext_vector_type(2)));
        const int row0 = u.pm * BM + wr * 64 + fr, col0 = u.pn * BM + wc * 32 + 4 * fq;
#pragma unroll
        for (int ai = 0; ai < 2; ++ai)
#pragma unroll
            for (int m = 0; m < 4; ++m) { const int row = row0 + ai * HALF + m * 16; const size_t off = (size_t)row * ldc + col0; float ss = 0.f;
#pragma unroll
                for (int bj = 0; bj < 2; ++bj)
#pragma unroll
                    for (int n = 0; n < 2; ++n) { const size_t o2 = off + bj * HALF + n * 16; const f32x4 o = *(const f32x4*)(base + o2) + acc[ai][bj][m][n];
                        *(f32x4*)(out + o2) = o; ss += (o[0] * o[0] + o[1] * o[1]) + (o[2] * o[2] + o[3] * o[3]);
                        if (WRITE_BF16) { u32x2v w; w.x = cvt_pk_bf16(o[0], o[1]); w.y = cvt_pk_bf16(o[2], o[3]); *(u32x2v*)(xb + o2) = w; } }
                ss += __shfl_xor(ss, 16); ss += __shfl_xor(ss, 32);
                if (fq == 0) ssq[(size_t)row * 16 + u.pn * 4 + wc] = ss;
                asm volatile("" ::: "memory"); }
    }
};
template <class Epi, class Sched, bool ALIGN_EPI = false, bool SP2 = false>
__device__ __forceinline__ void gemm_phase(PG8_LAS unsigned char* lds, const Gemm g, const Sched& S, const Epi& E) {
    const int tid = threadIdx.x, wid = __builtin_amdgcn_readfirstlane(tid >> 6), lane = tid & 63, wr = wid >> 2, wc = wid & 3, fr = lane & 15, fq = lane >> 4;
    const int K = g.K, nt = K / BK;
    unsigned voffA[2], voffB[2];
#pragma unroll
    for (int i = 0; i < 2; ++i) { int R, C; stage_rc(tid * 16 + i * 8192, R, C); const int Rb = Epi::PERM ? ((R & ~31) + perm32(R & 31)) : R;
        voffA[i] = (unsigned)(R * g.lda + C) * 2u; voffB[i] = (unsigned)(Rb * K + C) * 2u; }
    const size_t kstep = (size_t)(BK * 2);
    const size_t hstepA = (size_t)HALF * g.lda * 2, hstepB = (size_t)HALF * K * 2;
    const size_t tstepA = 2 * hstepA, tstepB = 2 * hstepB;
    const unsigned ldsw = (unsigned)wid * 1024u;
    const int aoff = lds_byte(wr * 64 + fr, fq * 8), boff = lds_byte(wc * 32 + fr, fq * 8);
#define PG8_SA(b, h) (((b) * 2 + (h)) * HTB)
#define PG8_SB(b, h) ((4 + (b) * 2 + (h)) * HTB)
#define PG8_STAGE(bufoff, gbase, voff) do { _Pragma("unroll") for (int _i = 0; _i < 2; ++_i) \
        __builtin_amdgcn_global_load_lds((const unsigned*)((const char*)(gbase) + (voff)[_i]), (PG8_LAS unsigned*)(lds + (bufoff) + ldsw + _i * 8192), 16, 0, 0); } while (0)
#define PG8_LDA(dst, b, h) do { _Pragma("unroll") for (int m = 0; m < 4; ++m) _Pragma("unroll") for (int k = 0; k < 2; ++k) dst[m][k] = *(const PG8_LAS bf16x8*)(lds + PG8_SA(b, h) + aoff + m * 2048 + k * 1024); } while (0)
#define PG8_LDB(dst, b, h) do { _Pragma("unroll") for (int n = 0; n < 2; ++n) _Pragma("unroll") for (int k = 0; k < 2; ++k) dst[n][k] = *(const PG8_LAS bf16x8*)(lds + PG8_SB(b, h) + boff + n * 2048 + k * 1024); } while (0)
#define PG8_MMA(ai, bj, At, Bt) do { __builtin_amdgcn_s_setprio(1); _Pragma("unroll") for (int m = 0; m < 4; ++m) _Pragma("unroll") for (int n = 0; n < 2; ++n) _Pragma("unroll") for (int k = 0; k < 2; ++k) \
        acc[ai][bj][m][n] = __builtin_amdgcn_mfma_f32_16x16x32_bf16(Bt[n][k], At[m][k], acc[ai][bj][m][n], 0, 0, 0); __builtin_amdgcn_s_setprio(0); } while (0)
#define PG8_WAIT_V(n) asm volatile("s_waitcnt vmcnt(" #n ")" ::: "memory")
#define PG8_WAIT_L(n) asm volatile("s_waitcnt lgkmcnt(" #n ")" ::: "memory")
#define PG8_BAR __builtin_amdgcn_s_barrier()
#define PG8_SCHED __builtin_amdgcn_sched_barrier(0)
    Unit cur, nxt; int ui = 0;
    if (!S.next(0, cur)) return;
    f32x4 acc[2][2][4][2];
#pragma unroll
    for (int a = 0; a < 2; ++a)
#pragma unroll
        for (int b = 0; b < 2; ++b)
#pragma unroll
            for (int m = 0; m < 4; ++m)
#pragma unroll
                for (int n = 0; n < 2; ++n) acc[a][b][m][n] = (f32x4){0.f, 0.f, 0.f, 0.f};
    bf16x8 At[4][2], B0[2][2], B1[2][2];
    const char* cA = (const char*)g.A + (size_t)cur.pm * tstepA; const char* cB = (const char*)g.Bt + (size_t)cur.pn * tstepB;
    S.a_ready(cur);
    if constexpr (SP2) {
        PG8_STAGE(PG8_SB(0, 0), cB, voffB); PG8_STAGE(PG8_SB(0, 1), cB + hstepB, voffB); PG8_STAGE(PG8_SA(0, 0), cA, voffA); PG8_STAGE(PG8_SA(0, 1), cA + hstepA, voffA);
        if (wr == 1) PG8_BAR;
        PG8_WAIT_V(2); PG8_BAR;
        PG8_STAGE(PG8_SB(1, 0), cB + kstep, voffB); PG8_STAGE(PG8_SA(1, 0), cA + kstep, voffA); PG8_STAGE(PG8_SB(1, 1), cB + hstepB + kstep, voffB);
        PG8_WAIT_V(6); PG8_BAR;
    } else {
        PG8_STAGE(PG8_SB(0, 0), cB, voffB); PG8_STAGE(PG8_SA(0, 0), cA, voffA); PG8_STAGE(PG8_SB(0, 1), cB + hstepB, voffB); PG8_STAGE(PG8_SA(0, 1), cA + hstepA, voffA);
        if (wr == 1) PG8_BAR;
        PG8_WAIT_V(4); PG8_BAR;
        PG8_STAGE(PG8_SB(1, 0), cB + kstep, voffB); PG8_STAGE(PG8_SA(1, 0), cA + kstep, voffA); PG8_STAGE(PG8_SB(1, 1), cB + hstepB + kstep, voffB);
        PG8_WAIT_V(6); PG8_BAR;
    }
    for (;;) {
        const bool has_next = S.next(ui + 1, nxt);
        const char* nA = has_next ? (const char*)g.A + (size_t)nxt.pm * tstepA : cA; const char* nB = has_next ? (const char*)g.Bt + (size_t)nxt.pn * tstepB : cB;
        for (int t = 0; t < nt; t += 2) {
            const bool last = (t == nt - 2);
            const char* a1 = cA + (size_t)(t + 1) * kstep;
            const char* a2 = last ? nA : cA + (size_t)(t + 2) * kstep; const char* b2 = last ? nB : cB + (size_t)(t + 2) * kstep;
            const char* a3 = a2 + kstep; const char* b3 = b2 + kstep;
            if (last && has_next) S.a_ready(nxt);
            if constexpr (SP2) {
            PG8_LDB(B0, 0, 0); PG8_LDB(B1, 0, 1); PG8_SCHED; PG8_LDA(At, 0, 0); PG8_STAGE(PG8_SA(1, 1), a1 + hstepA, voffA);
            PG8_WAIT_V(8); PG8_WAIT_L(0); PG8_BAR; PG8_MMA(0, 0, At, B0); PG8_MMA(0, 1, At, B1); PG8_BAR; PG8_SCHED;
            PG8_LDA(At, 0, 1); PG8_STAGE(PG8_SB(0, 0), b2, voffB); PG8_STAGE(PG8_SB(0, 1), b2 + hstepB, voffB); PG8_STAGE(PG8_SA(0, 0), a2, voffA);
            PG8_WAIT_V(8); PG8_WAIT_L(0); PG8_BAR; PG8_MMA(1, 0, At, B0); PG8_MMA(1, 1, At, B1); PG8_BAR; PG8_SCHED;
            PG8_LDB(B0, 1, 0); PG8_LDB(B1, 1, 1); PG8_SCHED; PG8_LDA(At, 1, 0); PG8_STAGE(PG8_SA(0, 1), a2 + hstepA, voffA);
            PG8_WAIT_V(8); PG8_WAIT_L(0); PG8_BAR; PG8_MMA(0, 0, At, B0); PG8_MMA(0, 1, At, B1); PG8_BAR; PG8_SCHED;
            PG8_LDA(At, 1, 1); PG8_STAGE(PG8_SB(1, 0), b3, voffB); PG8_STAGE(PG8_SB(1, 1), b3 + hstepB, voffB); PG8_STAGE(PG8_SA(1, 0), a3, voffA);
            PG8_WAIT_V(8); PG8_WAIT_L(0); PG8_BAR; PG8_MMA(1, 0, At, B0); PG8_MMA(1, 1, At, B1); PG8_BAR; PG8_SCHED;
            } else {
            PG8_LDB(B0, 0, 0); PG8_SCHED; PG8_LDA(At, 0, 0); PG8_STAGE(PG8_SA(1, 1), a1 + hstepA, voffA);
            PG8_WAIT_L(8); PG8_BAR; PG8_WAIT_L(0); PG8_MMA(0, 0, At, B0); PG8_BAR; PG8_SCHED;
            PG8_LDB(B1, 0, 1); PG8_STAGE(PG8_SB(0, 0), b2, voffB);
            PG8_BAR; PG8_WAIT_L(0); PG8_MMA(0, 1, At, B1); PG8_BAR;
            PG8_LDA(At, 0, 1); PG8_STAGE(PG8_SA(0, 0), a2, voffA);
            PG8_BAR; PG8_WAIT_L(0); PG8_MMA(1, 0, At, B0); PG8_BAR; PG8_SCHED;
            PG8_STAGE(PG8_SB(0, 1), b2 + hstepB, voffB);
            PG8_WAIT_V(6); PG8_BAR; PG8_MMA(1, 1, At, B1); PG8_BAR;
            PG8_LDB(B0, 1, 0); PG8_SCHED; PG8_LDA(At, 1, 0); PG8_STAGE(PG8_SA(0, 1), a2 + hstepA, voffA);
            PG8_WAIT_L(8); PG8_BAR; PG8_WAIT_L(0); PG8_MMA(0, 0, At, B0); PG8_BAR; PG8_SCHED;
            PG8_LDB(B1, 1, 1); PG8_STAGE(PG8_SB(1, 0), b3, voffB);
            PG8_BAR; PG8_WAIT_L(0); PG8_MMA(0, 1, At, B1); PG8_BAR;
            PG8_LDA(At, 1, 1); PG8_STAGE(PG8_SA(1, 0), a3, voffA);
            PG8_BAR; PG8_WAIT_L(0); PG8_MMA(1, 0, At, B0); PG8_BAR; PG8_SCHED;
            PG8_STAGE(PG8_SB(1, 1), b3 + hstepB, voffB);
            PG8_WAIT_V(6); PG8_BAR; PG8_MMA(1, 1, At, B1); PG8_BAR;
            }
        }
        if constexpr (ALIGN_EPI) { if (wr == 0) PG8_BAR; }
        if constexpr (!Epi::AFTER_DRAIN) { E(acc, cur, wr, wc, fr, fq); S.done(cur); }
        if (!has_next) break;
#pragma unroll
        for (int a = 0; a < 2; ++a)
#pragma unroll
            for (int b = 0; b < 2; ++b)
#pragma unroll
                for (int m = 0; m < 4; ++m)
#pragma unroll
                    for (int n = 0; n < 2; ++n) acc[a][b][m][n] = (f32x4){0.f, 0.f, 0.f, 0.f};
        cur = nxt; cA = nA; cB = nB; ++ui;
        if constexpr (ALIGN_EPI) { if (wr == 1) PG8_BAR; }
    }
    PG8_WAIT_V(0);
    if constexpr (!ALIGN_EPI) { if (wr == 0) PG8_BAR; }
    PG8_BAR;
    if constexpr (Epi::AFTER_DRAIN) { E.fused(acc, cur, wr, wc, fr, fq, lds, wid, lane); S.done(cur); }
#undef PG8_SA
#undef PG8_SB
#undef PG8_STAGE
#undef PG8_LDA
#undef PG8_LDB
#undef PG8_MMA
#undef PG8_WAIT_V
#undef PG8_WAIT_L
#undef PG8_BAR
#undef PG8_SCHED
}
}
#define GAS __attribute__((address_space(1)))
#define LAS __attribute__((address_space(3)))
typedef unsigned short bf16;
typedef unsigned v4u __attribute__((ext_vector_type(4)));
typedef float f32x4 __attribute__((ext_vector_type(4)));
typedef short bf16x8 __attribute__((ext_vector_type(8)));
typedef GAS unsigned gu32;
typedef GAS unsigned long long gu64;
#define RLX_AGENT __ATOMIC_RELAXED, __HIP_MEMORY_SCOPE_AGENT
#define LDS_WAIT() asm volatile("s_waitcnt lgkmcnt(0)" ::: "memory")
#define VM_WAIT() asm volatile("s_waitcnt vmcnt(0)" ::: "memory")
__device__ __forceinline__ unsigned long long rt() { return __builtin_amdgcn_s_memrealtime(); }
__device__ __forceinline__ unsigned f2bf(float f) { unsigned u = __builtin_bit_cast(unsigned, f); return (u + 0x7fffu + ((u >> 16) & 1u)) >> 16; }
__device__ __forceinline__ unsigned pk2(float lo, float hi) { return f2bf(lo) | (f2bf(hi) << 16); }

#define XB_TMO      128
#define XB_XCNT(j)  (256  + 64 * (j))
#define XB_XSUB(j)  (1280 + 64 * (j))
#define XB_XGEN(j)  (2304 + 64 * (j))
#define XB_TOP      3328
#define XB_TOPGEN   3392
#define XCD_BAR_WORDS 3456
#define XB_SPIN_CAP (1u << 18)

__device__ __forceinline__ unsigned xb_ld(unsigned* p)              { return __hip_atomic_load(p, __ATOMIC_RELAXED, __HIP_MEMORY_SCOPE_AGENT); }
__device__ __forceinline__ unsigned xb_add(unsigned* p, unsigned v) { return __hip_atomic_fetch_add(p, v, __ATOMIC_RELAXED, __HIP_MEMORY_SCOPE_AGENT); }
__device__ __forceinline__ unsigned xb_xcc_id() { return (unsigned)__builtin_amdgcn_s_getreg((3 << 11) | 20) & 0xFu; }
#define XB_SPIN(cond, bar) do { unsigned _sp = 0; while (cond) { __builtin_amdgcn_s_sleep(1); \
    if ((++_sp & 255u) == 0u) { if (xb_ld(&(bar)[XB_TMO])) break; if (_sp > XB_SPIN_CAP) { atomicAdd(&(bar)[XB_TMO], 1u); break; } } } } while (0)

struct XcdBarrier {
    unsigned* bar; unsigned x;
    volatile LAS unsigned* st;
};

__device__ __forceinline__ XcdBarrier xcd_barrier_post(unsigned* bar, volatile LAS unsigned* st) {
    XcdBarrier b; b.bar = bar; b.x = xb_xcc_id(); b.st = st;
    if (threadIdx.x == 0) (void)xb_add(&bar[XB_XCNT(b.x)], 1u);
    return b;
}
__device__ __forceinline__ void xcd_barrier_complete(unsigned* bar, unsigned x, unsigned& nloc, unsigned& nx) {
    const unsigned G = gridDim.x * gridDim.y * gridDim.z;
    unsigned sum, cnt, mine, sp = 0u;
    for (;;) {
        sum = 0u; cnt = 0u; mine = 0u;
#pragma unroll
        for (unsigned j = 0; j < 16; ++j) { const unsigned c = xb_ld(&bar[XB_XCNT(j)]); sum += c; cnt += (c > 0u) ? 1u : 0u; mine = (j == x) ? c : mine; }
        if (sum == G) break;
        __builtin_amdgcn_s_sleep(1);
        if ((++sp & 255u) == 0u) { if (xb_ld(&bar[XB_TMO])) break; if (sp > XB_SPIN_CAP) { atomicAdd(&bar[XB_TMO], 1u); break; } }
    }
    nloc = mine > 0u ? mine : 1u; nx = cnt > 0u ? cnt : 1u;
}

__device__ __forceinline__ void xcd_barrier(const XcdBarrier& b) {
    asm volatile("s_waitcnt vmcnt(0)" ::: "memory");
    __syncthreads();
    if (threadIdx.x == 0) {
        unsigned* bar = b.bar;
        __builtin_amdgcn_s_waitcnt(0);
        unsigned nloc = b.st[0], nx = b.st[1];
        if (nloc == 0u) { xcd_barrier_complete(bar, b.x, nloc, nx); b.st[0] = nloc; b.st[1] = nx; }
        const unsigned old = xb_add(&bar[XB_XSUB(b.x)], 1u);
        const unsigned gen = old / nloc;
        if (old + 1u == (gen + 1u) * nloc) {
            __builtin_amdgcn_fence(__ATOMIC_RELEASE, "agent");
            asm volatile("s_waitcnt vmcnt(0)" ::: "memory");
            const unsigned og = xb_add(&bar[XB_TOP], 1u);
            const unsigned tg = og / nx;
            if (og + 1u == (tg + 1u) * nx) xb_add(&bar[XB_TOPGEN], 1u);
            else XB_SPIN(xb_ld(&bar[XB_TOPGEN]) == tg, bar);
            __builtin_amdgcn_fence(__ATOMIC_ACQUIRE, "agent");
            xb_add(&bar[XB_XGEN(b.x)], 1u);
            asm volatile("s_waitcnt vmcnt(0)" ::: "memory");
        } else {
            XB_SPIN(xb_ld(&bar[XB_XGEN(b.x)]) == gen, bar);
            __builtin_amdgcn_fence(__ATOMIC_ACQUIRE, "agent");
            asm volatile("s_waitcnt vmcnt(0)" ::: "memory");
        }
    }
    __syncthreads();
}
constexpr int NWAVES = 8;
constexpr int BATCH = 16, SEQ = 2048, D = 1024, M = BATCH * SEQ;
constexpr int NP = 2816;
constexpr int IN_COLS = 2824;
constexpr int O_AK = 512, O_AV = 640, O_MQ = 768, O_MK = 1280, O_MV = 1792, O_MO = 2304, O_G = 2816;
constexpr int MEMLEN = 256, MMEM = BATCH * MEMLEN;
constexpr int FF = 2816, NU = 2 * FF;
constexpr float EPS = 1e-6f;
constexpr size_t MiB = 1u << 20;
constexpr size_t WS_CTL = 0, CTL_ZERO_BYTES = 1 * MiB;
constexpr size_t WS_RSTD0 = 1 * MiB;
constexpr size_t WS_RSTDM = WS_RSTD0 + 128 * 1024;
constexpr size_t WS_GPRE = 2 * MiB;
constexpr size_t WS_SSQ1 = 4 * MiB, WS_SSQ2 = 6 * MiB, WS_SSQ3 = 8 * MiB;
constexpr size_t WS_WIN = 16 * MiB, WS_WKV = 22 * MiB, WS_WOUT = 26 * MiB, WS_WQ = 28 * MiB, WS_WO = 30 * MiB, WS_WUP = 32 * MiB, WS_WDN = 43 * MiB;
constexpr size_t WS_MEMB = 49 * MiB;
constexpr size_t WS_KVM = 57 * MiB;
constexpr size_t WS_XB = 80 * MiB;
constexpr size_t WS_P = 144 * MiB;
constexpr size_t WS_MIX = 320 * MiB;
constexpr size_t WS_QX = 384 * MiB;
constexpr size_t WS_XO = 448 * MiB;
constexpr size_t WS_U = 144 * MiB;
constexpr size_t WS_END = 512 * MiB;
static_assert(WS_WDN + (size_t)D * FF * 2 <= WS_MEMB && WS_KVM + (size_t)MMEM * 2048 * 2 <= WS_XB && WS_XB + (size_t)M * D * 2 == WS_P && WS_P + (size_t)M * NP * 2 == WS_MIX && WS_U + (size_t)M * NU * 2 <= WS_END, "d_ws map");
constexpr int CW_TMO = 0, CW_CODE = 1;
constexpr int CW_BAR = 4096;
constexpr int N_BAR_REGIONS = 16;
static_assert((CW_BAR + N_BAR_REGIONS * XCD_BAR_WORDS) * 4 <= (int)CTL_ZERO_BYTES, "CTL words inside the memset region");
constexpr int RING_OFF = 0, RING_BYTES = 131072;
constexpr int LDS_BYTES = 163840;
constexpr int LDSCTL_OFF = LDS_BYTES - 512, MISC_OFF = LDSCTL_OFF + 320;
constexpr int PH_LDS = LDSCTL_OFF;

struct Args { const float* in[20]; float* out; unsigned char* ws; int ph_lo, ph_hi, li, pad; };

struct Frame {
    LAS unsigned char* lds; volatile LAS unsigned* MISC; gu32* ctl;
    int tid, lane, wave, vcu, G;
};
__device__ __forceinline__ float wave_sum(float v) {
#pragma unroll
    for (int o = 1; o < 64; o <<= 1) v += __shfl_xor(v, o);
    return v;
}
__device__ __forceinline__ float bf2f(unsigned short b) { return __builtin_bit_cast(float, (unsigned)b << 16); }
__device__ __forceinline__ float bflo(unsigned w) { return __builtin_bit_cast(float, w << 16); }
__device__ __forceinline__ float bfhi(unsigned w) { return __builtin_bit_cast(float, w & 0xffff0000u); }

__device__ __forceinline__ void p0_transpose_item(const float* W, int K, int ldw, int src_col0, const float* g, bf16* WT, int dst_row0, LAS float* scr, int kb, int lane) {
    const int k0 = 64 * kb;
#pragma unroll 8
    for (int i = 0; i < 32; ++i) { const int kk = 2 * i + (lane >> 5); float w = W[(size_t)(k0 + kk) * ldw + src_col0 + (lane & 31)]; if (g) w *= g[k0 + kk]; scr[kk * 33 + (lane & 31)] = w; }
    LDS_WAIT(); asm volatile("" ::: "memory");
    const int c = lane & 7;
#pragma unroll
    for (int j = 0; j < 4; ++j) { const int n = (lane >> 3) + 8 * j; const LAS float* s = scr + (8 * c) * 33 + n;
        v4u o; o.x = pk2(s[0 * 33], s[1 * 33]); o.y = pk2(s[2 * 33], s[3 * 33]); o.z = pk2(s[4 * 33], s[5 * 33]); o.w = pk2(s[6 * 33], s[7 * 33]);
        *(GAS v4u*)(WT + (size_t)(dst_row0 + n) * K + k0 + 8 * c) = o; }
    LDS_WAIT(); asm volatile("" ::: "memory");
}
__device__ __forceinline__ float row_to_bf16(const float* xrow, bf16* orow, int lane, f32x4 (&v)[4]) {
    const GAS f32x4* xr = (const GAS f32x4*)xrow + lane; float s = 0.f;
#pragma unroll
    for (int j = 0; j < 4; ++j) { v[j] = xr[64 * j]; s += (v[j][0] * v[j][0] + v[j][1] * v[j][1]) + (v[j][2] * v[j][2] + v[j][3] * v[j][3]); }
    GAS unsigned long long* o8 = (GAS unsigned long long*)orow + lane;
#pragma unroll
    for (int j = 0; j < 4; ++j) o8[64 * j] = (unsigned long long)pk2(v[j][0], v[j][1]) | ((unsigned long long)pk2(v[j][2], v[j][3]) << 32);
    return wave_sum(s);
}
__device__ __forceinline__ void p0_prologue(Frame& F, const Args& a) {
    unsigned char* ws = a.ws;
    LAS float* scr = (LAS float*)(F.lds + F.wave * 8448);
    LAS float* wgT = (LAS float*)(F.lds + 73728);
    const int gw = F.vcu * NWAVES + F.wave, NGW = F.G * NWAVES;
    {
        const float* w_in = a.in[3]; const float* gm = a.in[2];
        for (int i = F.tid; i < 8192; i += NWAVES * 64) { const int k = i >> 3, c = i & 7; wgT[c * 1024 + k] = gm[k] * w_in[(size_t)k * IN_COLS + O_G + c]; }
    }
    constexpr int I_IN = 16 * (NP / 32), I_KV = 16 * 64, I_SQ = 16 * 32, I_UP = 16 * (NU / 32), I_DN = (FF / 64) * 32;
    constexpr int NITEMS = I_IN + I_KV + 3 * I_SQ + I_UP + I_DN;
    for (int it = gw; it < NITEMS; it += NGW) {
        int r = it;
        if (r < I_IN) { const int nb = r % (NP / 32), kb = r / (NP / 32); p0_transpose_item(a.in[3], D, IN_COLS, 32 * nb, a.in[2], (bf16*)(ws + WS_WIN), 32 * nb, scr, kb, F.lane); continue; } r -= I_IN;
        if (r < I_KV) { const int nb = r % 64, kb = r / 64; p0_transpose_item(a.in[12], D, 2048, 32 * nb, a.in[10], (bf16*)(ws + WS_WKV), 32 * nb, scr, kb, F.lane); continue; } r -= I_KV;
        if (r < I_SQ) { const int nb = r % 32, kb = r / 32; p0_transpose_item(a.in[8], D, D, 32 * nb, nullptr, (bf16*)(ws + WS_WOUT), 32 * nb, scr, kb, F.lane); continue; } r -= I_SQ;
        if (r < I_SQ) { const int nb = r % 32, kb = r / 32; p0_transpose_item(a.in[11], D, D, 32 * nb, a.in[9], (bf16*)(ws + WS_WQ), 32 * nb, scr, kb, F.lane); continue; } r -= I_SQ;
        if (r < I_SQ) { const int nb = r % 32, kb = r / 32; p0_transpose_item(a.in[13], D, D, 32 * nb, nullptr, (bf16*)(ws + WS_WO), 32 * nb, scr, kb, F.lane); continue; } r -= I_SQ;
        if (r < I_UP) { const int nb = r % (NU / 32), kb = r / (NU / 32); p0_transpose_item(a.in[15], D, NU, 32 * nb, a.in[14], (bf16*)(ws + WS_WUP), 32 * nb, scr, kb, F.lane); continue; } r -= I_UP;
        { const int nb = r % 32, kb = r / 32; p0_transpose_item(a.in[18], FF, D, 32 * nb, nullptr, (bf16*)(ws + WS_WDN), 32 * nb, scr, kb, F.lane); }
    }
    __syncthreads();
    float* rstd0 = (float*)(ws + WS_RSTD0); float* gpre = (float*)(ws + WS_GPRE); bf16* XB = (bf16*)(ws + WS_XB);
    for (int m = gw; m < M; m += NGW) {
        f32x4 v[4];
        const float ssq = row_to_bf16(a.in[0] + (size_t)m * D, XB + (size_t)m * D, F.lane, v);
        const float rstd = 1.0f / sqrtf(ssq * (1.0f / D) + EPS);
        float ga[8];
#pragma unroll
        for (int c = 0; c < 8; ++c) { float s = 0.f;
#pragma unroll
            for (int j = 0; j < 4; ++j) { const f32x4 w = *(const LAS f32x4*)(wgT + c * 1024 + 256 * j + 4 * F.lane); s += (v[j][0] * w[0] + v[j][1] * w[1]) + (v[j][2] * w[2] + v[j][3] * w[3]); }
            ga[c] = wave_sum(s) * rstd; }
        if (F.lane == 0) { rstd0[m] = rstd; *(f32x4*)(gpre + (size_t)m * 8) = (f32x4){ga[0], ga[1], ga[2], ga[3]}; *(f32x4*)(gpre + (size_t)m * 8 + 4) = (f32x4){ga[4], ga[5], ga[6], ga[7]}; }
    }
    float* rstdm = (float*)(ws + WS_RSTDM); bf16* MEMB = (bf16*)(ws + WS_MEMB);
    for (int m = gw; m < MMEM; m += NGW) {
        f32x4 v[4];
        const float ssq = row_to_bf16(a.in[1] + (size_t)m * D, MEMB + (size_t)m * D, F.lane, v);
        if (F.lane == 0) rstdm[m] = 1.0f / sqrtf(ssq * (1.0f / D) + EPS);
    }
}
__device__ __forceinline__ void p8_act(Frame& F, const Args& a) {
    bf16* U = (bf16*)(a.ws + WS_U); const float* cw = a.in[16]; const float* cb = a.in[17];
    constexpr int NCH = FF / 8, RUN = 16, NIT = (M / RUN) * NCH;
    for (int it = blockIdx.x * (NWAVES * 64) + F.tid; it < NIT; it += F.G * NWAVES * 64) {
        const int ch = it % NCH, r = it / NCH, row0 = r * RUN, t0 = row0 % SEQ, c0 = ch * 8;
        float w0[8], w1[8], w2[8], bb[8];
#pragma unroll
        for (int e = 0; e < 8; e += 4) { const f32x4 x0 = *(const f32x4*)(cw + c0 + e), x1 = *(const f32x4*)(cw + FF + c0 + e), x2 = *(const f32x4*)(cw + 2 * FF + c0 + e), x3 = *(const f32x4*)(cb + c0 + e);
#pragma unroll
            for (int q = 0; q < 4; ++q) { w0[e + q] = x0[q]; w1[e + q] = x1[q]; w2[e + q] = x2[q]; bb[e + q] = x3[q]; } }
        v4u gm2 = (v4u){0u, 0u, 0u, 0u}, gm1 = gm2;
        if (t0 >= 2) { gm2 = *(const v4u*)(U + (size_t)(row0 - 2) * NU + c0); gm1 = *(const v4u*)(U + (size_t)(row0 - 1) * NU + c0); }
#pragma unroll 4
        for (int i = 0; i < RUN; ++i) {
            bf16* rp = U + (size_t)(row0 + i) * NU;
            const v4u g0 = *(const v4u*)(rp + c0), vv = *(const v4u*)(rp + FF + c0);
            v4u o;
#pragma unroll
            for (int q = 0; q < 4; ++q) {
                const float ga = w0[2 * q] * bflo(gm2[q]) + w1[2 * q] * bflo(gm1[q]) + w2[2 * q] * bflo(g0[q]) + bb[2 * q];
                const float gb = w0[2 * q + 1] * bfhi(gm2[q]) + w1[2 * q + 1] * bfhi(gm1[q]) + w2[2 * q + 1] * bfhi(g0[q]) + bb[2 * q + 1];
                const float ra = ga / (1.0f + __expf(-ga)) * bflo(vv[q]), rb = gb / (1.0f + __expf(-gb)) * bfhi(vv[q]);
                o[q] = pk2(ra, rb);
            }
            *(v4u*)(rp + FF + c0) = o;
            gm2 = gm1; gm1 = g0;
        }
    }
}
__device__ __forceinline__ void p10_final(Frame& F, const Args& a) {
    const int gw = F.vcu * NWAVES + F.wave, NGW = F.G * NWAVES;
    const float* gf = a.in[19]; const pg8::RsParts rs{(const float*)(a.ws + WS_SSQ3)};
    f32x4 gv[4];
#pragma unroll
    for (int j = 0; j < 4; ++j) gv[j] = ((const f32x4*)gf)[64 * j + F.lane];
    for (int m = gw; m < M; m += NGW) {
        const float r = rs.get(m);
        GAS f32x4* xr = (GAS f32x4*)(a.out + (size_t)m * D) + F.lane;
#pragma unroll
        for (int j = 0; j < 4; ++j) { const f32x4 v = xr[64 * j]; xr[64 * j] = v * r * gv[j]; }
    }
}

#ifndef PG8_SP2
#define PG8_SP2 true
#endif
#ifndef PG8_ALIGN
#define PG8_ALIGN true
#endif
enum { PH_PRO = 0, PH_G1 = 1, PH_MIX = 2, PH_G2 = 3, PH_G3 = 4, PH_XAT = 5, PH_G4 = 6, PH_G5 = 7, PH_ACT = 8, PH_G6 = 9, PH_FIN = 10, PH_N = 11 };

__global__ void __launch_bounds__(NWAVES * 64, 2) mk_fwd(Args args) {
    extern __shared__ __attribute__((aligned(16))) unsigned char lds[];
    Frame F;
    F.lds = (LAS unsigned char*)lds;
    F.MISC = (volatile LAS unsigned*)(F.lds + MISC_OFF);
    F.tid = threadIdx.x; F.lane = F.tid & 63; F.wave = __builtin_amdgcn_readfirstlane(F.tid >> 6);
    F.G = gridDim.x; { const int bx = blockIdx.x; F.vcu = (F.G % 8 == 0) ? (bx % 8) * (F.G / 8) + bx / 8 : bx; }
    unsigned char* ws = args.ws;
    F.ctl = (gu32*)(ws + WS_CTL);
    for (int u = F.tid; u < (LDS_BYTES - LDSCTL_OFF) / 4; u += NWAVES * 64) ((LAS unsigned*)(F.lds + LDSCTL_OFF))[u] = 0u;
    __syncthreads();
    const int lo = args.ph_lo, hi = args.ph_hi;
    XcdBarrier bar = xcd_barrier_post((unsigned*)(F.ctl + CW_BAR) + args.li * XCD_BAR_WORDS, F.MISC + 8);
#define IN(k) (lo <= (k) && (k) < hi)
#define SEAM(k) do { if (IN(k) && IN((k) + 1)) xcd_barrier(bar); } while (0)
    bf16* XB = (bf16*)(ws + WS_XB); bf16* P = (bf16*)(ws + WS_P); bf16* MIX = (bf16*)(ws + WS_MIX); bf16* QX = (bf16*)(ws + WS_QX); bf16* XO = (bf16*)(ws + WS_XO); bf16* U = (bf16*)(ws + WS_U);
    const int G = F.G, bx = (int)blockIdx.x;

    if (IN(PH_PRO)) { p0_prologue(F, args); SEAM(PH_PRO); }
    if (IN(PH_G1)) {
        { pg8::Gemm g{XB, D, (const bf16*)(ws + WS_WIN), M, NP, D}; pg8::StaticOrder S; S.init(M, NP, G, bx);
          pg8::EpiScaleBf16<pg8::RsArr> E{P, NP, {(const float*)(ws + WS_RSTD0)}};
          pg8::gemm_phase<pg8::EpiScaleBf16<pg8::RsArr>, pg8::StaticOrder, PG8_ALIGN, PG8_SP2>(F.lds + RING_OFF, g, S, E); }
        { pg8::Gemm g{(const bf16*)(ws + WS_MEMB), D, (const bf16*)(ws + WS_WKV), MMEM, 2048, D}; pg8::StaticOrder S; S.init(MMEM, 2048, G, (bx + G / 2) % G);
          pg8::EpiScaleBf16<pg8::RsArr> E{(bf16*)(ws + WS_KVM), 2048, {(const float*)(ws + WS_RSTDM)}};
          pg8::gemm_phase<pg8::EpiScaleBf16<pg8::RsArr>, pg8::StaticOrder, PG8_ALIGN, PG8_SP2>(F.lds + RING_OFF, g, S, E); }
        SEAM(PH_G1);
    }
    if (IN(PH_MIX)) {   SEAM(PH_MIX); }
    if (IN(PH_G2)) {
        pg8::Gemm g{MIX, D, (const bf16*)(ws + WS_WOUT), M, D, D}; pg8::StaticOrder S; S.init(M, D, G, bx);
        pg8::EpiResid<true> E{args.in[0], args.out, XB, (float*)(ws + WS_SSQ1), D};
        pg8::gemm_phase<pg8::EpiResid<true>, pg8::StaticOrder, PG8_ALIGN, PG8_SP2>(F.lds + RING_OFF, g, S, E);
        SEAM(PH_G2);
    }
    if (IN(PH_G3)) {
        pg8::Gemm g{XB, D, (const bf16*)(ws + WS_WQ), M, D, D}; pg8::StaticOrder S; S.init(M, D, G, bx);
        pg8::EpiScaleBf16<pg8::RsOne> E{QX, D, {}};
        pg8::gemm_phase<pg8::EpiScaleBf16<pg8::RsOne>, pg8::StaticOrder, PG8_ALIGN, PG8_SP2>(F.lds + RING_OFF, g, S, E);
        SEAM(PH_G3);
    }
    if (IN(PH_XAT)) {   SEAM(PH_XAT); }
    if (IN(PH_G4)) {
        pg8::Gemm g{XO, D, (const bf16*)(ws + WS_WO), M, D, D}; pg8::StaticOrder S; S.init(M, D, G, bx);
        pg8::EpiResid<true> E{args.out, args.out, XB, (float*)(ws + WS_SSQ2), D};
        pg8::gemm_phase<pg8::EpiResid<true>, pg8::StaticOrder, PG8_ALIGN, PG8_SP2>(F.lds + RING_OFF, g, S, E);
        SEAM(PH_G4);
    }
    if (IN(PH_G5)) {
        pg8::Gemm g{XB, D, (const bf16*)(ws + WS_WUP), M, NU, D}; pg8::StaticOrder S; S.init(M, NU, G, bx);
        pg8::EpiScaleBf16<pg8::RsParts> E{U, NU, {(const float*)(ws + WS_SSQ2)}};
        pg8::gemm_phase<pg8::EpiScaleBf16<pg8::RsParts>, pg8::StaticOrder, PG8_ALIGN, PG8_SP2>(F.lds + RING_OFF, g, S, E);
        SEAM(PH_G5);
    }
    if (IN(PH_ACT)) { p8_act(F, args); SEAM(PH_ACT); }
    if (IN(PH_G6)) {
        pg8::Gemm g{U + FF, NU, (const bf16*)(ws + WS_WDN), M, D, FF}; pg8::StaticOrder S; S.init(M, D, G, bx);
        pg8::EpiResid<false> E{args.out, args.out, nullptr, (float*)(ws + WS_SSQ3), D};
        pg8::gemm_phase<pg8::EpiResid<false>, pg8::StaticOrder, PG8_ALIGN, PG8_SP2>(F.lds + RING_OFF, g, S, E);
        SEAM(PH_G6);
    }
    if (IN(PH_FIN)) { p10_final(F, args); }
#undef IN
#undef SEAM
}
namespace nvb {
__global__ void __launch_bounds__(256) swa_k(const bf16* __restrict__ P, const float* __restrict__ sinks, bf16* MIX) {
    const int idx = blockIdx.x * blockDim.x + threadIdx.x;
    if (idx >= M * 8) return;
    const int h = idx & 7, row = idx >> 3, b = row / SEQ, t = row % SEQ, hk = h >> 2;
    const float slope = exp2f(-(float)(h + 1));
    const bf16* q = P + (size_t)row * NP + h * 64;
    float qr[64];
#pragma unroll
    for (int d = 0; d < 64; ++d) qr[d] = bf2f(q[d]);
    const float sink = sinks[h];
    float m = sink, l = 1.0f;
    float o[64];
#pragma unroll
    for (int d = 0; d < 64; ++d) o[d] = 0.f;
    const int s_lo = (t - 127 > 0) ? t - 127 : 0;
    for (int s = s_lo; s <= t; ++s) {
        const bf16* kp = P + (size_t)(b * SEQ + s) * NP + O_AK + hk * 64;
        const bf16* vp = P + (size_t)(b * SEQ + s) * NP + O_AV + hk * 64;
        float sc = 0.f;
#pragma unroll
        for (int d = 0; d < 64; ++d) sc += qr[d] * bf2f(kp[d]);
        sc = sc * 0.125f - slope * (float)(t - s);
        const float mn = fmaxf(m, sc);
        const float f = expf(m - mn), e = expf(sc - mn);
        l = l * f + e;
#pragma unroll
        for (int d = 0; d < 64; ++d) o[d] = o[d] * f + e * bf2f(vp[d]);
        m = mn;
    }
    const float inv = 1.0f / l;
    bf16* op = MIX + (size_t)row * D + h * 64;
#pragma unroll
    for (int d = 0; d < 64; ++d) op[d] = (bf16)f2bf(o[d] * inv);
}
__global__ void __launch_bounds__(128) mlstm_k(const bf16* __restrict__ P, const float* __restrict__ gpre, const float* __restrict__ bg, const float* __restrict__ cw, const float* __restrict__ cb, bf16* MIX) {
    const int b = blockIdx.x >> 2, h = blockIdx.x & 3, j = threadIdx.x;
    __shared__ float qs[128], ks[128], ns[128];
    float C[128];
#pragma unroll
    for (int d = 0; d < 128; ++d) C[d] = 0.f;
    ns[j] = 0.f;
    float mprev = 0.f;
    const int cq = h * 128 + j, ck = 512 + h * 128 + j;
    float wq[4], wk[4];
#pragma unroll
    for (int i = 0; i < 4; ++i) { wq[i] = cw[i * 1024 + cq]; wk[i] = cw[i * 1024 + ck]; }
    const float bq = cb[cq], bk = cb[ck];
    const float bi = bg[h], bf = bg[4 + h];
    __syncthreads();
    for (int t = 0; t < SEQ; ++t) {
        const size_t row = (size_t)b * SEQ + t;
        float aq = bq, ak = bk;
#pragma unroll
        for (int i = 0; i < 4; ++i) { const int tt = t - 3 + i; if (tt >= 0) { const bf16* pr = P + ((size_t)b * SEQ + tt) * NP + O_MQ; aq += wq[i] * bf2f(pr[cq]); ak += wk[i] * bf2f(pr[ck]); } }
        const float qv = aq / (1.0f + expf(-aq)) * 0.08838834764831845f;
        const float kv = ak / (1.0f + expf(-ak));
        const bf16* pr = P + row * NP;
        const float vv = bf2f(pr[O_MV + h * 128 + j]), ov = bf2f(pr[O_MO + h * 128 + j]);
        const float ipre = gpre[row * 8 + h] + bi, fpre = gpre[row * 8 + 4 + h] + bf;
        const float lf = fminf(fpre, 0.f) - log1pf(expf(-fabsf(fpre)));
        const float mt = fmaxf(lf + mprev, ipre);
        const float fg = expf(lf + mprev - mt), ig = expf(ipre - mt);
        __syncthreads();
        qs[j] = qv; ks[j] = kv;
        ns[j] = fg * ns[j] + ig * kv;
        __syncthreads();
        float num = 0.f, den = 0.f;
#pragma unroll
        for (int d = 0; d < 128; ++d) { C[d] = fg * C[d] + ig * ks[d] * vv; num += qs[d] * C[d]; den += qs[d] * ns[d]; }
        const float hh = num / fmaxf(fabsf(den), expf(-mt));
        MIX[row * D + 512 + h * 128 + j] = (bf16)f2bf(hh / (1.0f + expf(-ov)));
        mprev = mt;
    }
}
__global__ void __launch_bounds__(256) xattn_k(const bf16* __restrict__ QX, const float* __restrict__ ssq1, const bf16* __restrict__ KVM, bf16* XO) {
    const int row = blockIdx.x, b = row / SEQ, t = threadIdx.x;
    __shared__ float q[1024];
    __shared__ float a[256];
    __shared__ float red[8];
    float ss = 0.f;
    for (int i = 0; i < 16; ++i) ss += ssq1[(size_t)row * 16 + i];
    const float rstd = 1.0f / sqrtf(ss * (1.0f / 1024.0f) + EPS);
    for (int i = t; i < 1024; i += 256) q[i] = bf2f(QX[(size_t)row * 1024 + i]) * rstd;
    __syncthreads();
    for (int h = 0; h < 4; ++h) {
        const bf16* kp = KVM + (size_t)(b * MEMLEN + t) * 2048 + h * 256;
        float s = 0.f;
        for (int d = 0; d < 256; ++d) s += q[h * 256 + d] * bf2f(kp[d]);
        s *= 0.0625f;
        float mx = s;
        for (int o = 32; o > 0; o >>= 1) mx = fmaxf(mx, __shfl_xor(mx, o));
        if ((t & 63) == 0) red[t >> 6] = mx;
        __syncthreads();
        mx = fmaxf(fmaxf(red[0], red[1]), fmaxf(red[2], red[3]));
        const float e = expf(s - mx);
        float sm = e;
        for (int o = 32; o > 0; o >>= 1) sm += __shfl_xor(sm, o);
        if ((t & 63) == 0) red[4 + (t >> 6)] = sm;
        a[t] = e;
        __syncthreads();
        sm = red[4] + red[5] + red[6] + red[7];
        float o = 0.f;
        for (int m2 = 0; m2 < 256; ++m2) o += a[m2] * bf2f(KVM[(size_t)(b * MEMLEN + m2) * 2048 + 1024 + h * 256 + t]);
        XO[(size_t)row * 1024 + h * 256 + t] = (bf16)f2bf(o / sm);
        __syncthreads();
    }
}
}
extern "C" void kernel_launch(void* const* d_in, const int* in_sizes, int n_in, void* d_out, int out_size, void* d_ws, size_t ws_size, hipStream_t stream) {
    static int grid = 0;
    if (grid == 0) {
        if (n_in != 20 || in_sizes[0] != M * D || out_size != M * D || ws_size < WS_END) { fprintf(stderr, "kernel_launch: shape/workspace mismatch: n_in %d in0 %d out %d ws %zu (need %zu)\n", n_in, n_in > 0 ? in_sizes[0] : -1, out_size, ws_size, (size_t)WS_END); grid = -1; return; }
        int dev = 0, cus = 0, per_cu = 0;
        if (hipGetDevice(&dev) != hipSuccess || hipDeviceGetAttribute(&cus, hipDeviceAttributeMultiprocessorCount, dev) != hipSuccess) { fprintf(stderr, "kernel_launch: device query failed\n"); grid = -1; return; }
        if (hipFuncSetAttribute((const void*)mk_fwd, hipFuncAttributeMaxDynamicSharedMemorySize, LDS_BYTES) != hipSuccess) { fprintf(stderr, "kernel_launch: hipFuncSetAttribute failed\n"); grid = -1; return; }
        if (hipOccupancyMaxActiveBlocksPerMultiprocessor(&per_cu, (const void*)mk_fwd, NWAVES * 64, LDS_BYTES) != hipSuccess || per_cu < 1) { fprintf(stderr, "kernel_launch: occupancy query reports %d workgroups per CU\n", per_cu); (void)hipGetLastError(); grid = -1; return; }
        grid = cus;
    }
    if (grid < 0) return;
    (void)hipMemsetAsync((char*)d_ws + WS_CTL, 0, CTL_ZERO_BYTES, stream);
    Args a{};
    for (int i = 0; i < 20; ++i) a.in[i] = (const float*)d_in[i];
    a.out = (float*)d_out; a.ws = (unsigned char*)d_ws;
    unsigned char* ws = (unsigned char*)d_ws;
    auto launch = [&](int lo, int hi, int li) { a.ph_lo = lo; a.ph_hi = hi; a.li = li; hipLaunchKernelGGL(mk_fwd, dim3(grid), dim3(NWAVES * 64), LDS_BYTES, stream, a); };
    launch(PH_PRO, PH_MIX, 0);
    nvb::swa_k<<<M * 8 / 256, 256, 0, stream>>>((const bf16*)(ws + WS_P), a.in[7], (bf16*)(ws + WS_MIX));
    nvb::mlstm_k<<<BATCH * 4, 128, 0, stream>>>((const bf16*)(ws + WS_P), (const float*)(ws + WS_GPRE), a.in[4], a.in[5], a.in[6], (bf16*)(ws + WS_MIX));
    launch(PH_G2, PH_XAT, 1);
    nvb::xattn_k<<<M, 256, 0, stream>>>((const bf16*)(ws + WS_QX), (const float*)(ws + WS_SSQ1), (const bf16*)(ws + WS_KVM), (bf16*)(ws + WS_XO));
    launch(PH_G4, PH_N, 2);
}
```

```cpp
#include <hip/hip_runtime.h>
#include <cstdio>
#include <cstdint>
namespace pg8 {
#define PG8_LAS __attribute__((address_space(3)))
typedef unsigned short bf16_t;
typedef short bf16x8 __attribute__((ext_vector_type(8)));
typedef float f32x4 __attribute__((ext_vector_type(4)));
typedef unsigned u32x4 __attribute__((ext_vector_type(4)));
constexpr int BM = 256, BK = 64, HALF = 128, HTB = HALF * BK * 2  , STAGE_BYTES = 8 * HTB, NXCD = 8, WGM = 8;

__host__ __device__ __forceinline__ int lds_byte(int r, int c) { const int st = (r >> 4) * 2 + (c >> 5), rr = r & 15, cc = c & 31, ob = rr * 64 + cc * 2; return st * 1024 + (ob ^ (((ob >> 9) & 1) << 5)); }
__host__ __device__ __forceinline__ void stage_rc(int b, int& R, int& C) { const int st = b / 1024, sb = b % 1024, swz = sb ^ (((sb >> 9) & 1) << 5); R = (st >> 1) * 16 + swz / 64; C = (st & 1) * 32 + (swz % 64) / 2; }
__host__ __device__ __forceinline__ int perm32(int rho) { const int n = rho >> 4, i = rho & 15; return 8 * (i >> 2) + 4 * n + (i & 3); }

struct Unit { int pm, pn; };
struct Gemm { const bf16_t* A; int lda; const bf16_t* Bt; int M, N, K; };

struct StaticOrder {
    int nM, nN, nwg, G, c;
    __host__ __device__ void init(int M, int N, int G_, int c_) { nM = M / BM; nN = N / BM; nwg = nM * nN; G = G_; c = c_; }
    __host__ __device__ bool next(int i, Unit& u) const {
        const long L = (long)i * G + c; if (L >= nwg) return false;
        int wgid = (int)L; { const int q = nwg / NXCD, r = nwg % NXCD, xcd = wgid % NXCD, off = wgid / NXCD; wgid = (xcd < r ? xcd * (q + 1) : r * (q + 1) + (xcd - r) * q) + off; }
        const int nig = WGM * nN, gid = wgid / nig, fm = gid * WGM, gsz = (nM - fm) < WGM ? (nM - fm) : WGM;
        u.pm = fm + ((wgid % nig) % gsz); u.pn = (wgid % nig) / gsz; return true;
    }
    __device__ __forceinline__ void a_ready(const Unit&) const {}
    __device__ __forceinline__ void done(const Unit&) const {}
};

__device__ __forceinline__ unsigned cvt_pk_bf16(float lo, float hi) { unsigned r; asm volatile("v_cvt_pk_bf16_f32 %0, %1, %2" : "=v"(r) : "v"(lo), "v"(hi)); return r; }
typedef float f32x2 __attribute__((ext_vector_type(2)));
constexpr float RMS_EPS = 1e-6f;
struct RsOne   { __device__ __forceinline__ float get(int) const { return 1.0f; } };
struct RsArr   { const float* r; __device__ __forceinline__ float get(int row) const { return r[row]; } };
struct RsParts { const float* p;
    __device__ __forceinline__ float get(int row) const { const f32x4* q = (const f32x4*)(p + (size_t)row * 16); const f32x4 a = q[0], b = q[1], c = q[2], d = q[3];
        const float s = ((a[0] + a[1]) + (a[2] + a[3])) + ((b[0] + b[1]) + (b[2] + b[3])) + ((c[0] + c[1]) + (c[2] + c[3])) + ((d[0] + d[1]) + (d[2] + d[3]));
        return 1.0f / sqrtf(s * (1.0f / 1024.0f) + RMS_EPS); } };
template <class RS> struct EpiScaleBf16 {
    static constexpr bool PERM = true, AFTER_DRAIN = false;
    bf16_t* O; int ldc; RS rs;
    __device__ __forceinline__ void operator()(const f32x4 (&acc)[2][2][4][2], const Unit& u, int wr, int wc, int fr, int fq) const {
        const int row0 = u.pm * BM + wr * 64 + fr, col0 = u.pn * BM + wc * 32 + 8 * fq;
#pragma unroll
        for (int ai = 0; ai < 2; ++ai)
#pragma unroll
            for (int m = 0; m < 4; ++m) { const int row = row0 + ai * HALF + m * 16; const float sc = rs.get(row); bf16_t* rowp = O + (size_t)row * ldc + col0;
#pragma unroll
                for (int bj = 0; bj < 2; ++bj) { const f32x4 v0 = acc[ai][bj][m][0] * sc, v1 = acc[ai][bj][m][1] * sc;
                    u32x4 w; w.x = cvt_pk_bf16(v0[0], v0[1]); w.y = cvt_pk_bf16(v0[2], v0[3]); w.z = cvt_pk_bf16(v1[0], v1[1]); w.w = cvt_pk_bf16(v1[2], v1[3]);
                    *(u32x4*)(rowp + bj * HALF) = w; } }
    }
};
template <bool WRITE_BF16> struct EpiResid {
    static constexpr bool PERM = false, AFTER_DRAIN = false;
    const float* base; float* out; bf16_t* xb; float* ssq; int ldc;
    __device__ __forceinline__ void operator()(const f32x4 (&acc)[2][2][4][2], const Unit& u, int wr, int wc, int fr, int fq) const {
        typedef unsigned u32x2v __attribute__((ext_vector_type(2)));
        const int row0 = u.pm * BM + wr * 64 + fr, col0 = u.pn * BM + wc * 32 + 4 * fq;
#pragma unroll
        for (int ai = 0; ai < 2; ++ai)
#pragma unroll
            for (int m = 0; m < 4; ++m) { const int row = row0 + ai * HALF + m * 16; const size_t off = (size_t)row * ldc + col0; float ss = 0.f;
#pragma unroll
                for (int bj = 0; bj < 2; ++bj)
#pragma unroll
                    for (int n = 0; n < 2; ++n) { const size_t o2 = off + bj * HALF + n * 16; const f32x4 o = *(const f32x4*)(base + o2) + acc[ai][bj][m][n];
                        *(f32x4*)(out + o2) = o; ss += (o[0] * o[0] + o[1] * o[1]) + (o[2] * o[2] + o[3] * o[3]);
                        if (WRITE_BF16) { u32x2v w; w.x = cvt_pk_bf16(o[0], o[1]); w.y = cvt_pk_bf16(o[2], o[3]); *(u32x2v*)(xb + o2) = w; } }
                ss += __shfl_xor(ss, 16); ss += __shfl_xor(ss, 32);
                if (fq == 0) ssq[(size_t)row * 16 + u.pn * 4 + wc] = ss;
                asm volatile("" ::: "memory"); }
    }
};
template <class Epi, class Sched, bool ALIGN_EPI = false, bool SP2 = false>
__device__ __forceinline__ void gemm_phase(PG8_LAS unsigned char* lds, const Gemm g, const Sched& S, const Epi& E) {
    const int tid = threadIdx.x, wid = __builtin_amdgcn_readfirstlane(tid >> 6), lane = tid & 63, wr = wid >> 2, wc = wid & 3, fr = lane & 15, fq = lane >> 4;
    const int K = g.K, nt = K / BK;
    unsigned voffA[2], voffB[2];
#pragma unroll
    for (int i = 0; i < 2; ++i) { int R, C; stage_rc(tid * 16 + i * 8192, R, C); const int Rb = Epi::PERM ? ((R & ~31) + perm32(R & 31)) : R;
        voffA[i] = (unsigned)(R * g.lda + C) * 2u; voffB[i] = (unsigned)(Rb * K + C) * 2u; }
    const size_t kstep = (size_t)(BK * 2);
    const size_t hstepA = (size_t)HALF * g.lda * 2, hstepB = (size_t)HALF * K * 2;
    const size_t tstepA = 2 * hstepA, tstepB = 2 * hstepB;
    const unsigned ldsw = (unsigned)wid * 1024u;
    const int aoff = lds_byte(wr * 64 + fr, fq * 8), boff = lds_byte(wc * 32 + fr, fq * 8);
#define PG8_SA(b, h) (((b) * 2 + (h)) * HTB)
#define PG8_SB(b, h) ((4 + (b) * 2 + (h)) * HTB)
#define PG8_STAGE(bufoff, gbase, voff) do { _Pragma("unroll") for (int _i = 0; _i < 2; ++_i) \
        __builtin_amdgcn_global_load_lds((const unsigned*)((const char*)(gbase) + (voff)[_i]), (PG8_LAS unsigned*)(lds + (bufoff) + ldsw + _i * 8192), 16, 0, 0); } while (0)
#define PG8_LDA(dst, b, h) do { _Pragma("unroll") for (int m = 0; m < 4; ++m) _Pragma("unroll") for (int k = 0; k < 2; ++k) dst[m][k] = *(const PG8_LAS bf16x8*)(lds + PG8_SA(b, h) + aoff + m * 2048 + k * 1024); } while (0)
#define PG8_LDB(dst, b, h) do { _Pragma("unroll") for (int n = 0; n < 2; ++n) _Pragma("unroll") for (int k = 0; k < 2; ++k) dst[n][k] = *(const PG8_LAS bf16x8*)(lds + PG8_SB(b, h) + boff + n * 2048 + k * 1024); } while (0)
#define PG8_MMA(ai, bj, At, Bt) do { __builtin_amdgcn_s_setprio(1); _Pragma("unroll") for (int m = 0; m < 4; ++m) _Pragma("unroll") for (int n = 0; n < 2; ++n) _Pragma("unroll") for (int k = 0; k < 2; ++k) \
        acc[ai][bj][m][n] = __builtin_amdgcn_mfma_f32_16x16x32_bf16(Bt[n][k], At[m][k], acc[ai][bj][m][n], 0, 0, 0); __builtin_amdgcn_s_setprio(0); } while (0)
#define PG8_WAIT_V(n) asm volatile("s_waitcnt vmcnt(" #n ")" ::: "memory")
#define PG8_WAIT_L(n) asm volatile("s_waitcnt lgkmcnt(" #n ")" ::: "memory")
#define PG8_BAR __builtin_amdgcn_s_barrier()
#define PG8_SCHED __builtin_amdgcn_sched_barrier(0)
    Unit cur, nxt; int ui = 0;
    if (!S.next(0, cur)) return;
    f32x4 acc[2][2][4][2];
#pragma unroll
    for (int a = 0; a < 2; ++a)
#pragma unroll
        for (int b = 0; b < 2; ++b)
#pragma unroll
            for (int m = 0; m < 4; ++m)
#pragma unroll
                for (int n = 0; n < 2; ++n) acc[a][b][m][n] = (f32x4){0.f, 0.f, 0.f, 0.f};
    bf16x8 At[4][2], B0[2][2], B1[2][2];
    const char* cA = (const char*)g.A + (size_t)cur.pm * tstepA; const char* cB = (const char*)g.Bt + (size_t)cur.pn * tstepB;
    S.a_ready(cur);
    if constexpr (SP2) {
        PG8_STAGE(PG8_SB(0, 0), cB, voffB); PG8_STAGE(PG8_SB(0, 1), cB + hstepB, voffB); PG8_STAGE(PG8_SA(0, 0), cA, voffA); PG8_STAGE(PG8_SA(0, 1), cA + hstepA, voffA);
        if (wr == 1) PG8_BAR;
        PG8_WAIT_V(2); PG8_BAR;
        PG8_STAGE(PG8_SB(1, 0), cB + kstep, voffB); PG8_STAGE(PG8_SA(1, 0), cA + kstep, voffA); PG8_STAGE(PG8_SB(1, 1), cB + hstepB + kstep, voffB);
        PG8_WAIT_V(6); PG8_BAR;
    } else {
        PG8_STAGE(PG8_SB(0, 0), cB, voffB); PG8_STAGE(PG8_SA(0, 0), cA, voffA); PG8_STAGE(PG8_SB(0, 1), cB + hstepB, voffB); PG8_STAGE(PG8_SA(0, 1), cA + hstepA, voffA);
        if (wr == 1) PG8_BAR;
        PG8_WAIT_V(4); PG8_BAR;
        PG8_STAGE(PG8_SB(1, 0), cB + kstep, voffB); PG8_STAGE(PG8_SA(1, 0), cA + kstep, voffA); PG8_STAGE(PG8_SB(1, 1), cB + hstepB + kstep, voffB);
        PG8_WAIT_V(6); PG8_BAR;
    }
    for (;;) {
        const bool has_next = S.next(ui + 1, nxt);
        const char* nA = has_next ? (const char*)g.A + (size_t)nxt.pm * tstepA : cA; const char* nB = has_next ? (const char*)g.Bt + (size_t)nxt.pn * tstepB : cB;
        for (int t = 0; t < nt; t += 2) {
            const bool last = (t == nt - 2);
            const char* a1 = cA + (size_t)(t + 1) * kstep;
            const char* a2 = last ? nA : cA + (size_t)(t + 2) * kstep; const char* b2 = last ? nB : cB + (size_t)(t + 2) * kstep;
            const char* a3 = a2 + kstep; const char* b3 = b2 + kstep;
            if (last && has_next) S.a_ready(nxt);
            if constexpr (SP2) {
            PG8_LDB(B0, 0, 0); PG8_LDB(B1, 0, 1); PG8_SCHED; PG8_LDA(At, 0, 0); PG8_STAGE(PG8_SA(1, 1), a1 + hstepA, voffA);
            PG8_WAIT_V(8); PG8_WAIT_L(0); PG8_BAR; PG8_MMA(0, 0, At, B0); PG8_MMA(0, 1, At, B1); PG8_BAR; PG8_SCHED;
            PG8_LDA(At, 0, 1); PG8_STAGE(PG8_SB(0, 0), b2, voffB); PG8_STAGE(PG8_SB(0, 1), b2 + hstepB, voffB); PG8_STAGE(PG8_SA(0, 0), a2, voffA);
            PG8_WAIT_V(8); PG8_WAIT_L(0); PG8_BAR; PG8_MMA(1, 0, At, B0); PG8_MMA(1, 1, At, B1); PG8_BAR; PG8_SCHED;
            PG8_LDB(B0, 1, 0); PG8_LDB(B1, 1, 1); PG8_SCHED; PG8_LDA(At, 1, 0); PG8_STAGE(PG8_SA(0, 1), a2 + hstepA, voffA);
            PG8_WAIT_V(8); PG8_WAIT_L(0); PG8_BAR; PG8_MMA(0, 0, At, B0); PG8_MMA(0, 1, At, B1); PG8_BAR; PG8_SCHED;
            PG8_LDA(At, 1, 1); PG8_STAGE(PG8_SB(1, 0), b3, voffB); PG8_STAGE(PG8_SB(1, 1), b3 + hstepB, voffB); PG8_STAGE(PG8_SA(1, 0), a3, voffA);
            PG8_WAIT_V(8); PG8_WAIT_L(0); PG8_BAR; PG8_MMA(1, 0, At, B0); PG8_MMA(1, 1, At, B1); PG8_BAR; PG8_SCHED;
            } else {
            PG8_LDB(B0, 0, 0); PG8_SCHED; PG8_LDA(At, 0, 0); PG8_STAGE(PG8_SA(1, 1), a1 + hstepA, voffA);
            PG8_WAIT_L(8); PG8_BAR; PG8_WAIT_L(0); PG8_MMA(0, 0, At, B0); PG8_BAR; PG8_SCHED;
            PG8_LDB(B1, 0, 1); PG8_STAGE(PG8_SB(0, 0), b2, voffB);
            PG8_BAR; PG8_WAIT_L(0); PG8_MMA(0, 1, At, B1); PG8_BAR;
            PG8_LDA(At, 0, 1); PG8_STAGE(PG8_SA(0, 0), a2, voffA);
            PG8_BAR; PG8_WAIT_L(0); PG8_MMA(1, 0, At, B0); PG8_BAR; PG8_SCHED;
            PG8_STAGE(PG8_SB(0, 1), b2 + hstepB, voffB);
            PG8_WAIT_V(6); PG8_BAR; PG8_MMA(1, 1, At, B1); PG8_BAR;
            PG8_LDB(B0, 1, 0); PG8_SCHED; PG8_LDA(At, 1, 0); PG8_STAGE(PG8_SA(0, 1), a2 + hstepA, voffA);
            PG8_WAIT_L(8); PG8_BAR; PG8_WAIT_L(0); PG8_MMA(0, 0, At, B0); PG8_BAR; PG8_SCHED;
            PG8_LDB(B1, 1, 1); PG8_STAGE(PG8_SB(1, 0), b3, voffB);
            PG8_BAR; PG8_WAIT_L(0); PG8_MMA(0, 1, At, B1); PG8_BAR;
            PG8_LDA(At, 1, 1); PG8_STAGE(PG8_SA(1, 0), a3, voffA);
            PG8_BAR; PG8_WAIT_L(0); PG8_MMA(1, 0, At, B0); PG8_BAR; PG8_SCHED;
            PG8_STAGE(PG8_SB(1, 1), b3 + hstepB, voffB);
            PG8_WAIT_V(6); PG8_BAR; PG8_MMA(1, 1, At, B1); PG8_BAR;
            }
        }
        if constexpr (ALIGN_EPI) { if (wr == 0) PG8_BAR; }
        if constexpr (!Epi::AFTER_DRAIN) { E(acc, cur, wr, wc, fr, fq); S.done(cur); }
        if (!has_next) break;
#pragma unroll
        for (int a = 0; a < 2; ++a)
#pragma unroll
            for (int b = 0; b < 2; ++b)
#pragma unroll
                for (int m = 0; m < 4; ++m)
#pragma unroll
                    for (int n = 0; n < 2; ++n) acc[a][b][m][n] = (f32x4){0.f, 0.f, 0.f, 0.f};
        cur = nxt; cA = nA; cB = nB; ++ui;
        if constexpr (ALIGN_EPI) { if (wr == 1) PG8_BAR; }
    }
    PG8_WAIT_V(0);
    if constexpr (!ALIGN_EPI) { if (wr == 0) PG8_BAR; }
    PG8_BAR;
    if constexpr (Epi::AFTER_DRAIN) { E.fused(acc, cur, wr, wc, fr, fq, lds, wid, lane); S.done(cur); }
#undef PG8_SA
#undef PG8_SB
#undef PG8_STAGE
#undef PG8_LDA
#undef PG8_LDB
#undef PG8_MMA
#undef PG8_WAIT_V
#undef PG8_WAIT_L
#undef PG8_BAR
#undef PG8_SCHED
}
}
#define GAS __attribute__((address_space(1)))
#define LAS __attribute__((address_space(3)))
typedef unsigned short bf16;
typedef unsigned v4u __attribute__((ext_vector_type(4)));
typedef float f32x4 __attribute__((ext_vector_type(4)));
typedef short bf16x8 __attribute__((ext_vector_type(8)));
typedef GAS unsigned gu32;
typedef GAS unsigned long long gu64;
#define RLX_AGENT __ATOMIC_RELAXED, __HIP_MEMORY_SCOPE_AGENT
#define LDS_WAIT() asm volatile("s_waitcnt lgkmcnt(0)" ::: "memory")
#define VM_WAIT() asm volatile("s_waitcnt vmcnt(0)" ::: "memory")
__device__ __forceinline__ unsigned long long rt() { return __builtin_amdgcn_s_memrealtime(); }
__device__ __forceinline__ unsigned f2bf(float f) { unsigned u = __builtin_bit_cast(unsigned, f); return (u + 0x7fffu + ((u >> 16) & 1u)) >> 16; }
__device__ __forceinline__ unsigned pk2(float lo, float hi) { return f2bf(lo) | (f2bf(hi) << 16); }

#define XB_TMO      128
#define XB_XCNT(j)  (256  + 64 * (j))
#define XB_XSUB(j)  (1280 + 64 * (j))
#define XB_XGEN(j)  (2304 + 64 * (j))
#define XB_TOP      3328
#define XB_TOPGEN   3392
#define XCD_BAR_WORDS 3456
#define XB_SPIN_CAP (1u << 18)

__device__ __forceinline__ unsigned xb_ld(unsigned* p)              { return __hip_atomic_load(p, __ATOMIC_RELAXED, __HIP_MEMORY_SCOPE_AGENT); }
__device__ __forceinline__ unsigned xb_add(unsigned* p, unsigned v) { return __hip_atomic_fetch_add(p, v, __ATOMIC_RELAXED, __HIP_MEMORY_SCOPE_AGENT); }
__device__ __forceinline__ unsigned xb_xcc_id() { return (unsigned)__builtin_amdgcn_s_getreg((3 << 11) | 20) & 0xFu; }
#define XB_SPIN(cond, bar) do { unsigned _sp = 0; while (cond) { __builtin_amdgcn_s_sleep(1); \
    if ((++_sp & 255u) == 0u) { if (xb_ld(&(bar)[XB_TMO])) break; if (_sp > XB_SPIN_CAP) { atomicAdd(&(bar)[XB_TMO], 1u); break; } } } } while (0)

struct XcdBarrier {
    unsigned* bar; unsigned x;
    volatile LAS unsigned* st;
};

__device__ __forceinline__ XcdBarrier xcd_barrier_post(unsigned* bar, volatile LAS unsigned* st) {
    XcdBarrier b; b.bar = bar; b.x = xb_xcc_id(); b.st = st;
    if (threadIdx.x == 0) (void)xb_add(&bar[XB_XCNT(b.x)], 1u);
    return b;
}
__device__ __forceinline__ void xcd_barrier_complete(unsigned* bar, unsigned x, unsigned& nloc, unsigned& nx) {
    const unsigned G = gridDim.x * gridDim.y * gridDim.z;
    unsigned sum, cnt, mine, sp = 0u;
    for (;;) {
        sum = 0u; cnt = 0u; mine = 0u;
#pragma unroll
        for (unsigned j = 0; j < 16; ++j) { const unsigned c = xb_ld(&bar[XB_XCNT(j)]); sum += c; cnt += (c > 0u) ? 1u : 0u; mine = (j == x) ? c : mine; }
        if (sum == G) break;
        __builtin_amdgcn_s_sleep(1);
        if ((++sp & 255u) == 0u) { if (xb_ld(&bar[XB_TMO])) break; if (sp > XB_SPIN_CAP) { atomicAdd(&bar[XB_TMO], 1u); break; } }
    }
    nloc = mine > 0u ? mine : 1u; nx = cnt > 0u ? cnt : 1u;
}

__device__ __forceinline__ void xcd_barrier(const XcdBarrier& b) {
    asm volatile("s_waitcnt vmcnt(0)" ::: "memory");
    __syncthreads();
    if (threadIdx.x == 0) {
        unsigned* bar = b.bar;
        __builtin_amdgcn_s_waitcnt(0);
        unsigned nloc = b.st[0], nx = b.st[1];
        if (nloc == 0u) { xcd_barrier_complete(bar, b.x, nloc, nx); b.st[0] = nloc; b.st[1] = nx; }
        const unsigned old = xb_add(&bar[XB_XSUB(b.x)], 1u);
        const unsigned gen = old / nloc;
        if (old + 1u == (gen + 1u) * nloc) {
            __builtin_amdgcn_fence(__ATOMIC_RELEASE, "agent");
            asm volatile("s_waitcnt vmcnt(0)" ::: "memory");
            const unsigned og = xb_add(&bar[XB_TOP], 1u);
            const unsigned tg = og / nx;
            if (og + 1u == (tg + 1u) * nx) xb_add(&bar[XB_TOPGEN], 1u);
            else XB_SPIN(xb_ld(&bar[XB_TOPGEN]) == tg, bar);
            __builtin_amdgcn_fence(__ATOMIC_ACQUIRE, "agent");
            xb_add(&bar[XB_XGEN(b.x)], 1u);
            asm volatile("s_waitcnt vmcnt(0)" ::: "memory");
        } else {
            XB_SPIN(xb_ld(&bar[XB_XGEN(b.x)]) == gen, bar);
            __builtin_amdgcn_fence(__ATOMIC_ACQUIRE, "agent");
            asm volatile("s_waitcnt vmcnt(0)" ::: "memory");
        }
    }
    __syncthreads();
}
constexpr int NWAVES = 8;
constexpr int BATCH = 16, SEQ = 2048, D = 1024, M = BATCH * SEQ;
constexpr int NP = 2816;
constexpr int IN_COLS = 2824;
constexpr int O_AK = 512, O_AV = 640, O_MQ = 768, O_MK = 1280, O_MV = 1792, O_MO = 2304, O_G = 2816;
constexpr int MEMLEN = 256, MMEM = BATCH * MEMLEN;
constexpr int FF = 2816, NU = 2 * FF;
constexpr float EPS = 1e-6f;
constexpr size_t MiB = 1u << 20;
constexpr size_t WS_CTL = 0, CTL_ZERO_BYTES = 1 * MiB;
constexpr size_t WS_RSTD0 = 1 * MiB;
constexpr size_t WS_RSTDM = WS_RSTD0 + 128 * 1024;
constexpr size_t WS_GPRE = 2 * MiB;
constexpr size_t WS_SSQ1 = 4 * MiB, WS_SSQ2 = 6 * MiB, WS_SSQ3 = 8 * MiB;
constexpr size_t WS_WIN = 16 * MiB, WS_WKV = 22 * MiB, WS_WOUT = 26 * MiB, WS_WQ = 28 * MiB, WS_WO = 30 * MiB, WS_WUP = 32 * MiB, WS_WDN = 43 * MiB;
constexpr size_t WS_MEMB = 49 * MiB;
constexpr size_t WS_KVM = 57 * MiB;
constexpr size_t WS_XB = 80 * MiB;
constexpr size_t WS_P = 144 * MiB;
constexpr size_t WS_MIX = 320 * MiB;
constexpr size_t WS_QX = 384 * MiB;
constexpr size_t WS_XO = 448 * MiB;
constexpr size_t WS_U = 144 * MiB;
constexpr size_t WS_END = 512 * MiB;
static_assert(WS_WDN + (size_t)D * FF * 2 <= WS_MEMB && WS_KVM + (size_t)MMEM * 2048 * 2 <= WS_XB && WS_XB + (size_t)M * D * 2 == WS_P && WS_P + (size_t)M * NP * 2 == WS_MIX && WS_U + (size_t)M * NU * 2 <= WS_END, "d_ws map");
constexpr int CW_TMO = 0, CW_CODE = 1;
constexpr int CW_BAR = 4096;
constexpr int N_BAR_REGIONS = 16;
static_assert((CW_BAR + N_BAR_REGIONS * XCD_BAR_WORDS) * 4 <= (int)CTL_ZERO_BYTES, "CTL words inside the memset region");
constexpr int RING_OFF = 0, RING_BYTES = 131072;
constexpr int LDS_BYTES = 163840;
constexpr int LDSCTL_OFF = LDS_BYTES - 512, MISC_OFF = LDSCTL_OFF + 320;
constexpr int PH_LDS = LDSCTL_OFF;

struct Args { const float* in[20]; float* out; unsigned char* ws; int ph_lo, ph_hi, li, pad; };

struct Frame {
    LAS unsigned char* lds; volatile LAS unsigned* MISC; gu32* ctl;
    int tid, lane, wave, vcu, G;
};
__device__ __forceinline__ float wave_sum(float v) {
#pragma unroll
    for (int o = 1; o < 64; o <<= 1) v += __shfl_xor(v, o);
    return v;
}
__device__ __forceinline__ float bf2f(unsigned short b) { return __builtin_bit_cast(float, (unsigned)b << 16); }
__device__ __forceinline__ float bflo(unsigned w) { return __builtin_bit_cast(float, w << 16); }
__device__ __forceinline__ float bfhi(unsigned w) { return __builtin_bit_cast(float, w & 0xffff0000u); }

__device__ __forceinline__ void p0_transpose_item(const float* W, int K, int ldw, int src_col0, const float* g, bf16* WT, int dst_row0, LAS float* scr, int kb, int lane) {
    const int k0 = 64 * kb;
#pragma unroll 8
    for (int i = 0; i < 32; ++i) { const int kk = 2 * i + (lane >> 5); float w = W[(size_t)(k0 + kk) * ldw + src_col0 + (lane & 31)]; if (g) w *= g[k0 + kk]; scr[kk * 33 + (lane & 31)] = w; }
    LDS_WAIT(); asm volatile("" ::: "memory");
    const int c = lane & 7;
#pragma unroll
    for (int j = 0; j < 4; ++j) { const int n = (lane >> 3) + 8 * j; const LAS float* s = scr + (8 * c) * 33 + n;
        v4u o; o.x = pk2(s[0 * 33], s[1 * 33]); o.y = pk2(s[2 * 33], s[3 * 33]); o.z = pk2(s[4 * 33], s[5 * 33]); o.w = pk2(s[6 * 33], s[7 * 33]);
        *(GAS v4u*)(WT + (size_t)(dst_row0 + n) * K + k0 + 8 * c) = o; }
    LDS_WAIT(); asm volatile("" ::: "memory");
}
__device__ __forceinline__ float row_to_bf16(const float* xrow, bf16* orow, int lane, f32x4 (&v)[4]) {
    const GAS f32x4* xr = (const GAS f32x4*)xrow + lane; float s = 0.f;
#pragma unroll
    for (int j = 0; j < 4; ++j) { v[j] = xr[64 * j]; s += (v[j][0] * v[j][0] + v[j][1] * v[j][1]) + (v[j][2] * v[j][2] + v[j][3] * v[j][3]); }
    GAS unsigned long long* o8 = (GAS unsigned long long*)orow + lane;
#pragma unroll
    for (int j = 0; j < 4; ++j) o8[64 * j] = (unsigned long long)pk2(v[j][0], v[j][1]) | ((unsigned long long)pk2(v[j][2], v[j][3]) << 32);
    return wave_sum(s);
}
__device__ __forceinline__ void p2_mix_naive(Frame& F, const Args& a) {
    const bf16* P = (const bf16*)(a.ws + WS_P); bf16* MIX = (bf16*)(a.ws + WS_MIX);
    const int NSEQ = BATCH * 4;
    if ((int)blockIdx.x < NSEQ && F.G > NSEQ) {
        const float* gpre = (const float*)(a.ws + WS_GPRE); const float* bg = a.in[4]; const float* cw = a.in[5]; const float* cb = a.in[6];
        const int b = blockIdx.x >> 2, h = blockIdx.x & 3, j = F.tid & 127; const bool act = F.tid < 128;
        LAS float* qs = (LAS float*)F.lds; LAS float* ks = qs + 128; LAS float* ns = ks + 128;
        float C[128];
#pragma unroll
        for (int d = 0; d < 128; ++d) C[d] = 0.f;
        if (act) ns[j] = 0.f;
        float mprev = 0.f;
        const int cq = h * 128 + j, ck = 512 + h * 128 + j;
        float wq[4], wk[4];
#pragma unroll
        for (int i = 0; i < 4; ++i) { wq[i] = cw[i * 1024 + cq]; wk[i] = cw[i * 1024 + ck]; }
        const float bq = cb[cq], bk = cb[ck], bi = bg[h], bf = bg[4 + h];
        __syncthreads();
        for (int t = 0; t < SEQ; ++t) {
            const size_t row = (size_t)b * SEQ + t;
            float aq = bq, ak = bk;
#pragma unroll
            for (int i = 0; i < 4; ++i) { const int tt = t - 3 + i; if (tt >= 0) { const bf16* pr = P + ((size_t)b * SEQ + tt) * NP + O_MQ; aq += wq[i] * bf2f(pr[cq]); ak += wk[i] * bf2f(pr[ck]); } }
            const float qv = aq / (1.0f + expf(-aq)) * 0.08838834764831845f, kv = ak / (1.0f + expf(-ak));
            const bf16* pr = P + row * NP;
            const float vv = bf2f(pr[O_MV + h * 128 + j]), ov = bf2f(pr[O_MO + h * 128 + j]);
            const float ipre = gpre[row * 8 + h] + bi, fpre = gpre[row * 8 + 4 + h] + bf;
            const float lf = fminf(fpre, 0.f) - log1pf(expf(-fabsf(fpre)));
            const float mt = fmaxf(lf + mprev, ipre);
            const float fg = expf(lf + mprev - mt), ig = expf(ipre - mt);
            __syncthreads();
            if (act) { qs[j] = qv; ks[j] = kv; ns[j] = fg * ns[j] + ig * kv; }
            __syncthreads();
            if (act) {
                float num = 0.f, den = 0.f;
#pragma unroll
                for (int d = 0; d < 128; ++d) { C[d] = fg * C[d] + ig * ks[d] * vv; num += qs[d] * C[d]; den += qs[d] * ns[d]; }
                const float hh = num / fmaxf(fabsf(den), expf(-mt));
                MIX[row * D + 512 + h * 128 + j] = (bf16)f2bf(hh / (1.0f + expf(-ov)));
            }
            mprev = mt;
        }
    } else {
        const float* sinks = a.in[7];
        const int nb = F.G > NSEQ ? F.G - NSEQ : F.G, b0 = F.G > NSEQ ? (int)blockIdx.x - NSEQ : (int)blockIdx.x;
        for (int idx = b0 * (NWAVES * 64) + F.tid; idx < M * 8; idx += nb * NWAVES * 64) {
            const int h = idx & 7, row = idx >> 3, b = row / SEQ, t = row % SEQ, hk = h >> 2;
            const float slope = exp2f(-(float)(h + 1));
            const bf16* q = P + (size_t)row * NP + h * 64;
            float qr[64];
#pragma unroll
            for (int d = 0; d < 64; ++d) qr[d] = bf2f(q[d]);
            float m = sinks[h], l = 1.0f;
            float o[64];
#pragma unroll
            for (int d = 0; d < 64; ++d) o[d] = 0.f;
            const int s_lo = (t - 127 > 0) ? t - 127 : 0;
            for (int s = s_lo; s <= t; ++s) {
                const bf16* kp = P + (size_t)(b * SEQ + s) * NP + O_AK + hk * 64;
                const bf16* vp = P + (size_t)(b * SEQ + s) * NP + O_AV + hk * 64;
                float sc = 0.f;
#pragma unroll
                for (int d = 0; d < 64; ++d) sc += qr[d] * bf2f(kp[d]);
                sc = sc * 0.125f - slope * (float)(t - s);
                const float mn = fmaxf(m, sc);
                const float f = expf(m - mn), e = expf(sc - mn);
                l = l * f + e;
#pragma unroll
                for (int d = 0; d < 64; ++d) o[d] = o[d] * f + e * bf2f(vp[d]);
                m = mn;
            }
            const float inv = 1.0f / l;
            bf16* op = MIX + (size_t)row * D + h * 64;
#pragma unroll
            for (int d = 0; d < 64; ++d) op[d] = (bf16)f2bf(o[d] * inv);
        }
    }
}
__device__ __forceinline__ void p5_xattn_naive(Frame& F, const Args& a) {
    const bf16* QX = (const bf16*)(a.ws + WS_QX); const bf16* KVM = (const bf16*)(a.ws + WS_KVM); bf16* XO = (bf16*)(a.ws + WS_XO); const float* ssq1 = (const float*)(a.ws + WS_SSQ1);
    const int half = F.tid >> 8, t = F.tid & 255;
    LAS float* q = (LAS float*)F.lds + half * 1536; LAS float* av = q + 1024; LAS float* red = av + 256;
    for (int row0 = 2 * (int)blockIdx.x; row0 < M; row0 += 2 * F.G) {
        const int row = row0 + half, b = row / SEQ;
        float ss = 0.f;
        for (int i = 0; i < 16; ++i) ss += ssq1[(size_t)row * 16 + i];
        const float rstd = 1.0f / sqrtf(ss * (1.0f / 1024.0f) + EPS);
        __syncthreads();
        for (int i = t; i < 1024; i += 256) q[i] = bf2f(QX[(size_t)row * 1024 + i]) * rstd;
        __syncthreads();
        for (int h = 0; h < 4; ++h) {
            const bf16* kp = KVM + (size_t)(b * MEMLEN + t) * 2048 + h * 256;
            float s = 0.f;
            for (int d = 0; d < 256; ++d) s += q[h * 256 + d] * bf2f(kp[d]);
            s *= 0.0625f;
            float mx = s;
            for (int o = 32; o > 0; o >>= 1) mx = fmaxf(mx, __shfl_xor(mx, o));
            if ((t & 63) == 0) red[t >> 6] = mx;
            __syncthreads();
            mx = fmaxf(fmaxf(red[0], red[1]), fmaxf(red[2], red[3]));
            const float e = expf(s - mx);
            float sm = e;
            for (int o = 32; o > 0; o >>= 1) sm += __shfl_xor(sm, o);
            if ((t & 63) == 0) red[4 + (t >> 6)] = sm;
            av[t] = e;
            __syncthreads();
            sm = red[4] + red[5] + red[6] + red[7];
            float o = 0.f;
            for (int m2 = 0; m2 < 256; ++m2) o += av[m2] * bf2f(KVM[(size_t)(b * MEMLEN + m2) * 2048 + 1024 + h * 256 + t]);
            XO[(size_t)row * 1024 + h * 256 + t] = (bf16)f2bf(o / sm);
            __syncthreads();
        }
    }
}
__device__ __forceinline__ void p0_prologue(Frame& F, const Args& a) {
    unsigned char* ws = a.ws;
    LAS float* scr = (LAS float*)(F.lds + F.wave * 8448);
    LAS float* wgT = (LAS float*)(F.lds + 73728);
    const int gw = F.vcu * NWAVES + F.wave, NGW = F.G * NWAVES;
    {
        const float* w_in = a.in[3]; const float* gm = a.in[2];
        for (int i = F.tid; i < 8192; i += NWAVES * 64) { const int k = i >> 3, c = i & 7; wgT[c * 1024 + k] = gm[k] * w_in[(size_t)k * IN_COLS + O_G + c]; }
    }
    constexpr int I_IN = 16 * (NP / 32), I_KV = 16 * 64, I_SQ = 16 * 32, I_UP = 16 * (NU / 32), I_DN = (FF / 64) * 32;
    constexpr int NITEMS = I_IN + I_KV + 3 * I_SQ + I_UP + I_DN;
    for (int it = gw; it < NITEMS; it += NGW) {
        int r = it;
        if (r < I_IN) { const int nb = r % (NP / 32), kb = r / (NP / 32); p0_transpose_item(a.in[3], D, IN_COLS, 32 * nb, a.in[2], (bf16*)(ws + WS_WIN), 32 * nb, scr, kb, F.lane); continue; } r -= I_IN;
        if (r < I_KV) { const int nb = r % 64, kb = r / 64; p0_transpose_item(a.in[12], D, 2048, 32 * nb, a.in[10], (bf16*)(ws + WS_WKV), 32 * nb, scr, kb, F.lane); continue; } r -= I_KV;
        if (r < I_SQ) { const int nb = r % 32, kb = r / 32; p0_transpose_item(a.in[8], D, D, 32 * nb, nullptr, (bf16*)(ws + WS_WOUT), 32 * nb, scr, kb, F.lane); continue; } r -= I_SQ;
        if (r < I_SQ) { const int nb = r % 32, kb = r / 32; p0_transpose_item(a.in[11], D, D, 32 * nb, a.in[9], (bf16*)(ws + WS_WQ), 32 * nb, scr, kb, F.lane); continue; } r -= I_SQ;
        if (r < I_SQ) { const int nb = r % 32, kb = r / 32; p0_transpose_item(a.in[13], D, D, 32 * nb, nullptr, (bf16*)(ws + WS_WO), 32 * nb, scr, kb, F.lane); continue; } r -= I_SQ;
        if (r < I_UP) { const int nb = r % (NU / 32), kb = r / (NU / 32); p0_transpose_item(a.in[15], D, NU, 32 * nb, a.in[14], (bf16*)(ws + WS_WUP), 32 * nb, scr, kb, F.lane); continue; } r -= I_UP;
        { const int nb = r % 32, kb = r / 32; p0_transpose_item(a.in[18], FF, D, 32 * nb, nullptr, (bf16*)(ws + WS_WDN), 32 * nb, scr, kb, F.lane); }
    }
    __syncthreads();
    float* rstd0 = (float*)(ws + WS_RSTD0); float* gpre = (float*)(ws + WS_GPRE); bf16* XB = (bf16*)(ws + WS_XB);
    for (int m = gw; m < M; m += NGW) {
        f32x4 v[4];
        const float ssq = row_to_bf16(a.in[0] + (size_t)m * D, XB + (size_t)m * D, F.lane, v);
        const float rstd = 1.0f / sqrtf(ssq * (1.0f / D) + EPS);
        float ga[8];
#pragma unroll
        for (int c = 0; c < 8; ++c) { float s = 0.f;
#pragma unroll
            for (int j = 0; j < 4; ++j) { const f32x4 w = *(const LAS f32x4*)(wgT + c * 1024 + 256 * j + 4 * F.lane); s += (v[j][0] * w[0] + v[j][1] * w[1]) + (v[j][2] * w[2] + v[j][3] * w[3]); }
            ga[c] = wave_sum(s) * rstd; }
        if (F.lane == 0) { rstd0[m] = rstd; *(f32x4*)(gpre + (size_t)m * 8) = (f32x4){ga[0], ga[1], ga[2], ga[3]}; *(f32x4*)(gpre + (size_t)m * 8 + 4) = (f32x4){ga[4], ga[5], ga[6], ga[7]}; }
    }
    float* rstdm = (float*)(ws + WS_RSTDM); bf16* MEMB = (bf16*)(ws + WS_MEMB);
    for (int m = gw; m < MMEM; m += NGW) {
        f32x4 v[4];
        const float ssq = row_to_bf16(a.in[1] + (size_t)m * D, MEMB + (size_t)m * D, F.lane, v);
        if (F.lane == 0) rstdm[m] = 1.0f / sqrtf(ssq * (1.0f / D) + EPS);
    }
}
__device__ __forceinline__ void p8_act(Frame& F, const Args& a) {
    bf16* U = (bf16*)(a.ws + WS_U); const float* cw = a.in[16]; const float* cb = a.in[17];
    constexpr int NCH = FF / 8, RUN = 16, NIT = (M / RUN) * NCH;
    for (int it = blockIdx.x * (NWAVES * 64) + F.tid; it < NIT; it += F.G * NWAVES * 64) {
        const int ch = it % NCH, r = it / NCH, row0 = r * RUN, t0 = row0 % SEQ, c0 = ch * 8;
        float w0[8], w1[8], w2[8], bb[8];
#pragma unroll
        for (int e = 0; e < 8; e += 4) { const f32x4 x0 = *(const f32x4*)(cw + c0 + e), x1 = *(const f32x4*)(cw + FF + c0 + e), x2 = *(const f32x4*)(cw + 2 * FF + c0 + e), x3 = *(const f32x4*)(cb + c0 + e);
#pragma unroll
            for (int q = 0; q < 4; ++q) { w0[e + q] = x0[q]; w1[e + q] = x1[q]; w2[e + q] = x2[q]; bb[e + q] = x3[q]; } }
        v4u gm2 = (v4u){0u, 0u, 0u, 0u}, gm1 = gm2;
        if (t0 >= 2) { gm2 = *(const v4u*)(U + (size_t)(row0 - 2) * NU + c0); gm1 = *(const v4u*)(U + (size_t)(row0 - 1) * NU + c0); }
#pragma unroll 4
        for (int i = 0; i < RUN; ++i) {
            bf16* rp = U + (size_t)(row0 + i) * NU;
            const v4u g0 = *(const v4u*)(rp + c0), vv = *(const v4u*)(rp + FF + c0);
            v4u o;
#pragma unroll
            for (int q = 0; q < 4; ++q) {
                const float ga = w0[2 * q] * bflo(gm2[q]) + w1[2 * q] * bflo(gm1[q]) + w2[2 * q] * bflo(g0[q]) + bb[2 * q];
                const float gb = w0[2 * q + 1] * bfhi(gm2[q]) + w1[2 * q + 1] * bfhi(gm1[q]) + w2[2 * q + 1] * bfhi(g0[q]) + bb[2 * q + 1];
                const float ra = ga / (1.0f + __expf(-ga)) * bflo(vv[q]), rb = gb / (1.0f + __expf(-gb)) * bfhi(vv[q]);
                o[q] = pk2(ra, rb);
            }
            *(v4u*)(rp + FF + c0) = o;
            gm2 = gm1; gm1 = g0;
        }
    }
}
__device__ __forceinline__ void p10_final(Frame& F, const Args& a) {
    const int gw = F.vcu * NWAVES + F.wave, NGW = F.G * NWAVES;
    const float* gf = a.in[19]; const pg8::RsParts rs{(const float*)(a.ws + WS_SSQ3)};
    f32x4 gv[4];
#pragma unroll
    for (int j = 0; j < 4; ++j) gv[j] = ((const f32x4*)gf)[64 * j + F.lane];
    for (int m = gw; m < M; m += NGW) {
        const float r = rs.get(m);
        GAS f32x4* xr = (GAS f32x4*)(a.out + (size_t)m * D) + F.lane;
#pragma unroll
        for (int j = 0; j < 4; ++j) { const f32x4 v = xr[64 * j]; xr[64 * j] = v * r * gv[j]; }
    }
}

#ifndef PG8_SP2
#define PG8_SP2 true
#endif
#ifndef PG8_ALIGN
#define PG8_ALIGN true
#endif
enum { PH_PRO = 0, PH_G1 = 1, PH_MIX = 2, PH_G2 = 3, PH_G3 = 4, PH_XAT = 5, PH_G4 = 6, PH_G5 = 7, PH_ACT = 8, PH_G6 = 9, PH_FIN = 10, PH_N = 11 };

__global__ void __launch_bounds__(NWAVES * 64, 2) mk_fwd(Args args) {
    extern __shared__ __attribute__((aligned(16))) unsigned char lds[];
    Frame F;
    F.lds = (LAS unsigned char*)lds;
    F.MISC = (volatile LAS unsigned*)(F.lds + MISC_OFF);
    F.tid = threadIdx.x; F.lane = F.tid & 63; F.wave = __builtin_amdgcn_readfirstlane(F.tid >> 6);
    F.G = gridDim.x; { const int bx = blockIdx.x; F.vcu = (F.G % 8 == 0) ? (bx % 8) * (F.G / 8) + bx / 8 : bx; }
    unsigned char* ws = args.ws;
    F.ctl = (gu32*)(ws + WS_CTL);
    for (int u = F.tid; u < (LDS_BYTES - LDSCTL_OFF) / 4; u += NWAVES * 64) ((LAS unsigned*)(F.lds + LDSCTL_OFF))[u] = 0u;
    __syncthreads();
    const int lo = args.ph_lo, hi = args.ph_hi;
    XcdBarrier bar = xcd_barrier_post((unsigned*)(F.ctl + CW_BAR) + args.li * XCD_BAR_WORDS, F.MISC + 8);
#define IN(k) (lo <= (k) && (k) < hi)
#define SEAM(k) do { if (IN(k) && IN((k) + 1)) xcd_barrier(bar); } while (0)
    bf16* XB = (bf16*)(ws + WS_XB); bf16* P = (bf16*)(ws + WS_P); bf16* MIX = (bf16*)(ws + WS_MIX); bf16* QX = (bf16*)(ws + WS_QX); bf16* XO = (bf16*)(ws + WS_XO); bf16* U = (bf16*)(ws + WS_U);
    const int G = F.G, bx = (int)blockIdx.x;

    if (IN(PH_PRO)) { p0_prologue(F, args); SEAM(PH_PRO); }
    if (IN(PH_G1)) {
        { pg8::Gemm g{XB, D, (const bf16*)(ws + WS_WIN), M, NP, D}; pg8::StaticOrder S; S.init(M, NP, G, bx);
          pg8::EpiScaleBf16<pg8::RsArr> E{P, NP, {(const float*)(ws + WS_RSTD0)}};
          pg8::gemm_phase<pg8::EpiScaleBf16<pg8::RsArr>, pg8::StaticOrder, PG8_ALIGN, PG8_SP2>(F.lds + RING_OFF, g, S, E); }
        { pg8::Gemm g{(const bf16*)(ws + WS_MEMB), D, (const bf16*)(ws + WS_WKV), MMEM, 2048, D}; pg8::StaticOrder S; S.init(MMEM, 2048, G, (bx + G / 2) % G);
          pg8::EpiScaleBf16<pg8::RsArr> E{(bf16*)(ws + WS_KVM), 2048, {(const float*)(ws + WS_RSTDM)}};
          pg8::gemm_phase<pg8::EpiScaleBf16<pg8::RsArr>, pg8::StaticOrder, PG8_ALIGN, PG8_SP2>(F.lds + RING_OFF, g, S, E); }
        SEAM(PH_G1);
    }
    if (IN(PH_MIX)) { p2_mix_naive(F, args); SEAM(PH_MIX); }
    if (IN(PH_G2)) {
        pg8::Gemm g{MIX, D, (const bf16*)(ws + WS_WOUT), M, D, D}; pg8::StaticOrder S; S.init(M, D, G, bx);
        pg8::EpiResid<true> E{args.in[0], args.out, XB, (float*)(ws + WS_SSQ1), D};
        pg8::gemm_phase<pg8::EpiResid<true>, pg8::StaticOrder, PG8_ALIGN, PG8_SP2>(F.lds + RING_OFF, g, S, E);
        SEAM(PH_G2);
    }
    if (IN(PH_G3)) {
        pg8::Gemm g{XB, D, (const bf16*)(ws + WS_WQ), M, D, D}; pg8::StaticOrder S; S.init(M, D, G, bx);
        pg8::EpiScaleBf16<pg8::RsOne> E{QX, D, {}};
        pg8::gemm_phase<pg8::EpiScaleBf16<pg8::RsOne>, pg8::StaticOrder, PG8_ALIGN, PG8_SP2>(F.lds + RING_OFF, g, S, E);
        SEAM(PH_G3);
    }
    if (IN(PH_XAT)) { p5_xattn_naive(F, args); SEAM(PH_XAT); }
    if (IN(PH_G4)) {
        pg8::Gemm g{XO, D, (const bf16*)(ws + WS_WO), M, D, D}; pg8::StaticOrder S; S.init(M, D, G, bx);
        pg8::EpiResid<true> E{args.out, args.out, XB, (float*)(ws + WS_SSQ2), D};
        pg8::gemm_phase<pg8::EpiResid<true>, pg8::StaticOrder, PG8_ALIGN, PG8_SP2>(F.lds + RING_OFF, g, S, E);
        SEAM(PH_G4);
    }
    if (IN(PH_G5)) {
        pg8::Gemm g{XB, D, (const bf16*)(ws + WS_WUP), M, NU, D}; pg8::StaticOrder S; S.init(M, NU, G, bx);
        pg8::EpiScaleBf16<pg8::RsParts> E{U, NU, {(const float*)(ws + WS_SSQ2)}};
        pg8::gemm_phase<pg8::EpiScaleBf16<pg8::RsParts>, pg8::StaticOrder, PG8_ALIGN, PG8_SP2>(F.lds + RING_OFF, g, S, E);
        SEAM(PH_G5);
    }
    if (IN(PH_ACT)) { p8_act(F, args); SEAM(PH_ACT); }
    if (IN(PH_G6)) {
        pg8::Gemm g{U + FF, NU, (const bf16*)(ws + WS_WDN), M, D, FF}; pg8::StaticOrder S; S.init(M, D, G, bx);
        pg8::EpiResid<false> E{args.out, args.out, nullptr, (float*)(ws + WS_SSQ3), D};
        pg8::gemm_phase<pg8::EpiResid<false>, pg8::StaticOrder, PG8_ALIGN, PG8_SP2>(F.lds + RING_OFF, g, S, E);
        SEAM(PH_G6);
    }
    if (IN(PH_FIN)) { p10_final(F, args); }
#undef IN
#undef SEAM
}
extern "C" void kernel_launch(void* const* d_in, const int* in_sizes, int n_in, void* d_out, int out_size, void* d_ws, size_t ws_size, hipStream_t stream) {
    static int grid = 0;
    if (grid == 0) {
        if (n_in != 20 || in_sizes[0] != M * D || out_size != M * D || ws_size < WS_END) { fprintf(stderr, "kernel_launch: shape/workspace mismatch: n_in %d in0 %d out %d ws %zu (need %zu)\n", n_in, n_in > 0 ? in_sizes[0] : -1, out_size, ws_size, (size_t)WS_END); grid = -1; return; }
        int dev = 0, cus = 0, per_cu = 0;
        if (hipGetDevice(&dev) != hipSuccess || hipDeviceGetAttribute(&cus, hipDeviceAttributeMultiprocessorCount, dev) != hipSuccess) { fprintf(stderr, "kernel_launch: device query failed\n"); grid = -1; return; }
        if (hipFuncSetAttribute((const void*)mk_fwd, hipFuncAttributeMaxDynamicSharedMemorySize, LDS_BYTES) != hipSuccess) { fprintf(stderr, "kernel_launch: hipFuncSetAttribute failed\n"); grid = -1; return; }
        if (hipOccupancyMaxActiveBlocksPerMultiprocessor(&per_cu, (const void*)mk_fwd, NWAVES * 64, LDS_BYTES) != hipSuccess || per_cu < 1) { fprintf(stderr, "kernel_launch: occupancy query reports %d workgroups per CU\n", per_cu); (void)hipGetLastError(); grid = -1; return; }
        grid = cus;
    }
    if (grid < 0) return;
    (void)hipMemsetAsync((char*)d_ws + WS_CTL, 0, CTL_ZERO_BYTES, stream);
    Args a{};
    for (int i = 0; i < 20; ++i) a.in[i] = (const float*)d_in[i];
    a.out = (float*)d_out; a.ws = (unsigned char*)d_ws;
    unsigned char* ws = (unsigned char*)d_ws;
    auto launch = [&](int lo, int hi, int li) { a.ph_lo = lo; a.ph_hi = hi; a.li = li; hipLaunchKernelGGL(mk_fwd, dim3(grid), dim3(NWAVES * 64), LDS_BYTES, stream, a); };
    launch(PH_PRO, PH_N, 0);
}
```

```cpp
#include <hip/hip_runtime.h>
#include <cstdio>
#include <cstdint>
namespace pg8 {
#define PG8_LAS __attribute__((address_space(3)))
typedef unsigned short bf16_t;
typedef short bf16x8 __attribute__((ext_vector_type(8)));
typedef float f32x4 __attribute__((ext_vector_type(4)));
typedef unsigned u32x4 __attribute__((ext_vector_type(4)));
constexpr int BM = 256, BK = 64, HALF = 128, HTB = HALF * BK * 2  , STAGE_BYTES = 8 * HTB, NXCD = 8, WGM = 8;

__host__ __device__ __forceinline__ int lds_byte(int r, int c) { const int st = (r >> 4) * 2 + (c >> 5), rr = r & 15, cc = c & 31, ob = rr * 64 + cc * 2; return st * 1024 + (ob ^ (((ob >> 9) & 1) << 5)); }
__host__ __device__ __forceinline__ void stage_rc(int b, int& R, int& C) { const int st = b / 1024, sb = b % 1024, swz = sb ^ (((sb >> 9) & 1) << 5); R = (st >> 1) * 16 + swz / 64; C = (st & 1) * 32 + (swz % 64) / 2; }
__host__ __device__ __forceinline__ int perm32(int rho) { const int n = rho >> 4, i = rho & 15; return 8 * (i >> 2) + 4 * n + (i & 3); }

struct Unit { int pm, pn; };
struct Gemm { const bf16_t* A; int lda; const bf16_t* Bt; int M, N, K; };

struct StaticOrder {
    int nM, nN, nwg, G, c;
    __host__ __device__ void init(int M, int N, int G_, int c_) { nM = M / BM; nN = N / BM; nwg = nM * nN; G = G_; c = c_; }
    __host__ __device__ bool next(int i, Unit& u) const {
        const long L = (long)i * G + c; if (L >= nwg) return false;
        int wgid = (int)L; { const int q = nwg / NXCD, r = nwg % NXCD, xcd = wgid % NXCD, off = wgid / NXCD; wgid = (xcd < r ? xcd * (q + 1) : r * (q + 1) + (xcd - r) * q) + off; }
        const int nig = WGM * nN, gid = wgid / nig, fm = gid * WGM, gsz = (nM - fm) < WGM ? (nM - fm) : WGM;
        u.pm = fm + ((wgid % nig) % gsz); u.pn = (wgid % nig) / gsz; return true;
    }
    __device__ __forceinline__ void a_ready(const Unit&) const {}
    __device__ __forceinline__ void done(const Unit&) const {}
};

__device__ __forceinline__ unsigned cvt_pk_bf16(float lo, float hi) { unsigned r; asm volatile("v_cvt_pk_bf16_f32 %0, %1, %2" : "=v"(r) : "v"(lo), "v"(hi)); return r; }
typedef float f32x2 __attribute__((ext_vector_type(2)));
constexpr float RMS_EPS = 1e-6f;
struct RsOne   { __device__ __forceinline__ float get(int) const { return 1.0f; } };
struct RsArr   { const float* r; __device__ __forceinline__ float get(int row) const { return r[row]; } };
struct RsParts { const float* p;
    __device__ __forceinline__ float get(int row) const { const f32x4* q = (const f32x4*)(p + (size_t)row * 16); const f32x4 a = q[0], b = q[1], c = q[2], d = q[3];
        const float s = ((a[0] + a[1]) + (a[2] + a[3])) + ((b[0] + b[1]) + (b[2] + b[3])) + ((c[0] + c[1]) + (c[2] + c[3])) + ((d[0] + d[1]) + (d[2] + d[3]));
        return 1.0f / sqrtf(s * (1.0f / 1024.0f) + RMS_EPS); } };
template <class RS> struct EpiScaleBf16 {
    static constexpr bool PERM = true, AFTER_DRAIN = false;
    bf16_t* O; int ldc; RS rs;
    __device__ __forceinline__ void operator()(const f32x4 (&acc)[2][2][4][2], const Unit& u, int wr, int wc, int fr, int fq) const {
        const int row0 = u.pm * BM + wr * 64 + fr, col0 = u.pn * BM + wc * 32 + 8 * fq;
#pragma unroll
        for (int ai = 0; ai < 2; ++ai)
#pragma unroll
            for (int m = 0; m < 4; ++m) { const int row = row0 + ai * HALF + m * 16; const float sc = rs.get(row); bf16_t* rowp = O + (size_t)row * ldc + col0;
#pragma unroll
                for (int bj = 0; bj < 2; ++bj) { const f32x4 v0 = acc[ai][bj][m][0] * sc, v1 = acc[ai][bj][m][1] * sc;
                    u32x4 w; w.x = cvt_pk_bf16(v0[0], v0[1]); w.y = cvt_pk_bf16(v0[2], v0[3]); w.z = cvt_pk_bf16(v1[0], v1[1]); w.w = cvt_pk_bf16(v1[2], v1[3]);
                    *(u32x4*)(rowp + bj * HALF) = w; } }
    }
};
template <bool WRITE_BF16> struct EpiResid {
    static constexpr bool PERM = false, AFTER_DRAIN = false;
    const float* base; float* out; bf16_t* xb; float* ssq; int ldc;
    __device__ __forceinline__ void operator()(const f32x4 (&acc)[2][2][4][2], const Unit& u, int wr, int wc, int fr, int fq) const {
        typedef unsigned u32x2v __attribute__((ext_vector_type(2)));
        const int row0 = u.pm * BM + wr * 64 + fr, col0 = u.pn * BM + wc * 32 + 4 * fq;
#pragma unroll
        for (int ai = 0; ai < 2; ++ai)
#pragma unroll
            for (int m = 0; m < 4; ++m) { const int row = row0 + ai * HALF + m * 16; const size_t off = (size_t)row * ldc + col0; float ss = 0.f;
#pragma unroll
                for (int bj = 0; bj < 2; ++bj)
#pragma unroll
                    for (int n = 0; n < 2; ++n) { const size_t o2 = off + bj * HALF + n * 16; const f32x4 o = *(const f32x4*)(base + o2) + acc[ai][bj][m][n];
                        *(f32x4*)(out + o2) = o; ss += (o[0] * o[0] + o[1] * o[1]) + (o[2] * o[2] + o[3] * o[3]);
                        if (WRITE_BF16) { u32x2v w; w.x = cvt_pk_bf16(o[0], o[1]); w.y = cvt_pk_bf16(o[2], o[3]); *(u32x2v*)(xb + o2) = w; } }
                ss += __shfl_xor(ss, 16); ss += __shfl_xor(ss, 32);
                if (fq == 0) ssq[(size_t)row * 16 + u.pn * 4 + wc] = ss;
                asm volatile("" ::: "memory"); }
    }
};
template <class Epi, class Sched, bool ALIGN_EPI = false, bool SP2 = false>
__device__ __forceinline__ void gemm_phase(PG8_LAS unsigned char* lds, const Gemm g, const Sched& S, const Epi& E) {
    const int tid = threadIdx.x, wid = __builtin_amdgcn_readfirstlane(tid >> 6), lane = tid & 63, wr = wid >> 2, wc = wid & 3, fr = lane & 15, fq = lane >> 4;
    const int K = g.K, nt = K / BK;
    unsigned voffA[2], voffB[2];
#pragma unroll
    for (int i = 0; i < 2; ++i) { int R, C; stage_rc(tid * 16 + i * 8192, R, C); const int Rb = Epi::PERM ? ((R & ~31) + perm32(R & 31)) : R;
        voffA[i] = (unsigned)(R * g.lda + C) * 2u; voffB[i] = (unsigned)(Rb * K + C) * 2u; }
    const size_t kstep = (size_t)(BK * 2);
    const size_t hstepA = (size_t)HALF * g.lda * 2, hstepB = (size_t)HALF * K * 2;
    const size_t tstepA = 2 * hstepA, tstepB = 2 * hstepB;
    const unsigned ldsw = (unsigned)wid * 1024u;
    const int aoff = lds_byte(wr * 64 + fr, fq * 8), boff = lds_byte(wc * 32 + fr, fq * 8);
#define PG8_SA(b, h) (((b) * 2 + (h)) * HTB)
#define PG8_SB(b, h) ((4 + (b) * 2 + (h)) * HTB)
#define PG8_STAGE(bufoff, gbase, voff) do { _Pragma("unroll") for (int _i = 0; _i < 2; ++_i) \
        __builtin_amdgcn_global_load_lds((const unsigned*)((const char*)(gbase) + (voff)[_i]), (PG8_LAS unsigned*)(lds + (bufoff) + ldsw + _i * 8192), 16, 0, 0); } while (0)
#define PG8_LDA(dst, b, h) do { _Pragma("unroll") for (int m = 0; m < 4; ++m) _Pragma("unroll") for (int k = 0; k < 2; ++k) dst[m][k] = *(const PG8_LAS bf16x8*)(lds + PG8_SA(b, h) + aoff + m * 2048 + k * 1024); } while (0)
#define PG8_LDB(dst, b, h) do { _Pragma("unroll") for (int n = 0; n < 2; ++n) _Pragma("unroll") for (int k = 0; k < 2; ++k) dst[n][k] = *(const PG8_LAS bf16x8*)(lds + PG8_SB(b, h) + boff + n * 2048 + k * 1024); } while (0)
#define PG8_MMA(ai, bj, At, Bt) do { __builtin_amdgcn_s_setprio(1); _Pragma("unroll") for (int m = 0; m < 4; ++m) _Pragma("unroll") for (int n = 0; n < 2; ++n) _Pragma("unroll") for (int k = 0; k < 2; ++k) \
        acc[ai][bj][m][n] = __builtin_amdgcn_mfma_f32_16x16x32_bf16(Bt[n][k], At[m][k], acc[ai][bj][m][n], 0, 0, 0); __builtin_amdgcn_s_setprio(0); } while (0)
#define PG8_WAIT_V(n) asm volatile("s_waitcnt vmcnt(" #n ")" ::: "memory")
#define PG8_WAIT_L(n) asm volatile("s_waitcnt lgkmcnt(" #n ")" ::: "memory")
#define PG8_BAR __builtin_amdgcn_s_barrier()
#define PG8_SCHED __builtin_amdgcn_sched_barrier(0)
    Unit cur, nxt; int ui = 0;
    if (!S.next(0, cur)) return;
    f32x4 acc[2][2][4][2];
#pragma unroll
    for (int a = 0; a < 2; ++a)
#pragma unroll
        for (int b = 0; b < 2; ++b)
#pragma unroll
            for (int m = 0; m < 4; ++m)
#pragma unroll
                for (int n = 0; n < 2; ++n) acc[a][b][m][n] = (f32x4){0.f, 0.f, 0.f, 0.f};
    bf16x8 At[4][2], B0[2][2], B1[2][2];
    const char* cA = (const char*)g.A + (size_t)cur.pm * tstepA; const char* cB = (const char*)g.Bt + (size_t)cur.pn * tstepB;
    S.a_ready(cur);
    if constexpr (SP2) {
        PG8_STAGE(PG8_SB(0, 0), cB, voffB); PG8_STAGE(PG8_SB(0, 1), cB + hstepB, voffB); PG8_STAGE(PG8_SA(0, 0), cA, voffA); PG8_STAGE(PG8_SA(0, 1), cA + hstepA, voffA);
        if (wr == 1) PG8_BAR;
        PG8_WAIT_V(2); PG8_BAR;
        PG8_STAGE(PG8_SB(1, 0), cB + kstep, voffB); PG8_STAGE(PG8_SA(1, 0), cA + kstep, voffA); PG8_STAGE(PG8_SB(1, 1), cB + hstepB + kstep, voffB);
        PG8_WAIT_V(6); PG8_BAR;
    } else {
        PG8_STAGE(PG8_SB(0, 0), cB, voffB); PG8_STAGE(PG8_SA(0, 0), cA, voffA); PG8_STAGE(PG8_SB(0, 1), cB + hstepB, voffB); PG8_STAGE(PG8_SA(0, 1), cA + hstepA, voffA);
        if (wr == 1) PG8_BAR;
        PG8_WAIT_V(4); PG8_BAR;
        PG8_STAGE(PG8_SB(1, 0), cB + kstep, voffB); PG8_STAGE(PG8_SA(1, 0), cA + kstep, voffA); PG8_STAGE(PG8_SB(1, 1), cB + hstepB + kstep, voffB);
        PG8_WAIT_V(6); PG8_BAR;
    }
    for (;;) {
        const bool has_next = S.next(ui + 1, nxt);
        const char* nA = has_next ? (const char*)g.A + (size_t)nxt.pm * tstepA : cA; const char* nB = has_next ? (const char*)g.Bt + (size_t)nxt.pn * tstepB : cB;
        for (int t = 0; t < nt; t += 2) {
            const bool last = (t == nt - 2);
            const char* a1 = cA + (size_t)(t + 1) * kstep;
            const char* a2 = last ? nA : cA + (size_t)(t + 2) * kstep; const char* b2 = last ? nB : cB + (size_t)(t + 2) * kstep;
            const char* a3 = a2 + kstep; const char* b3 = b2 + kstep;
            if (last && has_next) S.a_ready(nxt);
            if constexpr (SP2) {
            PG8_LDB(B0, 0, 0); PG8_LDB(B1, 0, 1); PG8_SCHED; PG8_LDA(At, 0, 0); PG8_STAGE(PG8_SA(1, 1), a1 + hstepA, voffA);
            PG8_WAIT_V(8); PG8_WAIT_L(0); PG8_BAR; PG8_MMA(0, 0, At, B0); PG8_MMA(0, 1, At, B1); PG8_BAR; PG8_SCHED;
            PG8_LDA(At, 0, 1); PG8_STAGE(PG8_SB(0, 0), b2, voffB); PG8_STAGE(PG8_SB(0, 1), b2 + hstepB, voffB); PG8_STAGE(PG8_SA(0, 0), a2, voffA);
            PG8_WAIT_V(8); PG8_WAIT_L(0); PG8_BAR; PG8_MMA(1, 0, At, B0); PG8_MMA(1, 1, At, B1); PG8_BAR; PG8_SCHED;
            PG8_LDB(B0, 1, 0); PG8_LDB(B1, 1, 1); PG8_SCHED; PG8_LDA(At, 1, 0); PG8_STAGE(PG8_SA(0, 1), a2 + hstepA, voffA);
            PG8_WAIT_V(8); PG8_WAIT_L(0); PG8_BAR; PG8_MMA(0, 0, At, B0); PG8_MMA(0, 1, At, B1); PG8_BAR; PG8_SCHED;
            PG8_LDA(At, 1, 1); PG8_STAGE(PG8_SB(1, 0), b3, voffB); PG8_STAGE(PG8_SB(1, 1), b3 + hstepB, voffB); PG8_STAGE(PG8_SA(1, 0), a3, voffA);
            PG8_WAIT_V(8); PG8_WAIT_L(0); PG8_BAR; PG8_MMA(1, 0, At, B0); PG8_MMA(1, 1, At, B1); PG8_BAR; PG8_SCHED;
            } else {
            PG8_LDB(B0, 0, 0); PG8_SCHED; PG8_LDA(At, 0, 0); PG8_STAGE(PG8_SA(1, 1), a1 + hstepA, voffA);
            PG8_WAIT_L(8); PG8_BAR; PG8_WAIT_L(0); PG8_MMA(0, 0, At, B0); PG8_BAR; PG8_SCHED;
            PG8_LDB(B1, 0, 1); PG8_STAGE(PG8_SB(0, 0), b2, voffB);
            PG8_BAR; PG8_WAIT_L(0); PG8_MMA(0, 1, At, B1); PG8_BAR;
            PG8_LDA(At, 0, 1); PG8_STAGE(PG8_SA(0, 0), a2, voffA);
            PG8_BAR; PG8_WAIT_L(0); PG8_MMA(1, 0, At, B0); PG8_BAR; PG8_SCHED;
            PG8_STAGE(PG8_SB(0, 1), b2 + hstepB, voffB);
            PG8_WAIT_V(6); PG8_BAR; PG8_MMA(1, 1, At, B1); PG8_BAR;
            PG8_LDB(B0, 1, 0); PG8_SCHED; PG8_LDA(At, 1, 0); PG8_STAGE(PG8_SA(0, 1), a2 + hstepA, voffA);
            PG8_WAIT_L(8); PG8_BAR; PG8_WAIT_L(0); PG8_MMA(0, 0, At, B0); PG8_BAR; PG8_SCHED;
            PG8_LDB(B1, 1, 1); PG8_STAGE(PG8_SB(1, 0), b3, voffB);
            PG8_BAR; PG8_WAIT_L(0); PG8_MMA(0, 1, At, B1); PG8_BAR;
            PG8_LDA(At, 1, 1); PG8_STAGE(PG8_SA(1, 0), a3, voffA);
            PG8_BAR; PG8_WAIT_L(0); PG8_MMA(1, 0, At, B0); PG8_BAR; PG8_SCHED;
            PG8_STAGE(PG8_SB(1, 1), b3 + hstepB, voffB);
            PG8_WAIT_V(6); PG8_BAR; PG8_MMA(1, 1, At, B1); PG8_BAR;
            }
        }
        if constexpr (ALIGN_EPI) { if (wr == 0) PG8_BAR; }
        if constexpr (!Epi::AFTER_DRAIN) { E(acc, cur, wr, wc, fr, fq); S.done(cur); }
        if (!has_next) break;
#pragma unroll
        for (int a = 0; a < 2; ++a)
#pragma unroll
            for (int b = 0; b < 2; ++b)
#pragma unroll
                for (int m = 0; m < 4; ++m)
#pragma unroll
                    for (int n = 0; n < 2; ++n) acc[a][b][m][n] = (f32x4){0.f, 0.f, 0.f, 0.f};
        cur = nxt; cA = nA; cB = nB; ++ui;
        if constexpr (ALIGN_EPI) { if (wr == 1) PG8_BAR; }
    }
    PG8_WAIT_V(0);
    if constexpr (!ALIGN_EPI) { if (wr == 0) PG8_BAR; }
    PG8_BAR;
    if constexpr (Epi::AFTER_DRAIN) { E.fused(acc, cur, wr, wc, fr, fq, lds, wid, lane); S.done(cur); }
#undef PG8_SA
#undef PG8_SB
#undef PG8_STAGE
#undef PG8_LDA
#undef PG8_LDB
#undef PG8_MMA
#undef PG8_WAIT_V
#undef PG8_WAIT_L
#undef PG8_BAR
#undef PG8_SCHED
}
}
#define GAS __attribute__((address_space(1)))
#define LAS __attribute__((address_space(3)))
typedef unsigned short bf16;
typedef unsigned v4u __attribute__((ext_vector_type(4)));
typedef float f32x4 __attribute__((ext_vector_type(4)));
typedef short bf16x8 __attribute__((ext_vector_type(8)));
typedef GAS unsigned gu32;
typedef GAS unsigned long long gu64;
#define RLX_AGENT __ATOMIC_RELAXED, __HIP_MEMORY_SCOPE_AGENT
#define LDS_WAIT() asm volatile("s_waitcnt lgkmcnt(0)" ::: "memory")
#define VM_WAIT() asm volatile("s_waitcnt vmcnt(0)" ::: "memory")
__device__ __forceinline__ unsigned long long rt() { return __builtin_amdgcn_s_memrealtime(); }
__device__ __forceinline__ unsigned f2bf(float f) { unsigned u = __builtin_bit_cast(unsigned, f); return (u + 0x7fffu + ((u >> 16) & 1u)) >> 16; }
__device__ __forceinline__ unsigned pk2(float lo, float hi) { return f2bf(lo) | (f2bf(hi) << 16); }

#define XB_TMO      128
#define XB_XCNT(j)  (256  + 64 * (j))
#define XB_XSUB(j)  (1280 + 64 * (j))
#define XB_XGEN(j)  (2304 + 64 * (j))
#define XB_TOP      3328
#define XB_TOPGEN   3392
#define XCD_BAR_WORDS 3456
#define XB_SPIN_CAP (1u << 18)

__device__ __forceinline__ unsigned xb_ld(unsigned* p)              { return __hip_atomic_load(p, __ATOMIC_RELAXED, __HIP_MEMORY_SCOPE_AGENT); }
__device__ __forceinline__ unsigned xb_add(unsigned* p, unsigned v) { return __hip_atomic_fetch_add(p, v, __ATOMIC_RELAXED, __HIP_MEMORY_SCOPE_AGENT); }
__device__ __forceinline__ unsigned xb_xcc_id() { return (unsigned)__builtin_amdgcn_s_getreg((3 << 11) | 20) & 0xFu; }
#define XB_SPIN(cond, bar) do { unsigned _sp = 0; while (cond) { __builtin_amdgcn_s_sleep(1); \
    if ((++_sp & 255u) == 0u) { if (xb_ld(&(bar)[XB_TMO])) break; if (_sp > XB_SPIN_CAP) { atomicAdd(&(bar)[XB_TMO], 1u); break; } } } } while (0)

struct XcdBarrier {
    unsigned* bar; unsigned x;
    volatile LAS unsigned* st;
};

__device__ __forceinline__ XcdBarrier xcd_barrier_post(unsigned* bar, volatile LAS unsigned* st) {
    XcdBarrier b; b.bar = bar; b.x = xb_xcc_id(); b.st = st;
    if (threadIdx.x == 0) (void)xb_add(&bar[XB_XCNT(b.x)], 1u);
    return b;
}
__device__ __forceinline__ void xcd_barrier_complete(unsigned* bar, unsigned x, unsigned& nloc, unsigned& nx) {
    const unsigned G = gridDim.x * gridDim.y * gridDim.z;
    unsigned sum, cnt, mine, sp = 0u;
    for (;;) {
        sum = 0u; cnt = 0u; mine = 0u;
#pragma unroll
        for (unsigned j = 0; j < 16; ++j) { const unsigned c = xb_ld(&bar[XB_XCNT(j)]); sum += c; cnt += (c > 0u) ? 1u : 0u; mine = (j == x) ? c : mine; }
        if (sum == G) break;
        __builtin_amdgcn_s_sleep(1);
        if ((++sp & 255u) == 0u) { if (xb_ld(&bar[XB_TMO])) break; if (sp > XB_SPIN_CAP) { atomicAdd(&bar[XB_TMO], 1u); break; } }
    }
    nloc = mine > 0u ? mine : 1u; nx = cnt > 0u ? cnt : 1u;
}

__device__ __forceinline__ void xcd_barrier(const XcdBarrier& b) {
    asm volatile("s_waitcnt vmcnt(0)" ::: "memory");
    __syncthreads();
    if (threadIdx.x == 0) {
        unsigned* bar = b.bar;
        __builtin_amdgcn_s_waitcnt(0);
        unsigned nloc = b.st[0], nx = b.st[1];
        if (nloc == 0u) { xcd_barrier_complete(bar, b.x, nloc, nx); b.st[0] = nloc; b.st[1] = nx; }
        const unsigned old = xb_add(&bar[XB_XSUB(b.x)], 1u);
        const unsigned gen = old / nloc;
        if (old + 1u == (gen + 1u) * nloc) {
            __builtin_amdgcn_fence(__ATOMIC_RELEASE, "agent");
            asm volatile("s_waitcnt vmcnt(0)" ::: "memory");
            const unsigned og = xb_add(&bar[XB_TOP], 1u);
            const unsigned tg = og / nx;
            if (og + 1u == (tg + 1u) * nx) xb_add(&bar[XB_TOPGEN], 1u);
            else XB_SPIN(xb_ld(&bar[XB_TOPGEN]) == tg, bar);
            __builtin_amdgcn_fence(__ATOMIC_ACQUIRE, "agent");
            xb_add(&bar[XB_XGEN(b.x)], 1u);
            asm volatile("s_waitcnt vmcnt(0)" ::: "memory");
        } else {
            XB_SPIN(xb_ld(&bar[XB_XGEN(b.x)]) == gen, bar);
            __builtin_amdgcn_fence(__ATOMIC_ACQUIRE, "agent");
            asm volatile("s_waitcnt vmcnt(0)" ::: "memory");
        }
    }
    __syncthreads();
}
constexpr int NWAVES = 8;
constexpr int BATCH = 16, SEQ = 2048, D = 1024, M = BATCH * SEQ;
constexpr int NP = 2816;
constexpr int IN_COLS = 2824;
constexpr int O_AK = 512, O_AV = 640, O_MQ = 768, O_MK = 1280, O_MV = 1792, O_MO = 2304, O_G = 2816;
constexpr int MEMLEN = 256, MMEM = BATCH * MEMLEN;
constexpr int FF = 2816, NU = 2 * FF;
constexpr float EPS = 1e-6f;
constexpr size_t MiB = 1u << 20;
constexpr size_t WS_CTL = 0, CTL_ZERO_BYTES = 1 * MiB;
constexpr size_t WS_RSTD0 = 1 * MiB;
constexpr size_t WS_RSTDM = WS_RSTD0 + 128 * 1024;
constexpr size_t WS_GPRE = 2 * MiB;
constexpr size_t WS_SSQ1 = 4 * MiB, WS_SSQ2 = 6 * MiB, WS_SSQ3 = 8 * MiB;
constexpr size_t WS_WIN = 16 * MiB, WS_WKV = 22 * MiB, WS_WOUT = 26 * MiB, WS_WQ = 28 * MiB, WS_WO = 30 * MiB, WS_WUP = 32 * MiB, WS_WDN = 43 * MiB;
constexpr size_t WS_MEMB = 49 * MiB;
constexpr size_t WS_KVM = 57 * MiB;
constexpr size_t WS_XB = 80 * MiB;
constexpr size_t WS_P = 144 * MiB;
constexpr size_t WS_MIX = 320 * MiB;
constexpr size_t WS_QX = 384 * MiB;
constexpr size_t WS_XO = 448 * MiB;
constexpr size_t WS_U = 144 * MiB;
constexpr size_t WS_END = 512 * MiB;
static_assert(WS_WDN + (size_t)D * FF * 2 <= WS_MEMB && WS_KVM + (size_t)MMEM * 2048 * 2 <= WS_XB && WS_XB + (size_t)M * D * 2 == WS_P && WS_P + (size_t)M * NP * 2 == WS_MIX && WS_U + (size_t)M * NU * 2 <= WS_END, "d_ws map");
constexpr int CW_TMO = 0, CW_CODE = 1;
constexpr int CW_BAR = 4096;
constexpr int N_BAR_REGIONS = 16;
static_assert((CW_BAR + N_BAR_REGIONS * XCD_BAR_WORDS) * 4 <= (int)CTL_ZERO_BYTES, "CTL words inside the memset region");
constexpr int RING_OFF = 0, RING_BYTES = 131072;
constexpr int LDS_BYTES = 163840;
constexpr int LDSCTL_OFF = LDS_BYTES - 512, MISC_OFF = LDSCTL_OFF + 320;
constexpr int PH_LDS = LDSCTL_OFF;

struct Args { const float* in[20]; float* out; unsigned char* ws; int ph_lo, ph_hi, li, pad; };

struct Frame {
    LAS unsigned char* lds; volatile LAS unsigned* MISC; gu32* ctl;
    int tid, lane, wave, vcu, G;
};
__device__ __forceinline__ float wave_sum(float v) {
#pragma unroll
    for (int o = 1; o < 64; o <<= 1) v += __shfl_xor(v, o);
    return v;
}
__device__ __forceinline__ float bf2f(unsigned short b) { return __builtin_bit_cast(float, (unsigned)b << 16); }
__device__ __forceinline__ float bflo(unsigned w) { return __builtin_bit_cast(float, w << 16); }
__device__ __forceinline__ float bfhi(unsigned w) { return __builtin_bit_cast(float, w & 0xffff0000u); }

__device__ __forceinline__ void p0_transpose_item(const float* W, int K, int ldw, int src_col0, const float* g, bf16* WT, int dst_row0, LAS float* scr, int kb, int lane) {
    const int k0 = 64 * kb;
#pragma unroll 8
    for (int i = 0; i < 32; ++i) { const int kk = 2 * i + (lane >> 5); float w = W[(size_t)(k0 + kk) * ldw + src_col0 + (lane & 31)]; if (g) w *= g[k0 + kk]; scr[kk * 33 + (lane & 31)] = w; }
    LDS_WAIT(); asm volatile("" ::: "memory");
    const int c = lane & 7;
#pragma unroll
    for (int j = 0; j < 4; ++j) { const int n = (lane >> 3) + 8 * j; const LAS float* s = scr + (8 * c) * 33 + n;
        v4u o; o.x = pk2(s[0 * 33], s[1 * 33]); o.y = pk2(s[2 * 33], s[3 * 33]); o.z = pk2(s[4 * 33], s[5 * 33]); o.w = pk2(s[6 * 33], s[7 * 33]);
        *(GAS v4u*)(WT + (size_t)(dst_row0 + n) * K + k0 + 8 * c) = o; }
    LDS_WAIT(); asm volatile("" ::: "memory");
}
__device__ __forceinline__ float row_to_bf16(const float* xrow, bf16* orow, int lane, f32x4 (&v)[4]) {
    const GAS f32x4* xr = (const GAS f32x4*)xrow + lane; float s = 0.f;
#pragma unroll
    for (int j = 0; j < 4; ++j) { v[j] = xr[64 * j]; s += (v[j][0] * v[j][0] + v[j][1] * v[j][1]) + (v[j][2] * v[j][2] + v[j][3] * v[j][3]); }
    GAS unsigned long long* o8 = (GAS unsigned long long*)orow + lane;
#pragma unroll
    for (int j = 0; j < 4; ++j) o8[64 * j] = (unsigned long long)pk2(v[j][0], v[j][1]) | ((unsigned long long)pk2(v[j][2], v[j][3]) << 32);
    return wave_sum(s);
}
__device__ __forceinline__ void p2_mix_naive(Frame& F, const Args& a) {
    const bf16* P = (const bf16*)(a.ws + WS_P); bf16* MIX = (bf16*)(a.ws + WS_MIX);
    const int NSEQ = BATCH * 4;
    if ((int)blockIdx.x < NSEQ && F.G > NSEQ) {
        const float* gpre = (const float*)(a.ws + WS_GPRE); const float* bg = a.in[4]; const float* cw = a.in[5]; const float* cb = a.in[6];
        const int b = blockIdx.x >> 2, h = blockIdx.x & 3, j = F.tid & 127; const bool act = F.tid < 128;
        LAS float* qs = (LAS float*)F.lds; LAS float* ks = qs + 128; LAS float* ns = ks + 128;
        float C[128];
#pragma unroll
        for (int d = 0; d < 128; ++d) C[d] = 0.f;
        if (act) ns[j] = 0.f;
        float mprev = 0.f;
        const int cq = h * 128 + j, ck = 512 + h * 128 + j;
        float wq[4], wk[4];
#pragma unroll
        for (int i = 0; i < 4; ++i) { wq[i] = cw[i * 1024 + cq]; wk[i] = cw[i * 1024 + ck]; }
        const float bq = cb[cq], bk = cb[ck], bi = bg[h], bf = bg[4 + h];
        __syncthreads();
        for (int t = 0; t < SEQ; ++t) {
            const size_t row = (size_t)b * SEQ + t;
            float aq = bq, ak = bk;
#pragma unroll
            for (int i = 0; i < 4; ++i) { const int tt = t - 3 + i; if (tt >= 0) { const bf16* pr = P + ((size_t)b * SEQ + tt) * NP + O_MQ; aq += wq[i] * bf2f(pr[cq]); ak += wk[i] * bf2f(pr[ck]); } }
            const float qv = aq / (1.0f + expf(-aq)) * 0.08838834764831845f, kv = ak / (1.0f + expf(-ak));
            const bf16* pr = P + row * NP;
            const float vv = bf2f(pr[O_MV + h * 128 + j]), ov = bf2f(pr[O_MO + h * 128 + j]);
            const float ipre = gpre[row * 8 + h] + bi, fpre = gpre[row * 8 + 4 + h] + bf;
            const float lf = fminf(fpre, 0.f) - log1pf(expf(-fabsf(fpre)));
            const float mt = fmaxf(lf + mprev, ipre);
            const float fg = expf(lf + mprev - mt), ig = expf(ipre - mt);
            __syncthreads();
            if (act) { qs[j] = qv; ks[j] = kv; ns[j] = fg * ns[j] + ig * kv; }
            __syncthreads();
            if (act) {
                float num = 0.f, den = 0.f;
#pragma unroll
                for (int d = 0; d < 128; ++d) { C[d] = fg * C[d] + ig * ks[d] * vv; num += qs[d] * C[d]; den += qs[d] * ns[d]; }
                const float hh = num / fmaxf(fabsf(den), expf(-mt));
                MIX[row * D + 512 + h * 128 + j] = (bf16)f2bf(hh / (1.0f + expf(-ov)));
            }
            mprev = mt;
        }
    } else {
        const float* sinks = a.in[7];
        const int nb = F.G > NSEQ ? F.G - NSEQ : F.G, b0 = F.G > NSEQ ? (int)blockIdx.x - NSEQ : (int)blockIdx.x;
        for (int idx = b0 * (NWAVES * 64) + F.tid; idx < M * 8; idx += nb * NWAVES * 64) {
            const int h = idx & 7, row = idx >> 3, b = row / SEQ, t = row % SEQ, hk = h >> 2;
            const float slope = exp2f(-(float)(h + 1));
            const bf16* q = P + (size_t)row * NP + h * 64;
            float qr[64];
#pragma unroll
            for (int d = 0; d < 64; ++d) qr[d] = bf2f(q[d]);
            float m = sinks[h], l = 1.0f;
            float o[64];
#pragma unroll
            for (int d = 0; d < 64; ++d) o[d] = 0.f;
            const int s_lo = (t - 127 > 0) ? t - 127 : 0;
            for (int s = s_lo; s <= t; ++s) {
                const bf16* kp = P + (size_t)(b * SEQ + s) * NP + O_AK + hk * 64;
                const bf16* vp = P + (size_t)(b * SEQ + s) * NP + O_AV + hk * 64;
                float sc = 0.f;
#pragma unroll
                for (int d = 0; d < 64; ++d) sc += qr[d] * bf2f(kp[d]);
                sc = sc * 0.125f - slope * (float)(t - s);
                const float mn = fmaxf(m, sc);
                const float f = expf(m - mn), e = expf(sc - mn);
                l = l * f + e;
#pragma unroll
                for (int d = 0; d < 64; ++d) o[d] = o[d] * f + e * bf2f(vp[d]);
                m = mn;
            }
            const float inv = 1.0f / l;
            bf16* op = MIX + (size_t)row * D + h * 64;
#pragma unroll
            for (int d = 0; d < 64; ++d) op[d] = (bf16)f2bf(o[d] * inv);
        }
    }
}
__device__ __forceinline__ void p5_xattn_naive(Frame& F, const Args& a) {
    const bf16* QX = (const bf16*)(a.ws + WS_QX); const bf16* KVM = (const bf16*)(a.ws + WS_KVM); bf16* XO = (bf16*)(a.ws + WS_XO); const float* ssq1 = (const float*)(a.ws + WS_SSQ1);
    const int half = F.tid >> 8, t = F.tid & 255;
    LAS float* q = (LAS float*)F.lds + half * 1536; LAS float* av = q + 1024; LAS float* red = av + 256;
    for (int row0 = 2 * (int)blockIdx.x; row0 < M; row0 += 2 * F.G) {
        const int row = row0 + half, b = row / SEQ;
        float ss = 0.f;
        for (int i = 0; i < 16; ++i) ss += ssq1[(size_t)row * 16 + i];
        const float rstd = 1.0f / sqrtf(ss * (1.0f / 1024.0f) + EPS);
        __syncthreads();
        for (int i = t; i < 1024; i += 256) q[i] = bf2f(QX[(size_t)row * 1024 + i]) * rstd;
        __syncthreads();
        for (int h = 0; h < 4; ++h) {
            const bf16* kp = KVM + (size_t)(b * MEMLEN + t) * 2048 + h * 256;
            float s = 0.f;
            for (int d = 0; d < 256; ++d) s += q[h * 256 + d] * bf2f(kp[d]);
            s *= 0.0625f;
            float mx = s;
            for (int o = 32; o > 0; o >>= 1) mx = fmaxf(mx, __shfl_xor(mx, o));
            if ((t & 63) == 0) red[t >> 6] = mx;
            __syncthreads();
            mx = fmaxf(fmaxf(red[0], red[1]), fmaxf(red[2], red[3]));
            const float e = expf(s - mx);
            float sm = e;
            for (int o = 32; o > 0; o >>= 1) sm += __shfl_xor(sm, o);
            if ((t & 63) == 0) red[4 + (t >> 6)] = sm;
            av[t] = e;
            __syncthreads();
            sm = red[4] + red[5] + red[6] + red[7];
            float o = 0.f;
            for (int m2 = 0; m2 < 256; ++m2) o += av[m2] * bf2f(KVM[(size_t)(b * MEMLEN + m2) * 2048 + 1024 + h * 256 + t]);
            XO[(size_t)row * 1024 + h * 256 + t] = (bf16)f2bf(o / sm);
            __syncthreads();
        }
    }
}
typedef float f32x16 __attribute__((ext_vector_type(16)));
typedef short s16x4 __attribute__((ext_vector_type(4)));
__device__ __forceinline__ int crow(int r, int hi) { return (r & 3) + 8 * (r >> 2) + 4 * hi; }
__device__ __forceinline__ unsigned cvtpk(float lo, float hi) { typedef float f2 __attribute__((ext_vector_type(2))); typedef __bf16 b2 __attribute__((ext_vector_type(2))); f2 v = {lo, hi}; b2 b = __builtin_convertvector(v, b2); return __builtin_bit_cast(unsigned, b); }
__device__ __forceinline__ s16x4 ldtr(const LAS unsigned char* p) { typedef short v4i16 __attribute__((ext_vector_type(4))); return __builtin_bit_cast(s16x4, __builtin_amdgcn_ds_read_tr16_b64_v4i16((LAS v4i16*)p)); }
__device__ __forceinline__ bf16x8 pack8(const f32x16& p, int b) { v4u w; w.x = cvtpk(p[b], p[b + 1]); w.y = cvtpk(p[b + 2], p[b + 3]); w.z = cvtpk(p[b + 4], p[b + 5]); w.w = cvtpk(p[b + 6], p[b + 7]); return __builtin_bit_cast(bf16x8, w); }
#define GLDS16(gptr, ldsptr) __builtin_amdgcn_global_load_lds((const unsigned*)(gptr), (LAS unsigned*)(ldsptr), 16, 0, 0)

__device__ __forceinline__ void xattn_unit(Frame& F, int b, int xh, int qb, const bf16* QX, const float* ssq1, const bf16* KVM, bf16* XO) {
    const int lane = F.lane, w = F.wave, r32 = lane & 31, hi = lane >> 5;
    const size_t row = (size_t)b * SEQ + qb * 256 + w * 32 + r32;
    const bf16* Kg = KVM + (size_t)b * MEMLEN * 2048 + xh * 256;
    { const bf16* kp = Kg + (size_t)(2 * w + (lane >> 5)) * 2048 + (lane & 31) * 8;
#pragma unroll
      for (int i = 0; i < 16; ++i) GLDS16(kp + (size_t)i * 16 * 2048, F.lds + (w + 8 * i) * 1040); }
    const bf16* qp = QX + row * D + xh * 256 + hi * 8;
    bf16x8 qa[2], qc[2];
#pragma unroll
    for (int j = 0; j < 2; ++j) qa[j] = *(const bf16x8*)(qp + j * 16);
    const pg8::RsParts rs{ssq1};
    const float sc2 = rs.get((int)row) * (0.0625f * 1.4426950408889634f);
    asm volatile("s_waitcnt vmcnt(0)" ::: "memory"); __syncthreads();
    const LAS unsigned char* kbase = F.lds + (r32 >> 1) * 1040 + (r32 & 1) * 512 + hi * 16;
    f32x16 S[8];
#pragma unroll
    for (int kb = 0; kb < 8; ++kb) S[kb] = (f32x16){0.f, 0.f, 0.f, 0.f, 0.f, 0.f, 0.f, 0.f, 0.f, 0.f, 0.f, 0.f, 0.f, 0.f, 0.f, 0.f};
#define XQK(QF, G) do { _Pragma("unroll") for (int j = 0; j < 2; ++j) _Pragma("unroll") for (int kb = 0; kb < 8; ++kb) { \
            const bf16x8 a = *(const LAS bf16x8*)(kbase + kb * 16640 + (2 * (G) + j) * 32); \
            S[kb] = __builtin_amdgcn_mfma_f32_32x32x16_bf16(a, QF[j], S[kb], 0, 0, 0); } } while (0)
#define XQL(QF, G) do { _Pragma("unroll") for (int j = 0; j < 2; ++j) QF[j] = *(const bf16x8*)(qp + (2 * (G) + j) * 16); } while (0)
    XQL(qc, 1); asm volatile("" ::: "memory"); XQK(qa, 0); asm volatile("" ::: "memory");
    XQL(qa, 2); asm volatile("" ::: "memory"); XQK(qc, 1); asm volatile("" ::: "memory");
    XQL(qc, 3); asm volatile("" ::: "memory"); XQK(qa, 2); asm volatile("" ::: "memory");
    XQL(qa, 4); asm volatile("" ::: "memory"); XQK(qc, 3); asm volatile("" ::: "memory");
    XQL(qc, 5); asm volatile("" ::: "memory"); XQK(qa, 4); asm volatile("" ::: "memory");
    XQL(qa, 6); asm volatile("" ::: "memory"); XQK(qc, 5); asm volatile("" ::: "memory");
    XQL(qc, 7); asm volatile("" ::: "memory"); XQK(qa, 6); asm volatile("" ::: "memory");
    XQK(qc, 7);
#undef XQK
#undef XQL
    float mx = S[0][0];
#pragma unroll
    for (int kb = 0; kb < 8; ++kb)
#pragma unroll
        for (int r = 0; r < 16; ++r) mx = fmaxf(mx, S[kb][r]);
    mx = fmaxf(mx, __shfl_xor(mx, 32));
    const float mo = mx * sc2; float l = 0.f;
#pragma unroll
    for (int kb = 0; kb < 8; ++kb)
#pragma unroll
        for (int r = 0; r < 16; ++r) { const float e = __builtin_amdgcn_exp2f(S[kb][r] * sc2 - mo); S[kb][r] = e; l += e; }
    l += __shfl_xor(l, 32);
    const float inv = 1.0f / l;
    bf16x8 pf[8][2];
#pragma unroll
    for (int kb = 0; kb < 8; ++kb) { pf[kb][0] = pack8(S[kb], 0); pf[kb][1] = pack8(S[kb], 8); }
    __syncthreads();
    { const bf16* vp = KVM + (size_t)b * MEMLEN * 2048 + 1024 + xh * 256 + (size_t)(16 * w + (lane >> 2)) * 2048 + 8 * (lane & 3);
#pragma unroll
      for (int i = 0; i < 16; ++i) GLDS16(vp + (size_t)(i & 1) * 128 * 2048 + (i >> 1) * 32, F.lds + (w + 8 * i) * 1024); }
    asm volatile("s_waitcnt vmcnt(0)" ::: "memory"); __syncthreads();
    bf16* orow = XO + row * D + xh * 256 + 4 * hi;
    const int vbase = (4 * hi + ((lane & 15) >> 2)) * 64 + (16 * ((lane >> 4) & 1) + 4 * (lane & 3)) * 2;
#pragma unroll
    for (int db = 0; db < 8; ++db) {
        f32x16 o = (f32x16){0.f, 0.f, 0.f, 0.f, 0.f, 0.f, 0.f, 0.f, 0.f, 0.f, 0.f, 0.f, 0.f, 0.f, 0.f, 0.f};
#pragma unroll
        for (int kb = 0; kb < 8; ++kb)
#pragma unroll
            for (int s = 0; s < 2; ++s) {
                const LAS unsigned char* vp = F.lds + db * 16384 + (32 * kb + 16 * s) * 64 + vbase;
                const s16x4 lo = ldtr(vp), hh = ldtr(vp + 8 * 64);
                const bf16x8 a = (bf16x8){lo[0], lo[1], lo[2], lo[3], hh[0], hh[1], hh[2], hh[3]};
                o = __builtin_amdgcn_mfma_f32_32x32x16_bf16(a, pf[kb][s], o, 0, 0, 0);
            }
#pragma unroll
        for (int g = 0; g < 4; ++g) { typedef unsigned u2 __attribute__((ext_vector_type(2))); u2 wv; wv.x = cvtpk(o[4 * g] * inv, o[4 * g + 1] * inv); wv.y = cvtpk(o[4 * g + 2] * inv, o[4 * g + 3] * inv);
            *(u2*)(orow + 32 * db + 8 * g) = wv; }
    }
    __syncthreads();
}
__device__ __forceinline__ void p5_xattn(Frame& F, const Args& a) {
    const bf16* QX = (const bf16*)(a.ws + WS_QX); const bf16* KVM = (const bf16*)(a.ws + WS_KVM); bf16* XO = (bf16*)(a.ws + WS_XO); const float* ssq1 = (const float*)(a.ws + WS_SSQ1);
    constexpr int NUNIT = BATCH * 4 * (SEQ / 256);
    for (int u = F.vcu; u < NUNIT; u += F.G) { const int qb = u & 7, xh = (u >> 3) & 3, b = u >> 5; xattn_unit(F, b, xh, qb, QX, ssq1, KVM, XO); }
}
__device__ __forceinline__ void p0_prologue(Frame& F, const Args& a) {
    unsigned char* ws = a.ws;
    LAS float* scr = (LAS float*)(F.lds + F.wave * 8448);
    LAS float* wgT = (LAS float*)(F.lds + 73728);
    const int gw = F.vcu * NWAVES + F.wave, NGW = F.G * NWAVES;
    {
        const float* w_in = a.in[3]; const float* gm = a.in[2];
        for (int i = F.tid; i < 8192; i += NWAVES * 64) { const int k = i >> 3, c = i & 7; wgT[c * 1024 + k] = gm[k] * w_in[(size_t)k * IN_COLS + O_G + c]; }
    }
    constexpr int I_IN = 16 * (NP / 32), I_KV = 16 * 64, I_SQ = 16 * 32, I_UP = 16 * (NU / 32), I_DN = (FF / 64) * 32;
    constexpr int NITEMS = I_IN + I_KV + 3 * I_SQ + I_UP + I_DN;
    for (int it = gw; it < NITEMS; it += NGW) {
        int r = it;
        if (r < I_IN) { const int nb = r % (NP / 32), kb = r / (NP / 32); p0_transpose_item(a.in[3], D, IN_COLS, 32 * nb, a.in[2], (bf16*)(ws + WS_WIN), 32 * nb, scr, kb, F.lane); continue; } r -= I_IN;
        if (r < I_KV) { const int nb = r % 64, kb = r / 64; p0_transpose_item(a.in[12], D, 2048, 32 * nb, a.in[10], (bf16*)(ws + WS_WKV), 32 * nb, scr, kb, F.lane); continue; } r -= I_KV;
        if (r < I_SQ) { const int nb = r % 32, kb = r / 32; p0_transpose_item(a.in[8], D, D, 32 * nb, nullptr, (bf16*)(ws + WS_WOUT), 32 * nb, scr, kb, F.lane); continue; } r -= I_SQ;
        if (r < I_SQ) { const int nb = r % 32, kb = r / 32; p0_transpose_item(a.in[11], D, D, 32 * nb, a.in[9], (bf16*)(ws + WS_WQ), 32 * nb, scr, kb, F.lane); continue; } r -= I_SQ;
        if (r < I_SQ) { const int nb = r % 32, kb = r / 32; p0_transpose_item(a.in[13], D, D, 32 * nb, nullptr, (bf16*)(ws + WS_WO), 32 * nb, scr, kb, F.lane); continue; } r -= I_SQ;
        if (r < I_UP) { const int nb = r % (NU / 32), kb = r / (NU / 32); p0_transpose_item(a.in[15], D, NU, 32 * nb, a.in[14], (bf16*)(ws + WS_WUP), 32 * nb, scr, kb, F.lane); continue; } r -= I_UP;
        { const int nb = r % 32, kb = r / 32; p0_transpose_item(a.in[18], FF, D, 32 * nb, nullptr, (bf16*)(ws + WS_WDN), 32 * nb, scr, kb, F.lane); }
    }
    __syncthreads();
    float* rstd0 = (float*)(ws + WS_RSTD0); float* gpre = (float*)(ws + WS_GPRE); bf16* XB = (bf16*)(ws + WS_XB);
    for (int m = gw; m < M; m += NGW) {
        f32x4 v[4];
        const float ssq = row_to_bf16(a.in[0] + (size_t)m * D, XB + (size_t)m * D, F.lane, v);
        const float rstd = 1.0f / sqrtf(ssq * (1.0f / D) + EPS);
        float ga[8];
#pragma unroll
        for (int c = 0; c < 8; ++c) { float s = 0.f;
#pragma unroll
            for (int j = 0; j < 4; ++j) { const f32x4 w = *(const LAS f32x4*)(wgT + c * 1024 + 256 * j + 4 * F.lane); s += (v[j][0] * w[0] + v[j][1] * w[1]) + (v[j][2] * w[2] + v[j][3] * w[3]); }
            ga[c] = wave_sum(s) * rstd; }
        if (F.lane == 0) { rstd0[m] = rstd; *(f32x4*)(gpre + (size_t)m * 8) = (f32x4){ga[0], ga[1], ga[2], ga[3]}; *(f32x4*)(gpre + (size_t)m * 8 + 4) = (f32x4){ga[4], ga[5], ga[6], ga[7]}; }
    }
    float* rstdm = (float*)(ws + WS_RSTDM); bf16* MEMB = (bf16*)(ws + WS_MEMB);
    for (int m = gw; m < MMEM; m += NGW) {
        f32x4 v[4];
        const float ssq = row_to_bf16(a.in[1] + (size_t)m * D, MEMB + (size_t)m * D, F.lane, v);
        if (F.lane == 0) rstdm[m] = 1.0f / sqrtf(ssq * (1.0f / D) + EPS);
    }
}
__device__ __forceinline__ void p8_act(Frame& F, const Args& a) {
    bf16* U = (bf16*)(a.ws + WS_U); const float* cw = a.in[16]; const float* cb = a.in[17];
    constexpr int NCH = FF / 8, RUN = 16, NIT = (M / RUN) * NCH;
    for (int it = blockIdx.x * (NWAVES * 64) + F.tid; it < NIT; it += F.G * NWAVES * 64) {
        const int ch = it % NCH, r = it / NCH, row0 = r * RUN, t0 = row0 % SEQ, c0 = ch * 8;
        float w0[8], w1[8], w2[8], bb[8];
#pragma unroll
        for (int e = 0; e < 8; e += 4) { const f32x4 x0 = *(const f32x4*)(cw + c0 + e), x1 = *(const f32x4*)(cw + FF + c0 + e), x2 = *(const f32x4*)(cw + 2 * FF + c0 + e), x3 = *(const f32x4*)(cb + c0 + e);
#pragma unroll
            for (int q = 0; q < 4; ++q) { w0[e + q] = x0[q]; w1[e + q] = x1[q]; w2[e + q] = x2[q]; bb[e + q] = x3[q]; } }
        v4u gm2 = (v4u){0u, 0u, 0u, 0u}, gm1 = gm2;
        if (t0 >= 2) { gm2 = *(const v4u*)(U + (size_t)(row0 - 2) * NU + c0); gm1 = *(const v4u*)(U + (size_t)(row0 - 1) * NU + c0); }
#pragma unroll 4
        for (int i = 0; i < RUN; ++i) {
            bf16* rp = U + (size_t)(row0 + i) * NU;
            const v4u g0 = *(const v4u*)(rp + c0), vv = *(const v4u*)(rp + FF + c0);
            v4u o;
#pragma unroll
            for (int q = 0; q < 4; ++q) {
                const float ga = w0[2 * q] * bflo(gm2[q]) + w1[2 * q] * bflo(gm1[q]) + w2[2 * q] * bflo(g0[q]) + bb[2 * q];
                const float gb = w0[2 * q + 1] * bfhi(gm2[q]) + w1[2 * q + 1] * bfhi(gm1[q]) + w2[2 * q + 1] * bfhi(g0[q]) + bb[2 * q + 1];
                const float ra = ga / (1.0f + __expf(-ga)) * bflo(vv[q]), rb = gb / (1.0f + __expf(-gb)) * bfhi(vv[q]);
                o[q] = pk2(ra, rb);
            }
            *(v4u*)(rp + FF + c0) = o;
            gm2 = gm1; gm1 = g0;
        }
    }
}
__device__ __forceinline__ void p10_final(Frame& F, const Args& a) {
    const int gw = F.vcu * NWAVES + F.wave, NGW = F.G * NWAVES;
    const float* gf = a.in[19]; const pg8::RsParts rs{(const float*)(a.ws + WS_SSQ3)};
    f32x4 gv[4];
#pragma unroll
    for (int j = 0; j < 4; ++j) gv[j] = ((const f32x4*)gf)[64 * j + F.lane];
    for (int m = gw; m < M; m += NGW) {
        const float r = rs.get(m);
        GAS f32x4* xr = (GAS f32x4*)(a.out + (size_t)m * D) + F.lane;
#pragma unroll
        for (int j = 0; j < 4; ++j) { const f32x4 v = xr[64 * j]; xr[64 * j] = v * r * gv[j]; }
    }
}

#ifndef PG8_SP2
#define PG8_SP2 true
#endif
#ifndef PG8_ALIGN
#define PG8_ALIGN true
#endif
enum { PH_PRO = 0, PH_G1 = 1, PH_MIX = 2, PH_G2 = 3, PH_G3 = 4, PH_XAT = 5, PH_G4 = 6, PH_G5 = 7, PH_ACT = 8, PH_G6 = 9, PH_FIN = 10, PH_N = 11 };

__device__ __forceinline__ bool phase_in(Frame& F, int lo, int hi, int k) {
    if (!(lo <= k && k < hi)) return false;
    int t_ = threadIdx.x; asm volatile("" : "+v"(t_)); F.tid = t_; F.lane = t_ & 63; return true;
}
__global__ void __launch_bounds__(NWAVES * 64, 2) mk_fwd(Args args) {
    extern __shared__ __attribute__((aligned(16))) unsigned char lds[];
    Frame F;
    F.lds = (LAS unsigned char*)lds;
    F.MISC = (volatile LAS unsigned*)(F.lds + MISC_OFF);
    F.tid = threadIdx.x; F.lane = F.tid & 63; F.wave = __builtin_amdgcn_readfirstlane(F.tid >> 6);
    F.G = gridDim.x; { const int bx = blockIdx.x; F.vcu = (F.G % 8 == 0) ? (bx % 8) * (F.G / 8) + bx / 8 : bx; }
    unsigned char* ws = args.ws;
    F.ctl = (gu32*)(ws + WS_CTL);
    for (int u = F.tid; u < (LDS_BYTES - LDSCTL_OFF) / 4; u += NWAVES * 64) ((LAS unsigned*)(F.lds + LDSCTL_OFF))[u] = 0u;
    __syncthreads();
    const int lo = args.ph_lo, hi = args.ph_hi;
    XcdBarrier bar = xcd_barrier_post((unsigned*)(F.ctl + CW_BAR) + args.li * XCD_BAR_WORDS, F.MISC + 8);
#define IN(k) (phase_in(F, lo, hi, (k)))
#define SEAM(k) do { if (lo <= (k) && (k) + 1 < hi) xcd_barrier(bar); } while (0)
    bf16* XB = (bf16*)(ws + WS_XB); bf16* P = (bf16*)(ws + WS_P); bf16* MIX = (bf16*)(ws + WS_MIX); bf16* QX = (bf16*)(ws + WS_QX); bf16* XO = (bf16*)(ws + WS_XO); bf16* U = (bf16*)(ws + WS_U);
    const int G = F.G, bx = (int)blockIdx.x;

    if (IN(PH_PRO)) { p0_prologue(F, args); SEAM(PH_PRO); }
    if (IN(PH_G1)) {
        { pg8::Gemm g{XB, D, (const bf16*)(ws + WS_WIN), M, NP, D}; pg8::StaticOrder S; S.init(M, NP, G, bx);
          pg8::EpiScaleBf16<pg8::RsArr> E{P, NP, {(const float*)(ws + WS_RSTD0)}};
          pg8::gemm_phase<pg8::EpiScaleBf16<pg8::RsArr>, pg8::StaticOrder, PG8_ALIGN, PG8_SP2>(F.lds + RING_OFF, g, S, E); }
        { pg8::Gemm g{(const bf16*)(ws + WS_MEMB), D, (const bf16*)(ws + WS_WKV), MMEM, 2048, D}; pg8::StaticOrder S; S.init(MMEM, 2048, G, (bx + G / 2) % G);
          pg8::EpiScaleBf16<pg8::RsArr> E{(bf16*)(ws + WS_KVM), 2048, {(const float*)(ws + WS_RSTDM)}};
          pg8::gemm_phase<pg8::EpiScaleBf16<pg8::RsArr>, pg8::StaticOrder, PG8_ALIGN, PG8_SP2>(F.lds + RING_OFF, g, S, E); }
        SEAM(PH_G1);
    }
    if (IN(PH_MIX)) { p2_mix_naive(F, args); SEAM(PH_MIX); }
    if (IN(PH_G2)) {
        pg8::Gemm g{MIX, D, (const bf16*)(ws + WS_WOUT), M, D, D}; pg8::StaticOrder S; S.init(M, D, G, bx);
        pg8::EpiResid<true> E{args.in[0], args.out, XB, (float*)(ws + WS_SSQ1), D};
        pg8::gemm_phase<pg8::EpiResid<true>, pg8::StaticOrder, PG8_ALIGN, PG8_SP2>(F.lds + RING_OFF, g, S, E);
        SEAM(PH_G2);
    }
    if (IN(PH_G3)) {
        pg8::Gemm g{XB, D, (const bf16*)(ws + WS_WQ), M, D, D}; pg8::StaticOrder S; S.init(M, D, G, bx);
        pg8::EpiScaleBf16<pg8::RsOne> E{QX, D, {}};
        pg8::gemm_phase<pg8::EpiScaleBf16<pg8::RsOne>, pg8::StaticOrder, PG8_ALIGN, PG8_SP2>(F.lds + RING_OFF, g, S, E);
        SEAM(PH_G3);
    }
    if (IN(PH_XAT)) { p5_xattn(F, args); SEAM(PH_XAT); }
    if (IN(PH_G4)) {
        pg8::Gemm g{XO, D, (const bf16*)(ws + WS_WO), M, D, D}; pg8::StaticOrder S; S.init(M, D, G, bx);
        pg8::EpiResid<true> E{args.out, args.out, XB, (float*)(ws + WS_SSQ2), D};
        pg8::gemm_phase<pg8::EpiResid<true>, pg8::StaticOrder, PG8_ALIGN, PG8_SP2>(F.lds + RING_OFF, g, S, E);
        SEAM(PH_G4);
    }
    if (IN(PH_G5)) {
        pg8::Gemm g{XB, D, (const bf16*)(ws + WS_WUP), M, NU, D}; pg8::StaticOrder S; S.init(M, NU, G, bx);
        pg8::EpiScaleBf16<pg8::RsParts> E{U, NU, {(const float*)(ws + WS_SSQ2)}};
        pg8::gemm_phase<pg8::EpiScaleBf16<pg8::RsParts>, pg8::StaticOrder, PG8_ALIGN, PG8_SP2>(F.lds + RING_OFF, g, S, E);
        SEAM(PH_G5);
    }
    if (IN(PH_ACT)) { p8_act(F, args); SEAM(PH_ACT); }
    if (IN(PH_G6)) {
        pg8::Gemm g{U + FF, NU, (const bf16*)(ws + WS_WDN), M, D, FF}; pg8::StaticOrder S; S.init(M, D, G, bx);
        pg8::EpiResid<false> E{args.out, args.out, nullptr, (float*)(ws + WS_SSQ3), D};
        pg8::gemm_phase<pg8::EpiResid<false>, pg8::StaticOrder, PG8_ALIGN, PG8_SP2>(F.lds + RING_OFF, g, S, E);
        SEAM(PH_G6);
    }
    if (IN(PH_FIN)) { p10_final(F, args); }
#undef IN
#undef SEAM
}
extern "C" void kernel_launch(void* const* d_in, const int* in_sizes, int n_in, void* d_out, int out_size, void* d_ws, size_t ws_size, hipStream_t stream) {
    static int grid = 0;
    if (grid == 0) {
        if (n_in != 20 || in_sizes[0] != M * D || out_size != M * D || ws_size < WS_END) { fprintf(stderr, "kernel_launch: shape/workspace mismatch: n_in %d in0 %d out %d ws %zu (need %zu)\n", n_in, n_in > 0 ? in_sizes[0] : -1, out_size, ws_size, (size_t)WS_END); grid = -1; return; }
        int dev = 0, cus = 0, per_cu = 0;
        if (hipGetDevice(&dev) != hipSuccess || hipDeviceGetAttribute(&cus, hipDeviceAttributeMultiprocessorCount, dev) != hipSuccess) { fprintf(stderr, "kernel_launch: device query failed\n"); grid = -1; return; }
        if (hipFuncSetAttribute((const void*)mk_fwd, hipFuncAttributeMaxDynamicSharedMemorySize, LDS_BYTES) != hipSuccess) { fprintf(stderr, "kernel_launch: hipFuncSetAttribute failed\n"); grid = -1; return; }
        if (hipOccupancyMaxActiveBlocksPerMultiprocessor(&per_cu, (const void*)mk_fwd, NWAVES * 64, LDS_BYTES) != hipSuccess || per_cu < 1) { fprintf(stderr, "kernel_launch: occupancy query reports %d workgroups per CU\n", per_cu); (void)hipGetLastError(); grid = -1; return; }
        grid = cus;
    }
    if (grid < 0) return;
    (void)hipMemsetAsync((char*)d_ws + WS_CTL, 0, CTL_ZERO_BYTES, stream);
    Args a{};
    for (int i = 0; i < 20; ++i) a.in[i] = (const float*)d_in[i];
    a.out = (float*)d_out; a.ws = (unsigned char*)d_ws;
    unsigned char* ws = (unsigned char*)d_ws;
    auto launch = [&](int lo, int hi, int li) { a.ph_lo = lo; a.ph_hi = hi; a.li = li; hipLaunchKernelGGL(mk_fwd, dim3(grid), dim3(NWAVES * 64), LDS_BYTES, stream, a); };
    launch(PH_PRO, PH_N, 0);
}
```

```cpp
#include <hip/hip_runtime.h>
#include <cstdio>
#include <cstdint>
namespace pg8 {
#define PG8_LAS __attribute__((address_space(3)))
typedef unsigned short bf16_t;
typedef short bf16x8 __attribute__((ext_vector_type(8)));
typedef float f32x4 __attribute__((ext_vector_type(4)));
typedef unsigned u32x4 __attribute__((ext_vector_type(4)));
constexpr int BM = 256, BK = 64, HALF = 128, HTB = HALF * BK * 2  , STAGE_BYTES = 8 * HTB, NXCD = 8, WGM = 8;

__host__ __device__ __forceinline__ int lds_byte(int r, int c) { const int st = (r >> 4) * 2 + (c >> 5), rr = r & 15, cc = c & 31, ob = rr * 64 + cc * 2; return st * 1024 + (ob ^ (((ob >> 9) & 1) << 5)); }
__host__ __device__ __forceinline__ void stage_rc(int b, int& R, int& C) { const int st = b / 1024, sb = b % 1024, swz = sb ^ (((sb >> 9) & 1) << 5); R = (st >> 1) * 16 + swz / 64; C = (st & 1) * 32 + (swz % 64) / 2; }
__host__ __device__ __forceinline__ int perm32(int rho) { const int n = rho >> 4, i = rho & 15; return 8 * (i >> 2) + 4 * n + (i & 3); }

struct Unit { int pm, pn; };
struct Gemm { const bf16_t* A; int lda; const bf16_t* Bt; int M, N, K; };

struct StaticOrder {
    int nM, nN, nwg, G, c;
    __host__ __device__ void init(int M, int N, int G_, int c_) { nM = M / BM; nN = N / BM; nwg = nM * nN; G = G_; c = c_; }
    __host__ __device__ bool next(int i, Unit& u) const {
        const long L = (long)i * G + c; if (L >= nwg) return false;
        int wgid = (int)L; { const int q = nwg / NXCD, r = nwg % NXCD, xcd = wgid % NXCD, off = wgid / NXCD; wgid = (xcd < r ? xcd * (q + 1) : r * (q + 1) + (xcd - r) * q) + off; }
        const int nig = WGM * nN, gid = wgid / nig, fm = gid * WGM, gsz = (nM - fm) < WGM ? (nM - fm) : WGM;
        u.pm = fm + ((wgid % nig) % gsz); u.pn = (wgid % nig) / gsz; return true;
    }
    __device__ __forceinline__ void a_ready(const Unit&) const {}
    __device__ __forceinline__ void done(const Unit&) const {}
};

__device__ __forceinline__ unsigned cvt_pk_bf16(float lo, float hi) { unsigned r; asm volatile("v_cvt_pk_bf16_f32 %0, %1, %2" : "=v"(r) : "v"(lo), "v"(hi)); return r; }
typedef float f32x2 __attribute__((ext_vector_type(2)));
constexpr float RMS_EPS = 1e-6f;
struct RsOne   { __device__ __forceinline__ float get(int) const { return 1.0f; } };
struct RsArr   { const float* r; __device__ __forceinline__ float get(int row) const { return r[row]; } };
struct RsParts { const float* p;
    __device__ __forceinline__ float get(int row) const { const f32x4* q = (const f32x4*)(p + (size_t)row * 16); const f32x4 a = q[0], b = q[1], c = q[2], d = q[3];
        const float s = ((a[0] + a[1]) + (a[2] + a[3])) + ((b[0] + b[1]) + (b[2] + b[3])) + ((c[0] + c[1]) + (c[2] + c[3])) + ((d[0] + d[1]) + (d[2] + d[3]));
        return 1.0f / sqrtf(s * (1.0f / 1024.0f) + RMS_EPS); } };
template <class RS> struct EpiScaleBf16 {
    static constexpr bool PERM = true, AFTER_DRAIN = false;
    bf16_t* O; int ldc; RS rs;
    __device__ __forceinline__ void operator()(const f32x4 (&acc)[2][2][4][2], const Unit& u, int wr, int wc, int fr, int fq) const {
        const int row0 = u.pm * BM + wr * 64 + fr, col0 = u.pn * BM + wc * 32 + 8 * fq;
#pragma unroll
        for (int ai = 0; ai < 2; ++ai)
#pragma unroll
            for (int m = 0; m < 4; ++m) { const int row = row0 + ai * HALF + m * 16; const float sc = rs.get(row); bf16_t* rowp = O + (size_t)row * ldc + col0;
#pragma unroll
                for (int bj = 0; bj < 2; ++bj) { const f32x4 v0 = acc[ai][bj][m][0] * sc, v1 = acc[ai][bj][m][1] * sc;
                    u32x4 w; w.x = cvt_pk_bf16(v0[0], v0[1]); w.y = cvt_pk_bf16(v0[2], v0[3]); w.z = cvt_pk_bf16(v1[0], v1[1]); w.w = cvt_pk_bf16(v1[2], v1[3]);
                    *(u32x4*)(rowp + bj * HALF) = w; } }
    }
};
template <bool WRITE_BF16> struct EpiResid {
    static constexpr bool PERM = false, AFTER_DRAIN = false;
    const float* base; float* out; bf16_t* xb; float* ssq; int ldc;
    __device__ __forceinline__ void operator()(const f32x4 (&acc)[2][2][4][2], const Unit& u, int wr, int wc, int fr, int fq) const {
        typedef unsigned u32x2v __attribute__((ext_vector_type(2)));
        const int row0 = u.pm * BM + wr * 64 + fr, col0 = u.pn * BM + wc * 32 + 4 * fq;
#pragma unroll
        for (int ai = 0; ai < 2; ++ai)
#pragma unroll
            for (int m = 0; m < 4; ++m) { const int row = row0 + ai * HALF + m * 16; const size_t off = (size_t)row * ldc + col0; float ss = 0.f;
#pragma unroll
                for (int bj = 0; bj < 2; ++bj)
#pragma unroll
                    for (int n = 0; n < 2; ++n) { const size_t o2 = off + bj * HALF + n * 16; const f32x4 o = *(const f32x4*)(base + o2) + acc[ai][bj][m][n];
                        *(f32x4*)(out + o2) = o; ss += (o[0] * o[0] + o[1] * o[1]) + (o[2] * o[2] + o[3] * o[3]);
                        if (WRITE_BF16) { u32x2v w; w.x = cvt_pk_bf16(o[0], o[1]); w.y = cvt_pk_bf16(o[2], o[3]); *(u32x2v*)(xb + o2) = w; } }
                ss += __shfl_xor(ss, 16); ss += __shfl_xor(ss, 32);
                if (fq == 0) ssq[(size_t)row * 16 + u.pn * 4 + wc] = ss;
                asm volatile("" ::: "memory"); }
    }
};
template <class Epi, class Sched, bool ALIGN_EPI = false, bool SP2 = false>
__device__ __forceinline__ void gemm_phase(PG8_LAS unsigned char* lds, const Gemm g, const Sched& S, const Epi& E) {
    const int tid = threadIdx.x, wid = __builtin_amdgcn_readfirstlane(tid >> 6), lane = tid & 63, wr = wid >> 2, wc = wid & 3, fr = lane & 15, fq = lane >> 4;
    const int K = g.K, nt = K / BK;
    unsigned voffA[2], voffB[2];
#pragma unroll
    for (int i = 0; i < 2; ++i) { int R, C; stage_rc(tid * 16 + i * 8192, R, C); const int Rb = Epi::PERM ? ((R & ~31) + perm32(R & 31)) : R;
        voffA[i] = (unsigned)(R * g.lda + C) * 2u; voffB[i] = (unsigned)(Rb * K + C) * 2u; }
    const size_t kstep = (size_t)(BK * 2);
    const size_t hstepA = (size_t)HALF * g.lda * 2, hstepB = (size_t)HALF * K * 2;
    const size_t tstepA = 2 * hstepA, tstepB = 2 * hstepB;
    const unsigned ldsw = (unsigned)wid * 1024u;
    const int aoff = lds_byte(wr * 64 + fr, fq * 8), boff = lds_byte(wc * 32 + fr, fq * 8);
#define PG8_SA(b, h) (((b) * 2 + (h)) * HTB)
#define PG8_SB(b, h) ((4 + (b) * 2 + (h)) * HTB)
#define PG8_STAGE(bufoff, gbase, voff) do { _Pragma("unroll") for (int _i = 0; _i < 2; ++_i) \
        __builtin_amdgcn_global_load_lds((const unsigned*)((const char*)(gbase) + (voff)[_i]), (PG8_LAS unsigned*)(lds + (bufoff) + ldsw + _i * 8192), 16, 0, 0); } while (0)
#define PG8_LDA(dst, b, h) do { _Pragma("unroll") for (int m = 0; m < 4; ++m) _Pragma("unroll") for (int k = 0; k < 2; ++k) dst[m][k] = *(const PG8_LAS bf16x8*)(lds + PG8_SA(b, h) + aoff + m * 2048 + k * 1024); } while (0)
#define PG8_LDB(dst, b, h) do { _Pragma("unroll") for (int n = 0; n < 2; ++n) _Pragma("unroll") for (int k = 0; k < 2; ++k) dst[n][k] = *(const PG8_LAS bf16x8*)(lds + PG8_SB(b, h) + boff + n * 2048 + k * 1024); } while (0)
#define PG8_MMA(ai, bj, At, Bt) do { __builtin_amdgcn_s_setprio(1); _Pragma("unroll") for (int m = 0; m < 4; ++m) _Pragma("unroll") for (int n = 0; n < 2; ++n) _Pragma("unroll") for (int k = 0; k < 2; ++k) \
        acc[ai][bj][m][n] = __builtin_amdgcn_mfma_f32_16x16x32_bf16(Bt[n][k], At[m][k], acc[ai][bj][m][n], 0, 0, 0); __builtin_amdgcn_s_setprio(0); } while (0)
#define PG8_WAIT_V(n) asm volatile("s_waitcnt vmcnt(" #n ")" ::: "memory")
#define PG8_WAIT_L(n) asm volatile("s_waitcnt lgkmcnt(" #n ")" ::: "memory")
#define PG8_BAR __builtin_amdgcn_s_barrier()
#define PG8_SCHED __builtin_amdgcn_sched_barrier(0)
    Unit cur, nxt; int ui = 0;
    if (!S.next(0, cur)) return;
    f32x4 acc[2][2][4][2];
#pragma unroll
    for (int a = 0; a < 2; ++a)
#pragma unroll
        for (int b = 0; b < 2; ++b)
#pragma unroll
            for (int m = 0; m < 4; ++m)
#pragma unroll
                for (int n = 0; n < 2; ++n) acc[a][b][m][n] = (f32x4){0.f, 0.f, 0.f, 0.f};
    bf16x8 At[4][2], B0[2][2], B1[2][2];
    const char* cA = (const char*)g.A + (size_t)cur.pm * tstepA; const char* cB = (const char*)g.Bt + (size_t)cur.pn * tstepB;
    S.a_ready(cur);
    if constexpr (SP2) {
        PG8_STAGE(PG8_SB(0, 0), cB, voffB); PG8_STAGE(PG8_SB(0, 1), cB + hstepB, voffB); PG8_STAGE(PG8_SA(0, 0), cA, voffA); PG8_STAGE(PG8_SA(0, 1), cA + hstepA, voffA);
        if (wr == 1) PG8_BAR;
        PG8_WAIT_V(2); PG8_BAR;
        PG8_STAGE(PG8_SB(1, 0), cB + kstep, voffB); PG8_STAGE(PG8_SA(1, 0), cA + kstep, voffA); PG8_STAGE(PG8_SB(1, 1), cB + hstepB + kstep, voffB);
        PG8_WAIT_V(6); PG8_BAR;
    } else {
        PG8_STAGE(PG8_SB(0, 0), cB, voffB); PG8_STAGE(PG8_SA(0, 0), cA, voffA); PG8_STAGE(PG8_SB(0, 1), cB + hstepB, voffB); PG8_STAGE(PG8_SA(0, 1), cA + hstepA, voffA);
        if (wr == 1) PG8_BAR;
        PG8_WAIT_V(4); PG8_BAR;
        PG8_STAGE(PG8_SB(1, 0), cB + kstep, voffB); PG8_STAGE(PG8_SA(1, 0), cA + kstep, voffA); PG8_STAGE(PG8_SB(1, 1), cB + hstepB + kstep, voffB);
        PG8_WAIT_V(6); PG8_BAR;
    }
    for (;;) {
        const bool has_next = S.next(ui + 1, nxt);
        const char* nA = has_next ? (const char*)g.A + (size_t)nxt.pm * tstepA : cA; const char* nB = has_next ? (const char*)g.Bt + (size_t)nxt.pn * tstepB : cB;
        for (int t = 0; t < nt; t += 2) {
            const bool last = (t == nt - 2);
            const char* a1 = cA + (size_t)(t + 1) * kstep;
            const char* a2 = last ? nA : cA + (size_t)(t + 2) * kstep; const char* b2 = last ? nB : cB + (size_t)(t + 2) * kstep;
            const char* a3 = a2 + kstep; const char* b3 = b2 + kstep;
            if (last && has_next) S.a_ready(nxt);
            if constexpr (SP2) {
            PG8_LDB(B0, 0, 0); PG8_LDB(B1, 0, 1); PG8_SCHED; PG8_LDA(At, 0, 0); PG8_STAGE(PG8_SA(1, 1), a1 + hstepA, voffA);
            PG8_WAIT_V(8); PG8_WAIT_L(0); PG8_BAR; PG8_MMA(0, 0, At, B0); PG8_MMA(0, 1, At, B1); PG8_BAR; PG8_SCHED;
            PG8_LDA(At, 0, 1); PG8_STAGE(PG8_SB(0, 0), b2, voffB); PG8_STAGE(PG8_SB(0, 1), b2 + hstepB, voffB); PG8_STAGE(PG8_SA(0, 0), a2, voffA);
            PG8_WAIT_V(8); PG8_WAIT_L(0); PG8_BAR; PG8_MMA(1, 0, At, B0); PG8_MMA(1, 1, At, B1); PG8_BAR; PG8_SCHED;
            PG8_LDB(B0, 1, 0); PG8_LDB(B1, 1, 1); PG8_SCHED; PG8_LDA(At, 1, 0); PG8_STAGE(PG8_SA(0, 1), a2 + hstepA, voffA);
            PG8_WAIT_V(8); PG8_WAIT_L(0); PG8_BAR; PG8_MMA(0, 0, At, B0); PG8_MMA(0, 1, At, B1); PG8_BAR; PG8_SCHED;
            PG8_LDA(At, 1, 1); PG8_STAGE(PG8_SB(1, 0), b3, voffB); PG8_STAGE(PG8_SB(1, 1), b3 + hstepB, voffB); PG8_STAGE(PG8_SA(1, 0), a3, voffA);
            PG8_WAIT_V(8); PG8_WAIT_L(0); PG8_BAR; PG8_MMA(1, 0, At, B0); PG8_MMA(1, 1, At, B1); PG8_BAR; PG8_SCHED;
            } else {
            PG8_LDB(B0, 0, 0); PG8_SCHED; PG8_LDA(At, 0, 0); PG8_STAGE(PG8_SA(1, 1), a1 + hstepA, voffA);
            PG8_WAIT_L(8); PG8_BAR; PG8_WAIT_L(0); PG8_MMA(0, 0, At, B0); PG8_BAR; PG8_SCHED;
            PG8_LDB(B1, 0, 1); PG8_STAGE(PG8_SB(0, 0), b2, voffB);
            PG8_BAR; PG8_WAIT_L(0); PG8_MMA(0, 1, At, B1); PG8_BAR;
            PG8_LDA(At, 0, 1); PG8_STAGE(PG8_SA(0, 0), a2, voffA);
            PG8_BAR; PG8_WAIT_L(0); PG8_MMA(1, 0, At, B0); PG8_BAR; PG8_SCHED;
            PG8_STAGE(PG8_SB(0, 1), b2 + hstepB, voffB);
            PG8_WAIT_V(6); PG8_BAR; PG8_MMA(1, 1, At, B1); PG8_BAR;
            PG8_LDB(B0, 1, 0); PG8_SCHED; PG8_LDA(At, 1, 0); PG8_STAGE(PG8_SA(0, 1), a2 + hstepA, voffA);
            PG8_WAIT_L(8); PG8_BAR; PG8_WAIT_L(0); PG8_MMA(0, 0, At, B0); PG8_BAR; PG8_SCHED;
            PG8_LDB(B1, 1, 1); PG8_STAGE(PG8_SB(1, 0), b3, voffB);
            PG8_BAR; PG8_WAIT_L(0); PG8_MMA(0, 1, At, B1); PG8_BAR;
            PG8_LDA(At, 1, 1); PG8_STAGE(PG8_SA(1, 0), a3, voffA);
            PG8_BAR; PG8_WAIT_L(0); PG8_MMA(1, 0, At, B0); PG8_BAR; PG8_SCHED;
            PG8_STAGE(PG8_SB(1, 1), b3 + hstepB, voffB);
            PG8_WAIT_V(6); PG8_BAR; PG8_MMA(1, 1, At, B1); PG8_BAR;
            }
        }
        if constexpr (ALIGN_EPI) { if (wr == 0) PG8_BAR; }
        if constexpr (!Epi::AFTER_DRAIN) { E(acc, cur, wr, wc, fr, fq); S.done(cur); }
        if (!has_next) break;
#pragma unroll
        for (int a = 0; a < 2; ++a)
#pragma unroll
            for (int b = 0; b < 2; ++b)
#pragma unroll
                for (int m = 0; m < 4; ++m)
#pragma unroll
                    for (int n = 0; n < 2; ++n) acc[a][b][m][n] = (f32x4){0.f, 0.f, 0.f, 0.f};
        cur = nxt; cA = nA; cB = nB; ++ui;
        if constexpr (ALIGN_EPI) { if (wr == 1) PG8_BAR; }
    }
    PG8_WAIT_V(0);
    if constexpr (!ALIGN_EPI) { if (wr == 0) PG8_BAR; }
    PG8_BAR;
    if constexpr (Epi::AFTER_DRAIN) { E.fused(acc, cur, wr, wc, fr, fq, lds, wid, lane); S.done(cur); }
#undef PG8_SA
#undef PG8_SB
#undef PG8_STAGE
#undef PG8_LDA
#undef PG8_LDB
#undef PG8_MMA
#undef PG8_WAIT_V
#undef PG8_WAIT_L
#undef PG8_BAR
#undef PG8_SCHED
}
}
#define GAS __attribute__((address_space(1)))
#define LAS __attribute__((address_space(3)))
typedef unsigned short bf16;
typedef unsigned v4u __attribute__((ext_vector_type(4)));
typedef float f32x4 __attribute__((ext_vector_type(4)));
typedef short bf16x8 __attribute__((ext_vector_type(8)));
typedef GAS unsigned gu32;
typedef GAS unsigned long long gu64;
#define RLX_AGENT __ATOMIC_RELAXED, __HIP_MEMORY_SCOPE_AGENT
#define LDS_WAIT() asm volatile("s_waitcnt lgkmcnt(0)" ::: "memory")
#define VM_WAIT() asm volatile("s_waitcnt vmcnt(0)" ::: "memory")
__device__ __forceinline__ unsigned long long rt() { return __builtin_amdgcn_s_memrealtime(); }
__device__ __forceinline__ unsigned f2bf(float f) { unsigned u = __builtin_bit_cast(unsigned, f); return (u + 0x7fffu + ((u >> 16) & 1u)) >> 16; }
__device__ __forceinline__ unsigned pk2(float lo, float hi) { return f2bf(lo) | (f2bf(hi) << 16); }

#define XB_TMO      128
#define XB_XCNT(j)  (256  + 64 * (j))
#define XB_XSUB(j)  (1280 + 64 * (j))
#define XB_XGEN(j)  (2304 + 64 * (j))
#define XB_TOP      3328
#define XB_TOPGEN   3392
#define XCD_BAR_WORDS 3456
#define XB_SPIN_CAP (1u << 18)

__device__ __forceinline__ unsigned xb_ld(unsigned* p)              { return __hip_atomic_load(p, __ATOMIC_RELAXED, __HIP_MEMORY_SCOPE_AGENT); }
__device__ __forceinline__ unsigned xb_add(unsigned* p, unsigned v) { return __hip_atomic_fetch_add(p, v, __ATOMIC_RELAXED, __HIP_MEMORY_SCOPE_AGENT); }
__device__ __forceinline__ unsigned xb_xcc_id() { return (unsigned)__builtin_amdgcn_s_getreg((3 << 11) | 20) & 0xFu; }
#define XB_SPIN(cond, bar) do { unsigned _sp = 0; while (cond) { __builtin_amdgcn_s_sleep(1); \
    if ((++_sp & 255u) == 0u) { if (xb_ld(&(bar)[XB_TMO])) break; if (_sp > XB_SPIN_CAP) { atomicAdd(&(bar)[XB_TMO], 1u); break; } } } } while (0)

struct XcdBarrier {
    unsigned* bar; unsigned x;
    volatile LAS unsigned* st;
};

__device__ __forceinline__ XcdBarrier xcd_barrier_post(unsigned* bar, volatile LAS unsigned* st) {
    XcdBarrier b; b.bar = bar; b.x = xb_xcc_id(); b.st = st;
    if (threadIdx.x == 0) (void)xb_add(&bar[XB_XCNT(b.x)], 1u);
    return b;
}
__device__ __forceinline__ void xcd_barrier_complete(unsigned* bar, unsigned x, unsigned& nloc, unsigned& nx) {
    const unsigned G = gridDim.x * gridDim.y * gridDim.z;
    unsigned sum, cnt, mine, sp = 0u;
    for (;;) {
        sum = 0u; cnt = 0u; mine = 0u;
#pragma unroll
        for (unsigned j = 0; j < 16; ++j) { const unsigned c = xb_ld(&bar[XB_XCNT(j)]); sum += c; cnt += (c > 0u) ? 1u : 0u; mine = (j == x) ? c : mine; }
        if (sum == G) break;
        __builtin_amdgcn_s_sleep(1);
        if ((++sp & 255u) == 0u) { if (xb_ld(&bar[XB_TMO])) break; if (sp > XB_SPIN_CAP) { atomicAdd(&bar[XB_TMO], 1u); break; } }
    }
    nloc = mine > 0u ? mine : 1u; nx = cnt > 0u ? cnt : 1u;
}

__device__ __forceinline__ void xcd_barrier(const XcdBarrier& b) {
    asm volatile("s_waitcnt vmcnt(0)" ::: "memory");
    __syncthreads();
    if (threadIdx.x == 0) {
        unsigned* bar = b.bar;
        __builtin_amdgcn_s_waitcnt(0);
        unsigned nloc = b.st[0], nx = b.st[1];
        if (nloc == 0u) { xcd_barrier_complete(bar, b.x, nloc, nx); b.st[0] = nloc; b.st[1] = nx; }
        const unsigned old = xb_add(&bar[XB_XSUB(b.x)], 1u);
        const unsigned gen = old / nloc;
        if (old + 1u == (gen + 1u) * nloc) {
            __builtin_amdgcn_fence(__ATOMIC_RELEASE, "agent");
            asm volatile("s_waitcnt vmcnt(0)" ::: "memory");
            const unsigned og = xb_add(&bar[XB_TOP], 1u);
            const unsigned tg = og / nx;
            if (og + 1u == (tg + 1u) * nx) xb_add(&bar[XB_TOPGEN], 1u);
            else XB_SPIN(xb_ld(&bar[XB_TOPGEN]) == tg, bar);
            __builtin_amdgcn_fence(__ATOMIC_ACQUIRE, "agent");
            xb_add(&bar[XB_XGEN(b.x)], 1u);
            asm volatile("s_waitcnt vmcnt(0)" ::: "memory");
        } else {
            XB_SPIN(xb_ld(&bar[XB_XGEN(b.x)]) == gen, bar);
            __builtin_amdgcn_fence(__ATOMIC_ACQUIRE, "agent");
            asm volatile("s_waitcnt vmcnt(0)" ::: "memory");
        }
    }
    __syncthreads();
}
constexpr int NWAVES = 8;
constexpr int BATCH = 16, SEQ = 2048, D = 1024, M = BATCH * SEQ;
constexpr int NP = 2816;
constexpr int IN_COLS = 2824;
constexpr int O_AK = 512, O_AV = 640, O_MQ = 768, O_MK = 1280, O_MV = 1792, O_MO = 2304, O_G = 2816;
constexpr int MEMLEN = 256, MMEM = BATCH * MEMLEN;
constexpr int FF = 2816, NU = 2 * FF;
constexpr float EPS = 1e-6f;
constexpr size_t MiB = 1u << 20;
constexpr size_t WS_CTL = 0, CTL_ZERO_BYTES = 1 * MiB;
constexpr size_t WS_RSTD0 = 1 * MiB;
constexpr size_t WS_RSTDM = WS_RSTD0 + 128 * 1024;
constexpr size_t WS_GPRE = 2 * MiB;
constexpr size_t WS_SSQ1 = 4 * MiB, WS_SSQ2 = 6 * MiB, WS_SSQ3 = 8 * MiB;
constexpr size_t WS_WIN = 16 * MiB, WS_WKV = 22 * MiB, WS_WOUT = 26 * MiB, WS_WQ = 28 * MiB, WS_WO = 30 * MiB, WS_WUP = 32 * MiB, WS_WDN = 43 * MiB;
constexpr size_t WS_MEMB = 49 * MiB;
constexpr size_t WS_KVM = 57 * MiB;
constexpr size_t WS_XB = 80 * MiB;
constexpr size_t WS_P = 144 * MiB;
constexpr size_t WS_MIX = 320 * MiB;
constexpr size_t WS_QX = 384 * MiB;
constexpr size_t WS_XO = 448 * MiB;
constexpr size_t WS_U = 144 * MiB;
constexpr size_t WS_END = 512 * MiB;
static_assert(WS_WDN + (size_t)D * FF * 2 <= WS_MEMB && WS_KVM + (size_t)MMEM * 2048 * 2 <= WS_XB && WS_XB + (size_t)M * D * 2 == WS_P && WS_P + (size_t)M * NP * 2 == WS_MIX && WS_U + (size_t)M * NU * 2 <= WS_END, "d_ws map");
constexpr int CW_TMO = 0, CW_CODE = 1;
constexpr int CW_BAR = 4096;
constexpr int N_BAR_REGIONS = 16;
static_assert((CW_BAR + N_BAR_REGIONS * XCD_BAR_WORDS) * 4 <= (int)CTL_ZERO_BYTES, "CTL words inside the memset region");
constexpr int RING_OFF = 0, RING_BYTES = 131072;
constexpr int LDS_BYTES = 163840;
constexpr int LDSCTL_OFF = LDS_BYTES - 512, MISC_OFF = LDSCTL_OFF + 320;
constexpr int PH_LDS = LDSCTL_OFF;

struct Args { const float* in[20]; float* out; unsigned char* ws; int ph_lo, ph_hi, li, pad; };

struct Frame {
    LAS unsigned char* lds; volatile LAS unsigned* MISC; gu32* ctl;
    int tid, lane, wave, vcu, G;
};
__device__ __forceinline__ float wave_sum(float v) {
#pragma unroll
    for (int o = 1; o < 64; o <<= 1) v += __shfl_xor(v, o);
    return v;
}
__device__ __forceinline__ float bf2f(unsigned short b) { return __builtin_bit_cast(float, (unsigned)b << 16); }
__device__ __forceinline__ float bflo(unsigned w) { return __builtin_bit_cast(float, w << 16); }
__device__ __forceinline__ float bfhi(unsigned w) { return __builtin_bit_cast(float, w & 0xffff0000u); }

__device__ __forceinline__ void p0_transpose_item(const float* W, int K, int ldw, int src_col0, const float* g, bf16* WT, int dst_row0, LAS float* scr, int kb, int lane) {
    const int k0 = 64 * kb;
#pragma unroll 8
    for (int i = 0; i < 32; ++i) { const int kk = 2 * i + (lane >> 5); float w = W[(size_t)(k0 + kk) * ldw + src_col0 + (lane & 31)]; if (g) w *= g[k0 + kk]; scr[kk * 33 + (lane & 31)] = w; }
    LDS_WAIT(); asm volatile("" ::: "memory");
    const int c = lane & 7;
#pragma unroll
    for (int j = 0; j < 4; ++j) { const int n = (lane >> 3) + 8 * j; const LAS float* s = scr + (8 * c) * 33 + n;
        v4u o; o.x = pk2(s[0 * 33], s[1 * 33]); o.y = pk2(s[2 * 33], s[3 * 33]); o.z = pk2(s[4 * 33], s[5 * 33]); o.w = pk2(s[6 * 33], s[7 * 33]);
        *(GAS v4u*)(WT + (size_t)(dst_row0 + n) * K + k0 + 8 * c) = o; }
    LDS_WAIT(); asm volatile("" ::: "memory");
}
__device__ __forceinline__ float row_to_bf16(const float* xrow, bf16* orow, int lane, f32x4 (&v)[4]) {
    const GAS f32x4* xr = (const GAS f32x4*)xrow + lane; float s = 0.f;
#pragma unroll
    for (int j = 0; j < 4; ++j) { v[j] = xr[64 * j]; s += (v[j][0] * v[j][0] + v[j][1] * v[j][1]) + (v[j][2] * v[j][2] + v[j][3] * v[j][3]); }
    GAS unsigned long long* o8 = (GAS unsigned long long*)orow + lane;
#pragma unroll
    for (int j = 0; j < 4; ++j) o8[64 * j] = (unsigned long long)pk2(v[j][0], v[j][1]) | ((unsigned long long)pk2(v[j][2], v[j][3]) << 32);
    return wave_sum(s);
}
typedef float f32x16 __attribute__((ext_vector_type(16)));
typedef short s16x4 __attribute__((ext_vector_type(4)));
__device__ __forceinline__ int crow(int r, int hi) { return (r & 3) + 8 * (r >> 2) + 4 * hi; }
__device__ __forceinline__ unsigned cvtpk(float lo, float hi) { typedef float f2 __attribute__((ext_vector_type(2))); typedef __bf16 b2 __attribute__((ext_vector_type(2))); f2 v = {lo, hi}; b2 b = __builtin_convertvector(v, b2); return __builtin_bit_cast(unsigned, b); }
__device__ __forceinline__ s16x4 ldtr(const LAS unsigned char* p) { typedef short v4i16 __attribute__((ext_vector_type(4))); return __builtin_bit_cast(s16x4, __builtin_amdgcn_ds_read_tr16_b64_v4i16((LAS v4i16*)p)); }
__device__ __forceinline__ bf16x8 pack8(const f32x16& p, int b) { v4u w; w.x = cvtpk(p[b], p[b + 1]); w.y = cvtpk(p[b + 2], p[b + 3]); w.z = cvtpk(p[b + 4], p[b + 5]); w.w = cvtpk(p[b + 6], p[b + 7]); return __builtin_bit_cast(bf16x8, w); }
#define GLDS16(gptr, ldsptr) __builtin_amdgcn_global_load_lds((const unsigned*)(gptr), (LAS unsigned*)(ldsptr), 16, 0, 0)

__device__ __forceinline__ void xattn_unit(Frame& F, int b, int xh, int qb, const bf16* QX, const float* ssq1, const bf16* KVM, bf16* XO) {
    const int lane = F.lane, w = F.wave, r32 = lane & 31, hi = lane >> 5;
    const size_t row = (size_t)b * SEQ + qb * 256 + w * 32 + r32;
    const bf16* Kg = KVM + (size_t)b * MEMLEN * 2048 + xh * 256;
    { const bf16* kp = Kg + (size_t)(2 * w + (lane >> 5)) * 2048 + (lane & 31) * 8;
#pragma unroll
      for (int i = 0; i < 16; ++i) GLDS16(kp + (size_t)i * 16 * 2048, F.lds + (w + 8 * i) * 1040); }
    const bf16* qp = QX + row * D + xh * 256 + hi * 8;
    bf16x8 qa[2], qc[2];
#pragma unroll
    for (int j = 0; j < 2; ++j) qa[j] = *(const bf16x8*)(qp + j * 16);
    const pg8::RsParts rs{ssq1};
    const float sc2 = rs.get((int)row) * (0.0625f * 1.4426950408889634f);
    asm volatile("s_waitcnt vmcnt(0)" ::: "memory"); __syncthreads();
    const LAS unsigned char* kbase = F.lds + (r32 >> 1) * 1040 + (r32 & 1) * 512 + hi * 16;
    f32x16 S[8];
#pragma unroll
    for (int kb = 0; kb < 8; ++kb) S[kb] = (f32x16){0.f, 0.f, 0.f, 0.f, 0.f, 0.f, 0.f, 0.f, 0.f, 0.f, 0.f, 0.f, 0.f, 0.f, 0.f, 0.f};
#define XQK(QF, G) do { _Pragma("unroll") for (int j = 0; j < 2; ++j) _Pragma("unroll") for (int kb = 0; kb < 8; ++kb) { \
            const bf16x8 a = *(const LAS bf16x8*)(kbase + kb * 16640 + (2 * (G) + j) * 32); \
            S[kb] = __builtin_amdgcn_mfma_f32_32x32x16_bf16(a, QF[j], S[kb], 0, 0, 0); } } while (0)
#define XQL(QF, G) do { _Pragma("unroll") for (int j = 0; j < 2; ++j) QF[j] = *(const bf16x8*)(qp + (2 * (G) + j) * 16); } while (0)
    XQL(qc, 1); asm volatile("" ::: "memory"); XQK(qa, 0); asm volatile("" ::: "memory");
    XQL(qa, 2); asm volatile("" ::: "memory"); XQK(qc, 1); asm volatile("" ::: "memory");
    XQL(qc, 3); asm volatile("" ::: "memory"); XQK(qa, 2); asm volatile("" ::: "memory");
    XQL(qa, 4); asm volatile("" ::: "memory"); XQK(qc, 3); asm volatile("" ::: "memory");
    XQL(qc, 5); asm volatile("" ::: "memory"); XQK(qa, 4); asm volatile("" ::: "memory");
    XQL(qa, 6); asm volatile("" ::: "memory"); XQK(qc, 5); asm volatile("" ::: "memory");
    XQL(qc, 7); asm volatile("" ::: "memory"); XQK(qa, 6); asm volatile("" ::: "memory");
    XQK(qc, 7);
#undef XQK
#undef XQL
    float mx = S[0][0];
#pragma unroll
    for (int kb = 0; kb < 8; ++kb)
#pragma unroll
        for (int r = 0; r < 16; ++r) mx = fmaxf(mx, S[kb][r]);
    mx = fmaxf(mx, __shfl_xor(mx, 32));
    const float mo = mx * sc2; float l = 0.f;
#pragma unroll
    for (int kb = 0; kb < 8; ++kb)
#pragma unroll
        for (int r = 0; r < 16; ++r) { const float e = __builtin_amdgcn_exp2f(S[kb][r] * sc2 - mo); S[kb][r] = e; l += e; }
    l += __shfl_xor(l, 32);
    const float inv = 1.0f / l;
    bf16x8 pf[8][2];
#pragma unroll
    for (int kb = 0; kb < 8; ++kb) { pf[kb][0] = pack8(S[kb], 0); pf[kb][1] = pack8(S[kb], 8); }
    __syncthreads();
    { const bf16* vp = KVM + (size_t)b * MEMLEN * 2048 + 1024 + xh * 256 + (size_t)(16 * w + (lane >> 2)) * 2048 + 8 * (lane & 3);
#pragma unroll
      for (int i = 0; i < 16; ++i) GLDS16(vp + (size_t)(i & 1) * 128 * 2048 + (i >> 1) * 32, F.lds + (w + 8 * i) * 1024); }
    asm volatile("s_waitcnt vmcnt(0)" ::: "memory"); __syncthreads();
    bf16* orow = XO + row * D + xh * 256 + 4 * hi;
    const int vbase = (4 * hi + ((lane & 15) >> 2)) * 64 + (16 * ((lane >> 4) & 1) + 4 * (lane & 3)) * 2;
#pragma unroll
    for (int db = 0; db < 8; ++db) {
        f32x16 o = (f32x16){0.f, 0.f, 0.f, 0.f, 0.f, 0.f, 0.f, 0.f, 0.f, 0.f, 0.f, 0.f, 0.f, 0.f, 0.f, 0.f};
#pragma unroll
        for (int kb = 0; kb < 8; ++kb)
#pragma unroll
            for (int s = 0; s < 2; ++s) {
                const LAS unsigned char* vp = F.lds + db * 16384 + (32 * kb + 16 * s) * 64 + vbase;
                const s16x4 lo = ldtr(vp), hh = ldtr(vp + 8 * 64);
                const bf16x8 a = (bf16x8){lo[0], lo[1], lo[2], lo[3], hh[0], hh[1], hh[2], hh[3]};
                o = __builtin_amdgcn_mfma_f32_32x32x16_bf16(a, pf[kb][s], o, 0, 0, 0);
            }
#pragma unroll
        for (int g = 0; g < 4; ++g) { typedef unsigned u2 __attribute__((ext_vector_type(2))); u2 wv; wv.x = cvtpk(o[4 * g] * inv, o[4 * g + 1] * inv); wv.y = cvtpk(o[4 * g + 2] * inv, o[4 * g + 3] * inv);
            *(u2*)(orow + 32 * db + 8 * g) = wv; }
    }
    __syncthreads();
}
__device__ __forceinline__ void p5_xattn(Frame& F, const Args& a) {
    const bf16* QX = (const bf16*)(a.ws + WS_QX); const bf16* KVM = (const bf16*)(a.ws + WS_KVM); bf16* XO = (bf16*)(a.ws + WS_XO); const float* ssq1 = (const float*)(a.ws + WS_SSQ1);
    constexpr int NUNIT = BATCH * 4 * (SEQ / 256);
    for (int u = F.vcu; u < NUNIT; u += F.G) { const int qb = u & 7, xh = (u >> 3) & 3, b = u >> 5; xattn_unit(F, b, xh, qb, QX, ssq1, KVM, XO); }
}
__device__ __forceinline__ void swa_unit(Frame& F, int b, int hk, int n, const bf16* P, const float* sinks, bf16* MIX) {
    const int lane = F.lane, w = F.wave, r32 = lane & 31, hi = lane >> 5, wq = w & 3;
    LAS unsigned char* Kl = F.lds; LAS unsigned char* Vl = F.lds + 32768;
    const int np = n > 0 ? n - 1 : 0;
    {
        const int z = (4 * w + (lane >> 4)) & 7;
        const bf16* kp = P + (size_t)(b * SEQ + 8 * w + (lane >> 3)) * NP + O_AK + hk * 64 + (((lane & 7) ^ z) * 8);
#pragma unroll
        for (int i = 0; i < 4; ++i) GLDS16(kp + (size_t)(128 * (i < 2 ? np : n) + 64 * (i & 1)) * NP, Kl + (w + 8 * i) * 1024);
        const bf16* vp = P + (size_t)(b * SEQ + 16 * w + (lane >> 2)) * NP + O_AV + hk * 64 + 8 * (lane & 3);
#pragma unroll
        for (int i = 0; i < 4; ++i) GLDS16(vp + (size_t)(128 * ((i & 1) ? n : np)) * NP + 32 * (i >> 1), Vl + (w + 8 * i) * 1024);
    }
    const size_t row = (size_t)b * SEQ + n * 128 + wq * 32 + r32;
    bf16x8 qf[2][4];
#pragma unroll
    for (int gi = 0; gi < 2; ++gi) { const bf16* qp = P + row * NP + (hk * 4 + 2 * (w >> 2) + gi) * 64 + hi * 8;
#pragma unroll
        for (int ks = 0; ks < 4; ++ks) qf[gi][ks] = *(const bf16x8*)(qp + ks * 16); }
    asm volatile("s_waitcnt vmcnt(0)" ::: "memory"); __syncthreads();
    const int zk = (r32 >> 1) & 7;
    const LAS unsigned char* krow = Kl + (32 * wq + r32) * 128;
    const int vlane = (4 * hi + ((lane & 15) >> 2)) * 64 + (16 * ((lane >> 4) & 1) + 4 * (lane & 3)) * 2;
    const int dl = r32 - 4 * hi;
#pragma unroll
    for (int gi = 0; gi < 2; ++gi) {
        const int h = hk * 4 + 2 * (w >> 2) + gi;
        const float slope2 = exp2f(-(float)(h + 1)) * 1.4426950408889634f, sink2 = sinks[h] * 1.4426950408889634f;
        constexpr float sc = 0.125f * 1.4426950408889634f;
        f32x16 S[5];
#pragma unroll
        for (int jb = 0; jb < 5; ++jb) S[jb] = (f32x16){0.f, 0.f, 0.f, 0.f, 0.f, 0.f, 0.f, 0.f, 0.f, 0.f, 0.f, 0.f, 0.f, 0.f, 0.f, 0.f};
#pragma unroll
        for (int ks = 0; ks < 4; ++ks) { const int co = ((2 * ks + hi) ^ zk) * 16;
#pragma unroll
            for (int jb = 0; jb < 5; ++jb) { const bf16x8 a = *(const LAS bf16x8*)(krow + jb * 4096 + co); S[jb] = __builtin_amdgcn_mfma_f32_32x32x16_bf16(a, qf[gi][ks], S[jb], 0, 0, 0); } }
        int dlo = dl; float bbase = -slope2 * (float)(dl + 128);
        asm volatile("" : "+v"(dlo), "+v"(bbase));
        float mx = sink2;
#pragma unroll
        for (int jb = 0; jb < 5; ++jb) { const bool dead = (n == 0) && (wq + jb < 4);
#pragma unroll
            for (int r = 0; r < 16; ++r) { const int cr = 32 * jb + (r & 3) + 8 * (r >> 2);
                float v = __builtin_fmaf(S[jb][r], sc, __builtin_fmaf(slope2, (float)cr, bbase));
                if (jb == 0) v = (dlo >= cr) ? -1e30f : v;
                if (jb == 4) v = (dlo < cr - 128) ? -1e30f : v;
                v = dead ? -1e30f : v;
                S[jb][r] = v; mx = fmaxf(mx, v); } }
        mx = fmaxf(mx, __shfl_xor(mx, 32));
        float l = 0.f;
#pragma unroll
        for (int jb = 0; jb < 5; ++jb)
#pragma unroll
            for (int r = 0; r < 16; ++r) { const float e = __builtin_amdgcn_exp2f(S[jb][r] - mx); S[jb][r] = e; l += e; }
        l += __shfl_xor(l, 32);
        const float inv = 1.0f / (l + __builtin_amdgcn_exp2f(sink2 - mx));
        bf16x8 pf[5][2];
#pragma unroll
        for (int jb = 0; jb < 5; ++jb) { pf[jb][0] = pack8(S[jb], 0); pf[jb][1] = pack8(S[jb], 8); }
        bf16* orow = MIX + row * D + h * 64 + 4 * hi;
#pragma unroll
        for (int db = 0; db < 2; ++db) {
            f32x16 o = (f32x16){0.f, 0.f, 0.f, 0.f, 0.f, 0.f, 0.f, 0.f, 0.f, 0.f, 0.f, 0.f, 0.f, 0.f, 0.f, 0.f};
#pragma unroll
            for (int jb = 0; jb < 5; ++jb)
#pragma unroll
                for (int s = 0; s < 2; ++s) { const LAS unsigned char* vp = Vl + db * 16384 + (32 * (wq + jb) + 16 * s) * 64 + vlane;
                    const s16x4 lo = ldtr(vp), hh = ldtr(vp + 8 * 64);
                    const bf16x8 a = (bf16x8){lo[0], lo[1], lo[2], lo[3], hh[0], hh[1], hh[2], hh[3]};
                    o = __builtin_amdgcn_mfma_f32_32x32x16_bf16(a, pf[jb][s], o, 0, 0, 0); }
#pragma unroll
            for (int g4 = 0; g4 < 4; ++g4) { typedef unsigned u2 __attribute__((ext_vector_type(2))); u2 wv; wv.x = cvtpk(o[4 * g4] * inv, o[4 * g4 + 1] * inv); wv.y = cvtpk(o[4 * g4 + 2] * inv, o[4 * g4 + 3] * inv);
                *(u2*)(orow + 32 * db + 8 * g4) = wv; }
        }
        __builtin_amdgcn_sched_barrier(0);
    }
    __syncthreads();
}
namespace ml {
constexpr int QS = 0, KS = 16384, KT = 32768, VS0 = 49152, VS1 = 65536, CT0 = 81920, CT1 = 114688, NS = 147456, PS = 148480, GS = 156672, WS = 157696, END = 162816;
static_assert(END <= PH_LDS, "mLSTM LDS map");
constexpr float L2E = 1.4426950408889634f;
}
__device__ __forceinline__ void mlstm_seq(Frame& F, int b, int h, const bf16* P, const float* gpre, const float* bg, const float* cw, const float* cb, bf16* MIX) {
    using namespace ml;
    const int tid = F.tid, lane = F.lane, w = F.wave, r32 = lane & 31, hi = lane >> 5, vb = w & 3, tb = w >> 2;
    LAS unsigned char* L = F.lds;
    const int chg = tid & 31, run = tid >> 5, cc = chg & 15, t0 = 4 * run; const bool isk = chg >= 16;
    const int cch = (isk ? 512 : 0) + h * 128 + 8 * cc;
    for (int i = tid; i < 32768 / 16; i += NWAVES * 64) *(LAS v4u*)(L + CT0 + 16 * i) = (v4u){0u, 0u, 0u, 0u};
    if (tid < 256) ((LAS float*)(L + NS))[tid] = 0.f;
    if (run == 0) { LAS float* wl = (LAS float*)(L + WS) + chg * 40;
        for (int j = 0; j < 4; ++j) for (int e = 0; e < 8; ++e) wl[j * 8 + e] = cw[j * 1024 + cch + e];
        for (int e = 0; e < 8; ++e) wl[32 + e] = cb[cch + e]; }
    const float bi = bg[h], bfb = bg[4 + h];
    float mprev = 0.f;
    f32x16 Cacc[2];
#pragma unroll
    for (int i = 0; i < 2; ++i) Cacc[i] = (f32x16){0.f, 0.f, 0.f, 0.f, 0.f, 0.f, 0.f, 0.f, 0.f, 0.f, 0.f, 0.f, 0.f, 0.f, 0.f, 0.f};
    const size_t rowb = (size_t)b * SEQ;
    const bf16* rawp = P + O_MQ + cch;
    const bf16* vsrc = P + (rowb + (lane >> 2)) * NP + O_MV + h * 128 + 8 * (lane & 3);
    v4u raw[7]; float gin, gfn;
#pragma unroll
    for (int k = 0; k < 7; ++k) { const int t = t0 - 3 + k; raw[k] = (t >= 0) ? *(const v4u*)(rawp + (rowb + t) * NP) : (v4u){0u, 0u, 0u, 0u}; }
    gin = gpre[(rowb + lane) * 8 + h]; gfn = gpre[(rowb + lane) * 8 + 4 + h];
#pragma unroll
    for (int i = 0; i < 2; ++i) { const int p = w + 8 * i; GLDS16(vsrc + (size_t)(16 * (p & 3)) * NP + 32 * (p >> 2), L + VS0 + p * 1024); }
    __syncthreads();
    const int zsw = (r32 & 15);
    const int vlane = (4 * hi + ((lane & 15) >> 2)) * 64 + (16 * ((lane >> 4) & 1) + 4 * (lane & 3)) * 2;
    for (int c = 0; c < SEQ / 64; ++c) {
        const int par = c & 1;
        const float gi = gin + bi, gf = gfn + bfb;
        const float lf = fminf(gf, 0.f) - log1pf(__expf(-fabsf(gf)));
        float bs = lf;
#pragma unroll
        for (int o = 1; o < 64; o <<= 1) { const float v = __shfl_up(bs, o); if (lane >= o) bs += v; }
        const float u = gi - bs; float pm = u;
#pragma unroll
        for (int o = 1; o < 64; o <<= 1) { const float v = __shfl_up(pm, o); if (lane >= o) pm = fmaxf(pm, v); }
        const float Mt = fmaxf(mprev, pm);
        const float M63 = __shfl(Mt, 63), b63 = __shfl(bs, 63);
        const float decay = __expf(mprev - M63);
        const float wsl = __expf(u - M63);
        if (w == 0) { LAS float* g = (LAS float*)(L + GS); g[lane] = u * L2E; g[64 + lane] = Mt * L2E; g[128 + lane] = __expf(mprev - Mt); g[192 + lane] = __expf(-(bs + Mt)); }
        {
            const LAS float* wl = (const LAS float*)(L + WS) + chg * 40;
            float wt[4][8], bb[8];
#pragma unroll
            for (int j = 0; j < 4; ++j) { const f32x4 a = *(const LAS f32x4*)(wl + j * 8), bq = *(const LAS f32x4*)(wl + j * 8 + 4);
#pragma unroll
                for (int e = 0; e < 4; ++e) { wt[j][e] = a[e]; wt[j][4 + e] = bq[e]; } }
            { const f32x4 a = *(const LAS f32x4*)(wl + 32), bq = *(const LAS f32x4*)(wl + 36);
#pragma unroll
              for (int e = 0; e < 4; ++e) { bb[e] = a[e]; bb[4 + e] = bq[e]; } }
            float psum[8];
#pragma unroll
            for (int e = 0; e < 8; ++e) psum[e] = 0.f;
#pragma unroll
            for (int i = 0; i < 4; ++i) {
                const int t = t0 + i; const float wsr = __shfl(wsl, t);
                float y[8];
#pragma unroll
                for (int e = 0; e < 8; ++e) y[e] = bb[e];
#pragma unroll
                for (int j = 0; j < 4; ++j)
#pragma unroll
                    for (int q = 0; q < 4; ++q) { y[2 * q] += wt[j][2 * q] * bflo(raw[i + j][q]); y[2 * q + 1] += wt[j][2 * q + 1] * bfhi(raw[i + j][q]); }
#pragma unroll
                for (int e = 0; e < 8; ++e) y[e] = y[e] / (1.0f + __expf(-y[e]));
                const int sw = (cc ^ (t & 15)) * 16;
                if (!isk) { v4u o;
#pragma unroll
                    for (int q = 0; q < 4; ++q) o[q] = cvtpk(y[2 * q] * 0.08838834764831845f, y[2 * q + 1] * 0.08838834764831845f);
                    *(LAS v4u*)(L + QS + t * 256 + sw) = o;
                } else { v4u o, o2;
#pragma unroll
                    for (int q = 0; q < 4; ++q) { o[q] = cvtpk(y[2 * q], y[2 * q + 1]); o2[q] = cvtpk(y[2 * q] * wsr, y[2 * q + 1] * wsr); }
#pragma unroll
                    for (int e = 0; e < 8; ++e) psum[e] += y[e] * wsr;
                    *(LAS v4u*)(L + KS + t * 256 + sw) = o;
                    *(LAS v4u*)(L + KT + (cc >> 2) * 4096 + t * 64 + (cc & 3) * 16) = o2;
                }
            }
            if (isk) { LAS float* ps = (LAS float*)(L + PS) + run * 128 + 8 * cc; *(LAS f32x4*)ps = (f32x4){psum[0], psum[1], psum[2], psum[3]}; *(LAS f32x4*)(ps + 4) = (f32x4){psum[4], psum[5], psum[6], psum[7]}; }
        }
        asm volatile("s_waitcnt vmcnt(0)" ::: "memory"); __syncthreads();
        const size_t row0 = rowb + (size_t)c * 64;
        if (c + 1 < SEQ / 64) {
#pragma unroll
            for (int k = 0; k < 7; ++k) raw[k] = *(const v4u*)(rawp + (row0 + 64 + t0 - 3 + k) * NP);
            gin = gpre[(row0 + 64 + lane) * 8 + h]; gfn = gpre[(row0 + 64 + lane) * 8 + 4 + h];
#pragma unroll
            for (int i = 0; i < 2; ++i) { const int p = w + 8 * i; GLDS16(vsrc + (size_t)((c + 1) * 64 + 16 * (p & 3)) * NP + 32 * (p >> 2), L + (par ? VS0 : VS1) + p * 1024); }
        }
        const size_t trow = row0 + 32 * tb + r32;
        typedef unsigned u2 __attribute__((ext_vector_type(2)));
        u2 mo[4];
#pragma unroll
        for (int g4 = 0; g4 < 4; ++g4) mo[g4] = *(const u2*)(P + trow * NP + O_MO + h * 128 + 32 * vb + 8 * g4 + 4 * hi);
        const LAS unsigned char* Vl = L + (par ? VS1 : VS0);
        const LAS unsigned char* Cr = L + (par ? CT1 : CT0); LAS unsigned char* Cw = L + (par ? CT0 : CT1);
        const LAS float* nr = (const LAS float*)(L + NS) + par * 128; LAS float* nw = (LAS float*)(L + NS) + (par ^ 1) * 128;
        const LAS float* g = (const LAS float*)(L + GS);
        const int tl = 32 * tb + r32;
        const float M2 = g[64 + tl], wi = g[128 + tl], ef = g[192 + tl];
        bf16x8 qf[8];
#pragma unroll
        for (int ks = 0; ks < 8; ++ks) qf[ks] = *(const LAS bf16x8*)(L + QS + tl * 256 + (((2 * ks + hi) ^ zsw) * 16));
        float qn = 0.f;
#pragma unroll
        for (int ks = 0; ks < 8; ++ks) { const f32x4 n0 = *(const LAS f32x4*)(nr + 16 * ks + 8 * hi), n1 = *(const LAS f32x4*)(nr + 16 * ks + 8 * hi + 4);
#pragma unroll
            for (int j = 0; j < 4; ++j) { qn += bf2f((unsigned short)qf[ks][j]) * n0[j]; qn += bf2f((unsigned short)qf[ks][4 + j]) * n1[j]; } }
        qn += __shfl_xor(qn, 32);
        f32x16 o = (f32x16){0.f, 0.f, 0.f, 0.f, 0.f, 0.f, 0.f, 0.f, 0.f, 0.f, 0.f, 0.f, 0.f, 0.f, 0.f, 0.f};
#pragma unroll
        for (int ks = 0; ks < 8; ++ks) { const bf16x8 a = *(const LAS bf16x8*)(Cr + (32 * vb + r32) * 256 + (((2 * ks + hi) ^ zsw) * 16)); o = __builtin_amdgcn_mfma_f32_32x32x16_bf16(a, qf[ks], o, 0, 0, 0); }
#pragma unroll
        for (int r = 0; r < 16; ++r) o[r] *= wi;
        bf16x8 vf[4];
#pragma unroll
        for (int s4 = 0; s4 < 4; ++s4) { const LAS unsigned char* vp = Vl + vb * 4096 + (16 * s4) * 64 + vlane; const s16x4 lo = ldtr(vp), hh = ldtr(vp + 8 * 64);
            vf[s4] = (bf16x8){lo[0], lo[1], lo[2], lo[3], hh[0], hh[1], hh[2], hh[3]}; }
        float dsum = 0.f;
#pragma unroll
        for (int sb = 0; sb < 2; ++sb) if (sb <= tb) {
            f32x16 S = (f32x16){0.f, 0.f, 0.f, 0.f, 0.f, 0.f, 0.f, 0.f, 0.f, 0.f, 0.f, 0.f, 0.f, 0.f, 0.f, 0.f};
#pragma unroll
            for (int ks = 0; ks < 8; ++ks) { const bf16x8 a = *(const LAS bf16x8*)(L + KS + (32 * sb + r32) * 256 + (((2 * ks + hi) ^ zsw) * 16)); S = __builtin_amdgcn_mfma_f32_32x32x16_bf16(a, qf[ks], S, 0, 0, 0); }
#pragma unroll
            for (int g4 = 0; g4 < 4; ++g4) { const f32x4 uu = *(const LAS f32x4*)(g + 32 * sb + 8 * g4 + 4 * hi);
#pragma unroll
                for (int e = 0; e < 4; ++e) { const int r = 4 * g4 + e; const int sl = 32 * sb + 8 * g4 + 4 * hi + e;
                    const float gm = (sl <= tl) ? __builtin_amdgcn_exp2f(uu[e] - M2) : 0.f; const float v = S[r] * gm; S[r] = v; dsum += v; } }
            o = __builtin_amdgcn_mfma_f32_32x32x16_bf16(vf[2 * sb], pack8(S, 0), o, 0, 0, 0);
            o = __builtin_amdgcn_mfma_f32_32x32x16_bf16(vf[2 * sb + 1], pack8(S, 8), o, 0, 0, 0);
        }
        dsum += __shfl_xor(dsum, 32);
        const float den = wi * qn + dsum;
        const float rden = 1.0f / fmaxf(fabsf(den), ef);
        { bf16* op = MIX + trow * D + 512 + h * 128 + 32 * vb + 4 * hi;
#pragma unroll
          for (int g4 = 0; g4 < 4; ++g4) { float x[4];
#pragma unroll
              for (int e = 0; e < 4; ++e) { const float og = (e & 1) ? bfhi(mo[g4][e >> 1]) : bflo(mo[g4][e >> 1]); x[e] = o[4 * g4 + e] * rden / (1.0f + __expf(-og)); }
              u2 wv; wv.x = cvtpk(x[0], x[1]); wv.y = cvtpk(x[2], x[3]); *(u2*)(op + 8 * g4) = wv; } }
#pragma unroll
        for (int i = 0; i < 2; ++i) {
#pragma unroll
            for (int r = 0; r < 16; ++r) Cacc[i][r] *= decay;
#pragma unroll
            for (int s4 = 0; s4 < 4; ++s4) { const LAS unsigned char* kp = L + KT + (2 * tb + i) * 4096 + (16 * s4) * 64 + vlane; const s16x4 lo = ldtr(kp), hh = ldtr(kp + 8 * 64);
                const bf16x8 a = (bf16x8){lo[0], lo[1], lo[2], lo[3], hh[0], hh[1], hh[2], hh[3]};
                Cacc[i] = __builtin_amdgcn_mfma_f32_32x32x16_bf16(a, vf[s4], Cacc[i], 0, 0, 0); }
            const int dv = 32 * vb + r32;
#pragma unroll
            for (int g4 = 0; g4 < 4; ++g4) { const int ch = 4 * (2 * tb + i) + g4; u2 wv; wv.x = cvtpk(Cacc[i][4 * g4], Cacc[i][4 * g4 + 1]); wv.y = cvtpk(Cacc[i][4 * g4 + 2], Cacc[i][4 * g4 + 3]);
                *(LAS u2*)(Cw + dv * 256 + ((ch ^ (dv & 15)) * 16) + 8 * hi) = wv; }
        }
        if (tid < 128) { float s = 0.f; const LAS float* ps = (const LAS float*)(L + PS) + tid;
#pragma unroll
            for (int q = 0; q < 16; ++q) s += ps[q * 128];
            nw[tid] = decay * nr[tid] + s; }
        mprev = b63 + M63;
        __syncthreads();
    }
}
__device__ __forceinline__ void p2_mix_naive(Frame& F, const Args& a) {
    const bf16* P = (const bf16*)(a.ws + WS_P); bf16* MIX = (bf16*)(a.ws + WS_MIX);
    const int NSEQ = BATCH * 4;
    if ((int)blockIdx.x < NSEQ && F.G > NSEQ) {
        mlstm_seq(F, (int)blockIdx.x >> 2, (int)blockIdx.x & 3, P, (const float*)(a.ws + WS_GPRE), a.in[4], a.in[5], a.in[6], MIX);
    } else {
        const int nb = F.G > NSEQ ? F.G - NSEQ : F.G, b0 = F.G > NSEQ ? (int)blockIdx.x - NSEQ : (int)blockIdx.x;
        for (int u = b0; u < BATCH * 2 * 16; u += nb) swa_unit(F, u >> 5, (u >> 4) & 1, u & 15, P, a.in[7], MIX);
    }
}
__device__ __forceinline__ void p5_xattn_naive(Frame& F, const Args& a) {
    const bf16* QX = (const bf16*)(a.ws + WS_QX); const bf16* KVM = (const bf16*)(a.ws + WS_KVM); bf16* XO = (bf16*)(a.ws + WS_XO); const float* ssq1 = (const float*)(a.ws + WS_SSQ1);
    const int half = F.tid >> 8, t = F.tid & 255;
    LAS float* q = (LAS float*)F.lds + half * 1536; LAS float* av = q + 1024; LAS float* red = av + 256;
    for (int row0 = 2 * (int)blockIdx.x; row0 < M; row0 += 2 * F.G) {
        const int row = row0 + half, b = row / SEQ;
        float ss = 0.f;
        for (int i = 0; i < 16; ++i) ss += ssq1[(size_t)row * 16 + i];
        const float rstd = 1.0f / sqrtf(ss * (1.0f / 1024.0f) + EPS);
        __syncthreads();
        for (int i = t; i < 1024; i += 256) q[i] = bf2f(QX[(size_t)row * 1024 + i]) * rstd;
        __syncthreads();
        for (int h = 0; h < 4; ++h) {
            const bf16* kp = KVM + (size_t)(b * MEMLEN + t) * 2048 + h * 256;
            float s = 0.f;
            for (int d = 0; d < 256; ++d) s += q[h * 256 + d] * bf2f(kp[d]);
            s *= 0.0625f;
            float mx = s;
            for (int o = 32; o > 0; o >>= 1) mx = fmaxf(mx, __shfl_xor(mx, o));
            if ((t & 63) == 0) red[t >> 6] = mx;
            __syncthreads();
            mx = fmaxf(fmaxf(red[0], red[1]), fmaxf(red[2], red[3]));
            const float e = expf(s - mx);
            float sm = e;
            for (int o = 32; o > 0; o >>= 1) sm += __shfl_xor(sm, o);
            if ((t & 63) == 0) red[4 + (t >> 6)] = sm;
            av[t] = e;
            __syncthreads();
            sm = red[4] + red[5] + red[6] + red[7];
            float o = 0.f;
            for (int m2 = 0; m2 < 256; ++m2) o += av[m2] * bf2f(KVM[(size_t)(b * MEMLEN + m2) * 2048 + 1024 + h * 256 + t]);
            XO[(size_t)row * 1024 + h * 256 + t] = (bf16)f2bf(o / sm);
            __syncthreads();
        }
    }
}
__device__ __forceinline__ void p0_prologue(Frame& F, const Args& a) {
    unsigned char* ws = a.ws;
    LAS float* scr = (LAS float*)(F.lds + F.wave * 8448);
    LAS float* wgT = (LAS float*)(F.lds + 73728);
    const int gw = F.vcu * NWAVES + F.wave, NGW = F.G * NWAVES;
    {
        const float* w_in = a.in[3]; const float* gm = a.in[2];
        for (int i = F.tid; i < 8192; i += NWAVES * 64) { const int k = i >> 3, c = i & 7; wgT[c * 1024 + k] = gm[k] * w_in[(size_t)k * IN_COLS + O_G + c]; }
    }
    constexpr int I_IN = 16 * (NP / 32), I_KV = 16 * 64, I_SQ = 16 * 32, I_UP = 16 * (NU / 32), I_DN = (FF / 64) * 32;
    constexpr int NITEMS = I_IN + I_KV + 3 * I_SQ + I_UP + I_DN;
    for (int it = gw; it < NITEMS; it += NGW) {
        int r = it;
        if (r < I_IN) { const int nb = r % (NP / 32), kb = r / (NP / 32); p0_transpose_item(a.in[3], D, IN_COLS, 32 * nb, a.in[2], (bf16*)(ws + WS_WIN), 32 * nb, scr, kb, F.lane); continue; } r -= I_IN;
        if (r < I_KV) { const int nb = r % 64, kb = r / 64; p0_transpose_item(a.in[12], D, 2048, 32 * nb, a.in[10], (bf16*)(ws + WS_WKV), 32 * nb, scr, kb, F.lane); continue; } r -= I_KV;
        if (r < I_SQ) { const int nb = r % 32, kb = r / 32; p0_transpose_item(a.in[8], D, D, 32 * nb, nullptr, (bf16*)(ws + WS_WOUT), 32 * nb, scr, kb, F.lane); continue; } r -= I_SQ;
        if (r < I_SQ) { const int nb = r % 32, kb = r / 32; p0_transpose_item(a.in[11], D, D, 32 * nb, a.in[9], (bf16*)(ws + WS_WQ), 32 * nb, scr, kb, F.lane); continue; } r -= I_SQ;
        if (r < I_SQ) { const int nb = r % 32, kb = r / 32; p0_transpose_item(a.in[13], D, D, 32 * nb, nullptr, (bf16*)(ws + WS_WO), 32 * nb, scr, kb, F.lane); continue; } r -= I_SQ;
        if (r < I_UP) { const int nb = r % (NU / 32), kb = r / (NU / 32); p0_transpose_item(a.in[15], D, NU, 32 * nb, a.in[14], (bf16*)(ws + WS_WUP), 32 * nb, scr, kb, F.lane); continue; } r -= I_UP;
        { const int nb = r % 32, kb = r / 32; p0_transpose_item(a.in[18], FF, D, 32 * nb, nullptr, (bf16*)(ws + WS_WDN), 32 * nb, scr, kb, F.lane); }
    }
    __syncthreads();
    float* rstd0 = (float*)(ws + WS_RSTD0); float* gpre = (float*)(ws + WS_GPRE); bf16* XB = (bf16*)(ws + WS_XB);
    for (int m = gw; m < M; m += NGW) {
        f32x4 v[4];
        const float ssq = row_to_bf16(a.in[0] + (size_t)m * D, XB + (size_t)m * D, F.lane, v);
        const float rstd = 1.0f / sqrtf(ssq * (1.0f / D) + EPS);
        float ga[8];
#pragma unroll
        for (int c = 0; c < 8; ++c) { float s = 0.f;
#pragma unroll
            for (int j = 0; j < 4; ++j) { const f32x4 w = *(const LAS f32x4*)(wgT + c * 1024 + 256 * j + 4 * F.lane); s += (v[j][0] * w[0] + v[j][1] * w[1]) + (v[j][2] * w[2] + v[j][3] * w[3]); }
            ga[c] = wave_sum(s) * rstd; }
        if (F.lane == 0) { rstd0[m] = rstd; *(f32x4*)(gpre + (size_t)m * 8) = (f32x4){ga[0], ga[1], ga[2], ga[3]}; *(f32x4*)(gpre + (size_t)m * 8 + 4) = (f32x4){ga[4], ga[5], ga[6], ga[7]}; }
    }
    float* rstdm = (float*)(ws + WS_RSTDM); bf16* MEMB = (bf16*)(ws + WS_MEMB);
    for (int m = gw; m < MMEM; m += NGW) {
        f32x4 v[4];
        const float ssq = row_to_bf16(a.in[1] + (size_t)m * D, MEMB + (size_t)m * D, F.lane, v);
        if (F.lane == 0) rstdm[m] = 1.0f / sqrtf(ssq * (1.0f / D) + EPS);
    }
}
__device__ __forceinline__ void p8_act(Frame& F, const Args& a) {
    bf16* U = (bf16*)(a.ws + WS_U); const float* cw = a.in[16]; const float* cb = a.in[17];
    constexpr int NCH = FF / 8, RUN = 16, NIT = (M / RUN) * NCH;
    for (int it = blockIdx.x * (NWAVES * 64) + F.tid; it < NIT; it += F.G * NWAVES * 64) {
        const int ch = it % NCH, r = it / NCH, row0 = r * RUN, t0 = row0 % SEQ, c0 = ch * 8;
        float w0[8], w1[8], w2[8], bb[8];
#pragma unroll
        for (int e = 0; e < 8; e += 4) { const f32x4 x0 = *(const f32x4*)(cw + c0 + e), x1 = *(const f32x4*)(cw + FF + c0 + e), x2 = *(const f32x4*)(cw + 2 * FF + c0 + e), x3 = *(const f32x4*)(cb + c0 + e);
#pragma unroll
            for (int q = 0; q < 4; ++q) { w0[e + q] = x0[q]; w1[e + q] = x1[q]; w2[e + q] = x2[q]; bb[e + q] = x3[q]; } }
        v4u gm2 = (v4u){0u, 0u, 0u, 0u}, gm1 = gm2;
        if (t0 >= 2) { gm2 = *(const v4u*)(U + (size_t)(row0 - 2) * NU + c0); gm1 = *(const v4u*)(U + (size_t)(row0 - 1) * NU + c0); }
#pragma unroll 4
        for (int i = 0; i < RUN; ++i) {
            bf16* rp = U + (size_t)(row0 + i) * NU;
            const v4u g0 = *(const v4u*)(rp + c0), vv = *(const v4u*)(rp + FF + c0);
            v4u o;
#pragma unroll
            for (int q = 0; q < 4; ++q) {
                const float ga = w0[2 * q] * bflo(gm2[q]) + w1[2 * q] * bflo(gm1[q]) + w2[2 * q] * bflo(g0[q]) + bb[2 * q];
                const float gb = w0[2 * q + 1] * bfhi(gm2[q]) + w1[2 * q + 1] * bfhi(gm1[q]) + w2[2 * q + 1] * bfhi(g0[q]) + bb[2 * q + 1];
                const float ra = ga / (1.0f + __expf(-ga)) * bflo(vv[q]), rb = gb / (1.0f + __expf(-gb)) * bfhi(vv[q]);
                o[q] = pk2(ra, rb);
            }
            *(v4u*)(rp + FF + c0) = o;
            gm2 = gm1; gm1 = g0;
        }
    }
}
__device__ __forceinline__ void p10_final(Frame& F, const Args& a) {
    const int gw = F.vcu * NWAVES + F.wave, NGW = F.G * NWAVES;
    const float* gf = a.in[19]; const pg8::RsParts rs{(const float*)(a.ws + WS_SSQ3)};
    f32x4 gv[4];
#pragma unroll
    for (int j = 0; j < 4; ++j) gv[j] = ((const f32x4*)gf)[64 * j + F.lane];
    for (int m = gw; m < M; m += NGW) {
        const float r = rs.get(m);
        GAS f32x4* xr = (GAS f32x4*)(a.out + (size_t)m * D) + F.lane;
#pragma unroll
        for (int j = 0; j < 4; ++j) { const f32x4 v = xr[64 * j]; xr[64 * j] = v * r * gv[j]; }
    }
}

#ifndef PG8_SP2
#define PG8_SP2 true
#endif
#ifndef PG8_ALIGN
#define PG8_ALIGN true
#endif
enum { PH_PRO = 0, PH_G1 = 1, PH_MIX = 2, PH_G2 = 3, PH_G3 = 4, PH_XAT = 5, PH_G4 = 6, PH_G5 = 7, PH_ACT = 8, PH_G6 = 9, PH_FIN = 10, PH_N = 11 };

__device__ __forceinline__ bool phase_in(Frame& F, int lo, int hi, int k) {
    if (!(lo <= k && k < hi)) return false;
    int t_ = threadIdx.x; asm volatile("" : "+v"(t_)); F.tid = t_; F.lane = t_ & 63; return true;
}
__global__ void __launch_bounds__(NWAVES * 64, 2) mk_fwd(Args args) {
    extern __shared__ __attribute__((aligned(16))) unsigned char lds[];
    Frame F;
    F.lds = (LAS unsigned char*)lds;
    F.MISC = (volatile LAS unsigned*)(F.lds + MISC_OFF);
    F.tid = threadIdx.x; F.lane = F.tid & 63; F.wave = __builtin_amdgcn_readfirstlane(F.tid >> 6);
    F.G = gridDim.x; { const int bx = blockIdx.x; F.vcu = (F.G % 8 == 0) ? (bx % 8) * (F.G / 8) + bx / 8 : bx; }
    unsigned char* ws = args.ws;
    F.ctl = (gu32*)(ws + WS_CTL);
    for (int u = F.tid; u < (LDS_BYTES - LDSCTL_OFF) / 4; u += NWAVES * 64) ((LAS unsigned*)(F.lds + LDSCTL_OFF))[u] = 0u;
    __syncthreads();
    const int lo = args.ph_lo, hi = args.ph_hi;
    XcdBarrier bar = xcd_barrier_post((unsigned*)(F.ctl + CW_BAR) + args.li * XCD_BAR_WORDS, F.MISC + 8);
#define IN(k) (phase_in(F, lo, hi, (k)))
#define SEAM(k) do { if (lo <= (k) && (k) + 1 < hi) xcd_barrier(bar); } while (0)
    bf16* XB = (bf16*)(ws + WS_XB); bf16* P = (bf16*)(ws + WS_P); bf16* MIX = (bf16*)(ws + WS_MIX); bf16* QX = (bf16*)(ws + WS_QX); bf16* XO = (bf16*)(ws + WS_XO); bf16* U = (bf16*)(ws + WS_U);
    const int G = F.G, bx = (int)blockIdx.x;

    if (IN(PH_PRO)) { p0_prologue(F, args); SEAM(PH_PRO); }
    if (IN(PH_G1)) {
        { pg8::Gemm g{XB, D, (const bf16*)(ws + WS_WIN), M, NP, D}; pg8::StaticOrder S; S.init(M, NP, G, bx);
          pg8::EpiScaleBf16<pg8::RsArr> E{P, NP, {(const float*)(ws + WS_RSTD0)}};
          pg8::gemm_phase<pg8::EpiScaleBf16<pg8::RsArr>, pg8::StaticOrder, PG8_ALIGN, PG8_SP2>(F.lds + RING_OFF, g, S, E); }
        { pg8::Gemm g{(const bf16*)(ws + WS_MEMB), D, (const bf16*)(ws + WS_WKV), MMEM, 2048, D}; pg8::StaticOrder S; S.init(MMEM, 2048, G, (bx + G / 2) % G);
          pg8::EpiScaleBf16<pg8::RsArr> E{(bf16*)(ws + WS_KVM), 2048, {(const float*)(ws + WS_RSTDM)}};
          pg8::gemm_phase<pg8::EpiScaleBf16<pg8::RsArr>, pg8::StaticOrder, PG8_ALIGN, PG8_SP2>(F.lds + RING_OFF, g, S, E); }
        SEAM(PH_G1);
    }
    if (IN(PH_MIX)) { p2_mix_naive(F, args); SEAM(PH_MIX); }
    if (IN(PH_G2)) {
        pg8::Gemm g{MIX, D, (const bf16*)(ws + WS_WOUT), M, D, D}; pg8::StaticOrder S; S.init(M, D, G, bx);
        pg8::EpiResid<true> E{args.in[0], args.out, XB, (float*)(ws + WS_SSQ1), D};
        pg8::gemm_phase<pg8::EpiResid<true>, pg8::StaticOrder, PG8_ALIGN, PG8_SP2>(F.lds + RING_OFF, g, S, E);
        SEAM(PH_G2);
    }
    if (IN(PH_G3)) {
        pg8::Gemm g{XB, D, (const bf16*)(ws + WS_WQ), M, D, D}; pg8::StaticOrder S; S.init(M, D, G, bx);
        pg8::EpiScaleBf16<pg8::RsOne> E{QX, D, {}};
        pg8::gemm_phase<pg8::EpiScaleBf16<pg8::RsOne>, pg8::StaticOrder, PG8_ALIGN, PG8_SP2>(F.lds + RING_OFF, g, S, E);
        SEAM(PH_G3);
    }
    if (IN(PH_XAT)) { p5_xattn(F, args); SEAM(PH_XAT); }
    if (IN(PH_G4)) {
        pg8::Gemm g{XO, D, (const bf16*)(ws + WS_WO), M, D, D}; pg8::StaticOrder S; S.init(M, D, G, bx);
        pg8::EpiResid<true> E{args.out, args.out, XB, (float*)(ws + WS_SSQ2), D};
        pg8::gemm_phase<pg8::EpiResid<true>, pg8::StaticOrder, PG8_ALIGN, PG8_SP2>(F.lds + RING_OFF, g, S, E);
        SEAM(PH_G4);
    }
    if (IN(PH_G5)) {
        pg8::Gemm g{XB, D, (const bf16*)(ws + WS_WUP), M, NU, D}; pg8::StaticOrder S; S.init(M, NU, G, bx);
        pg8::EpiScaleBf16<pg8::RsParts> E{U, NU, {(const float*)(ws + WS_SSQ2)}};
        pg8::gemm_phase<pg8::EpiScaleBf16<pg8::RsParts>, pg8::StaticOrder, PG8_ALIGN, PG8_SP2>(F.lds + RING_OFF, g, S, E);
        SEAM(PH_G5);
    }
    if (IN(PH_ACT)) { p8_act(F, args); SEAM(PH_ACT); }
    if (IN(PH_G6)) {
        pg8::Gemm g{U + FF, NU, (const bf16*)(ws + WS_WDN), M, D, FF}; pg8::StaticOrder S; S.init(M, D, G, bx);
        pg8::EpiResid<false> E{args.out, args.out, nullptr, (float*)(ws + WS_SSQ3), D};
        pg8::gemm_phase<pg8::EpiResid<false>, pg8::StaticOrder, PG8_ALIGN, PG8_SP2>(F.lds + RING_OFF, g, S, E);
        SEAM(PH_G6);
    }
    if (IN(PH_FIN)) { p10_final(F, args); }
#undef IN
#undef SEAM
}
extern "C" void kernel_launch(void* const* d_in, const int* in_sizes, int n_in, void* d_out, int out_size, void* d_ws, size_t ws_size, hipStream_t stream) {
    static int grid = 0;
    if (grid == 0) {
        if (n_in != 20 || in_sizes[0] != M * D || out_size != M * D || ws_size < WS_END) { fprintf(stderr, "kernel_launch: shape/workspace mismatch: n_in %d in0 %d out %d ws %zu (need %zu)\n", n_in, n_in > 0 ? in_sizes[0] : -1, out_size, ws_size, (size_t)WS_END); grid = -1; return; }
        int dev = 0, cus = 0, per_cu = 0;
        if (hipGetDevice(&dev) != hipSuccess || hipDeviceGetAttribute(&cus, hipDeviceAttributeMultiprocessorCount, dev) != hipSuccess) { fprintf(stderr, "kernel_launch: device query failed\n"); grid = -1; return; }
        if (hipFuncSetAttribute((const void*)mk_fwd, hipFuncAttributeMaxDynamicSharedMemorySize, LDS_BYTES) != hipSuccess) { fprintf(stderr, "kernel_launch: hipFuncSetAttribute failed\n"); grid = -1; return; }
        if (hipOccupancyMaxActiveBlocksPerMultiprocessor(&per_cu, (const void*)mk_fwd, NWAVES * 64, LDS_BYTES) != hipSuccess || per_cu < 1) { fprintf(stderr, "kernel_launch: occupancy query reports %d workgroups per CU\n", per_cu); (void)hipGetLastError(); grid = -1; return; }
        grid = cus;
    }
    if (grid < 0) return;
    (void)hipMemsetAsync((char*)d_ws + WS_CTL, 0, CTL_ZERO_BYTES, stream);
    Args a{};
    for (int i = 0; i < 20; ++i) a.in[i] = (const float*)d_in[i];
    a.out = (float*)d_out; a.ws = (unsigned char*)d_ws;
    unsigned char* ws = (unsigned char*)d_ws;
    auto launch = [&](int lo, int hi, int li) { a.ph_lo = lo; a.ph_hi = hi; a.li = li; hipLaunchKernelGGL(mk_fwd, dim3(grid), dim3(NWAVES * 64), LDS_BYTES, stream, a); };
    launch(PH_PRO, PH_N, 0);
}
```

```cpp
#include <hip/hip_runtime.h>
#include <cstdio>
#include <cstdint>
namespace pg8 {
#define PG8_LAS __attribute__((address_space(3)))
typedef unsigned short bf16_t;
typedef short bf16x8 __attribute__((ext_vector_type(8)));
typedef float f32x4 __attribute__((ext_vector_type(4)));
typedef unsigned u32x4 __attribute__((ext_vector_type(4)));
constexpr int BM = 256, BK = 64, HALF = 128, HTB = HALF * BK * 2  , STAGE_BYTES = 8 * HTB, NXCD = 8, WGM = 8;

__host__ __device__ __forceinline__ int lds_byte(int r, int c) { const int st = (r >> 4) * 2 + (c >> 5), rr = r & 15, cc = c & 31, ob = rr * 64 + cc * 2; return st * 1024 + (ob ^ (((ob >> 9) & 1) << 5)); }
__host__ __device__ __forceinline__ void stage_rc(int b, int& R, int& C) { const int st = b / 1024, sb = b % 1024, swz = sb ^ (((sb >> 9) & 1) << 5); R = (st >> 1) * 16 + swz / 64; C = (st & 1) * 32 + (swz % 64) / 2; }
__host__ __device__ __forceinline__ int perm32(int rho) { const int n = rho >> 4, i = rho & 15; return 8 * (i >> 2) + 4 * n + (i & 3); }

struct Unit { int pm, pn; };
struct Gemm { const bf16_t* A; int lda; const bf16_t* Bt; int M, N, K; };

struct StaticOrder {
    int nM, nN, nwg, G, c;
    __host__ __device__ void init(int M, int N, int G_, int c_) { nM = M / BM; nN = N / BM; nwg = nM * nN; G = G_; c = c_; }
    __host__ __device__ bool next(int i, Unit& u) const {
        const long L = (long)i * G + c; if (L >= nwg) return false;
        int wgid = (int)L; { const int q = nwg / NXCD, r = nwg % NXCD, xcd = wgid % NXCD, off = wgid / NXCD; wgid = (xcd < r ? xcd * (q + 1) : r * (q + 1) + (xcd - r) * q) + off; }
        const int nig = WGM * nN, gid = wgid / nig, fm = gid * WGM, gsz = (nM - fm) < WGM ? (nM - fm) : WGM;
        u.pm = fm + ((wgid % nig) % gsz); u.pn = (wgid % nig) / gsz; return true;
    }
    __device__ __forceinline__ void a_ready(const Unit&) const {}
    __device__ __forceinline__ void done(const Unit&) const {}
};

__device__ __forceinline__ unsigned cvt_pk_bf16(float lo, float hi) { unsigned r; asm volatile("v_cvt_pk_bf16_f32 %0, %1, %2" : "=v"(r) : "v"(lo), "v"(hi)); return r; }
typedef float f32x2 __attribute__((ext_vector_type(2)));
constexpr float RMS_EPS = 1e-6f;
struct RsOne   { __device__ __forceinline__ float get(int) const { return 1.0f; } };
struct RsArr   { const float* r; __device__ __forceinline__ float get(int row) const { return r[row]; } };
struct RsParts { const float* p;
    __device__ __forceinline__ float get(int row) const { const f32x4* q = (const f32x4*)(p + (size_t)row * 16); const f32x4 a = q[0], b = q[1], c = q[2], d = q[3];
        const float s = ((a[0] + a[1]) + (a[2] + a[3])) + ((b[0] + b[1]) + (b[2] + b[3])) + ((c[0] + c[1]) + (c[2] + c[3])) + ((d[0] + d[1]) + (d[2] + d[3]));
        return 1.0f / sqrtf(s * (1.0f / 1024.0f) + RMS_EPS); } };
template <class RS> struct EpiScaleBf16 {
    static constexpr bool PERM = true, AFTER_DRAIN = false;
    bf16_t* O; int ldc; RS rs;
    __device__ __forceinline__ void operator()(const f32x4 (&acc)[2][2][4][2], const Unit& u, int wr, int wc, int fr, int fq) const {
        const int row0 = u.pm * BM + wr * 64 + fr, col0 = u.pn * BM + wc * 32 + 8 * fq;
#pragma unroll
        for (int ai = 0; ai < 2; ++ai)
#pragma unroll
            for (int m = 0; m < 4; ++m) { const int row = row0 + ai * HALF + m * 16; const float sc = rs.get(row); bf16_t* rowp = O + (size_t)row * ldc + col0;
#pragma unroll
                for (int bj = 0; bj < 2; ++bj) { const f32x4 v0 = acc[ai][bj][m][0] * sc, v1 = acc[ai][bj][m][1] * sc;
                    u32x4 w; w.x = cvt_pk_bf16(v0[0], v0[1]); w.y = cvt_pk_bf16(v0[2], v0[3]); w.z = cvt_pk_bf16(v1[0], v1[1]); w.w = cvt_pk_bf16(v1[2], v1[3]);
                    *(u32x4*)(rowp + bj * HALF) = w; } }
    }
};
template <bool WRITE_BF16> struct EpiResid {
    static constexpr bool PERM = false, AFTER_DRAIN = false;
    const float* base; float* out; bf16_t* xb; float* ssq; int ldc;
    __device__ __forceinline__ void operator()(const f32x4 (&acc)[2][2][4][2], const Unit& u, int wr, int wc, int fr, int fq) const {
        typedef unsigned u32x2v __attribute__((ext_vector_type(2)));
        const int row0 = u.pm * BM + wr * 64 + fr, col0 = u.pn * BM + wc * 32 + 4 * fq;
#pragma unroll
        for (int ai = 0; ai < 2; ++ai) {
            f32x4 pre[4][2][2];
#pragma unroll
            for (int m = 0; m < 4; ++m) { const size_t off = (size_t)(row0 + ai * HALF + m * 16) * ldc + col0;
#pragma unroll
                for (int bj = 0; bj < 2; ++bj)
#pragma unroll
                    for (int n = 0; n < 2; ++n) pre[m][bj][n] = *(const f32x4*)(base + off + bj * HALF + n * 16); }
#pragma unroll
            for (int m = 0; m < 4; ++m) { const int row = row0 + ai * HALF + m * 16; const size_t off = (size_t)row * ldc + col0; float ss = 0.f;
#pragma unroll
                for (int bj = 0; bj < 2; ++bj)
#pragma unroll
                    for (int n = 0; n < 2; ++n) { const size_t o2 = off + bj * HALF + n * 16; const f32x4 o = pre[m][bj][n] + acc[ai][bj][m][n];
                        *(f32x4*)(out + o2) = o; ss += (o[0] * o[0] + o[1] * o[1]) + (o[2] * o[2] + o[3] * o[3]);
                        if (WRITE_BF16) { u32x2v w; w.x = cvt_pk_bf16(o[0], o[1]); w.y = cvt_pk_bf16(o[2], o[3]); *(u32x2v*)(xb + o2) = w; } }
                ss += __shfl_xor(ss, 16); ss += __shfl_xor(ss, 32);
                if (fq == 0) ssq[(size_t)row * 16 + u.pn * 4 + wc] = ss; }
            asm volatile("" ::: "memory");
        }
    }
};
template <class Epi, class Sched, bool ALIGN_EPI = false, bool SP2 = false>
__device__ __forceinline__ void gemm_phase(PG8_LAS unsigned char* lds, const Gemm g, const Sched& S, const Epi& E) {
    const int tid = threadIdx.x, wid = __builtin_amdgcn_readfirstlane(tid >> 6), lane = tid & 63, wr = wid >> 2, wc = wid & 3, fr = lane & 15, fq = lane >> 4;
    const int K = g.K, nt = K / BK;
    unsigned voffA[2], voffB[2];
#pragma unroll
    for (int i = 0; i < 2; ++i) { int R, C; stage_rc(tid * 16 + i * 8192, R, C); const int Rb = Epi::PERM ? ((R & ~31) + perm32(R & 31)) : R;
        voffA[i] = (unsigned)(R * g.lda + C) * 2u; voffB[i] = (unsigned)(Rb * K + C) * 2u; }
    const size_t kstep = (size_t)(BK * 2);
    const size_t hstepA = (size_t)HALF * g.lda * 2, hstepB = (size_t)HALF * K * 2;
    const size_t tstepA = 2 * hstepA, tstepB = 2 * hstepB;
    const unsigned ldsw = (unsigned)wid * 1024u;
    const int aoff = lds_byte(wr * 64 + fr, fq * 8), boff = lds_byte(wc * 32 + fr, fq * 8);
#define PG8_SA(b, h) (((b) * 2 + (h)) * HTB)
#define PG8_SB(b, h) ((4 + (b) * 2 + (h)) * HTB)
#define PG8_STAGE(bufoff, gbase, voff) do { _Pragma("unroll") for (int _i = 0; _i < 2; ++_i) \
        __builtin_amdgcn_global_load_lds((const unsigned*)((const char*)(gbase) + (voff)[_i]), (PG8_LAS unsigned*)(lds + (bufoff) + ldsw + _i * 8192), 16, 0, 0); } while (0)
#define PG8_LDA(dst, b, h) do { _Pragma("unroll") for (int m = 0; m < 4; ++m) _Pragma("unroll") for (int k = 0; k < 2; ++k) dst[m][k] = *(const PG8_LAS bf16x8*)(lds + PG8_SA(b, h) + aoff + m * 2048 + k * 1024); } while (0)
#define PG8_LDB(dst, b, h) do { _Pragma("unroll") for (int n = 0; n < 2; ++n) _Pragma("unroll") for (int k = 0; k < 2; ++k) dst[n][k] = *(const PG8_LAS bf16x8*)(lds + PG8_SB(b, h) + boff + n * 2048 + k * 1024); } while (0)
#define PG8_MMA(ai, bj, At, Bt) do { __builtin_amdgcn_s_setprio(1); _Pragma("unroll") for (int m = 0; m < 4; ++m) _Pragma("unroll") for (int n = 0; n < 2; ++n) _Pragma("unroll") for (int k = 0; k < 2; ++k) \
        acc[ai][bj][m][n] = __builtin_amdgcn_mfma_f32_16x16x32_bf16(Bt[n][k], At[m][k], acc[ai][bj][m][n], 0, 0, 0); __builtin_amdgcn_s_setprio(0); } while (0)
#define PG8_WAIT_V(n) asm volatile("s_waitcnt vmcnt(" #n ")" ::: "memory")
#define PG8_WAIT_L(n) asm volatile("s_waitcnt lgkmcnt(" #n ")" ::: "memory")
#define PG8_BAR __builtin_amdgcn_s_barrier()
#define PG8_SCHED __builtin_amdgcn_sched_barrier(0)
    Unit cur, nxt; int ui = 0;
    if (!S.next(0, cur)) return;
    f32x4 acc[2][2][4][2];
#pragma unroll
    for (int a = 0; a < 2; ++a)
#pragma unroll
        for (int b = 0; b < 2; ++b)
#pragma unroll
            for (int m = 0; m < 4; ++m)
#pragma unroll
                for (int n = 0; n < 2; ++n) acc[a][b][m][n] = (f32x4){0.f, 0.f, 0.f, 0.f};
    bf16x8 At[4][2], B0[2][2], B1[2][2];
    const char* cA = (const char*)g.A + (size_t)cur.pm * tstepA; const char* cB = (const char*)g.Bt + (size_t)cur.pn * tstepB;
    S.a_ready(cur);
    if constexpr (SP2) {
        PG8_STAGE(PG8_SB(0, 0), cB, voffB); PG8_STAGE(PG8_SB(0, 1), cB + hstepB, voffB); PG8_STAGE(PG8_SA(0, 0), cA, voffA); PG8_STAGE(PG8_SA(0, 1), cA + hstepA, voffA);
        if (wr == 1) PG8_BAR;
        PG8_WAIT_V(2); PG8_BAR;
        PG8_STAGE(PG8_SB(1, 0), cB + kstep, voffB); PG8_STAGE(PG8_SA(1, 0), cA + kstep, voffA); PG8_STAGE(PG8_SB(1, 1), cB + hstepB + kstep, voffB);
        PG8_WAIT_V(6); PG8_BAR;
    } else {
        PG8_STAGE(PG8_SB(0, 0), cB, voffB); PG8_STAGE(PG8_SA(0, 0), cA, voffA); PG8_STAGE(PG8_SB(0, 1), cB + hstepB, voffB); PG8_STAGE(PG8_SA(0, 1), cA + hstepA, voffA);
        if (wr == 1) PG8_BAR;
        PG8_WAIT_V(4); PG8_BAR;
        PG8_STAGE(PG8_SB(1, 0), cB + kstep, voffB); PG8_STAGE(PG8_SA(1, 0), cA + kstep, voffA); PG8_STAGE(PG8_SB(1, 1), cB + hstepB + kstep, voffB);
        PG8_WAIT_V(6); PG8_BAR;
    }
    for (;;) {
        const bool has_next = S.next(ui + 1, nxt);
        const char* nA = has_next ? (const char*)g.A + (size_t)nxt.pm * tstepA : cA; const char* nB = has_next ? (const char*)g.Bt + (size_t)nxt.pn * tstepB : cB;
        for (int t = 0; t < nt; t += 2) {
            const bool last = (t == nt - 2);
            const char* a1 = cA + (size_t)(t + 1) * kstep;
            const char* a2 = last ? nA : cA + (size_t)(t + 2) * kstep; const char* b2 = last ? nB : cB + (size_t)(t + 2) * kstep;
            const char* a3 = a2 + kstep; const char* b3 = b2 + kstep;
            if (last && has_next) S.a_ready(nxt);
            if constexpr (SP2) {
            PG8_LDB(B0, 0, 0); PG8_LDB(B1, 0, 1); PG8_SCHED; PG8_LDA(At, 0, 0); PG8_STAGE(PG8_SA(1, 1), a1 + hstepA, voffA);
            PG8_WAIT_V(8); PG8_WAIT_L(0); PG8_BAR; PG8_MMA(0, 0, At, B0); PG8_MMA(0, 1, At, B1); PG8_BAR; PG8_SCHED;
            PG8_LDA(At, 0, 1); PG8_STAGE(PG8_SB(0, 0), b2, voffB); PG8_STAGE(PG8_SB(0, 1), b2 + hstepB, voffB); PG8_STAGE(PG8_SA(0, 0), a2, voffA);
            PG8_WAIT_V(8); PG8_WAIT_L(0); PG8_BAR; PG8_MMA(1, 0, At, B0); PG8_MMA(1, 1, At, B1); PG8_BAR; PG8_SCHED;
            PG8_LDB(B0, 1, 0); PG8_LDB(B1, 1, 1); PG8_SCHED; PG8_LDA(At, 1, 0); PG8_STAGE(PG8_SA(0, 1), a2 + hstepA, voffA);
            PG8_WAIT_V(8); PG8_WAIT_L(0); PG8_BAR; PG8_MMA(0, 0, At, B0); PG8_MMA(0, 1, At, B1); PG8_BAR; PG8_SCHED;
            PG8_LDA(At, 1, 1); PG8_STAGE(PG8_SB(1, 0), b3, voffB); PG8_STAGE(PG8_SB(1, 1), b3 + hstepB, voffB); PG8_STAGE(PG8_SA(1, 0), a3, voffA);
            PG8_WAIT_V(8); PG8_WAIT_L(0); PG8_BAR; PG8_MMA(1, 0, At, B0); PG8_MMA(1, 1, At, B1); PG8_BAR; PG8_SCHED;
            } else {
            PG8_LDB(B0, 0, 0); PG8_SCHED; PG8_LDA(At, 0, 0); PG8_STAGE(PG8_SA(1, 1), a1 + hstepA, voffA);
            PG8_WAIT_L(8); PG8_BAR; PG8_WAIT_L(0); PG8_MMA(0, 0, At, B0); PG8_BAR; PG8_SCHED;
            PG8_LDB(B1, 0, 1); PG8_STAGE(PG8_SB(0, 0), b2, voffB);
            PG8_BAR; PG8_WAIT_L(0); PG8_MMA(0, 1, At, B1); PG8_BAR;
            PG8_LDA(At, 0, 1); PG8_STAGE(PG8_SA(0, 0), a2, voffA);
            PG8_BAR; PG8_WAIT_L(0); PG8_MMA(1, 0, At, B0); PG8_BAR; PG8_SCHED;
            PG8_STAGE(PG8_SB(0, 1), b2 + hstepB, voffB);
            PG8_WAIT_V(6); PG8_BAR; PG8_MMA(1, 1, At, B1); PG8_BAR;
            PG8_LDB(B0, 1, 0); PG8_SCHED; PG8_LDA(At, 1, 0); PG8_STAGE(PG8_SA(0, 1), a2 + hstepA, voffA);
            PG8_WAIT_L(8); PG8_BAR; PG8_WAIT_L(0); PG8_MMA(0, 0, At, B0); PG8_BAR; PG8_SCHED;
            PG8_LDB(B1, 1, 1); PG8_STAGE(PG8_SB(1, 0), b3, voffB);
            PG8_BAR; PG8_WAIT_L(0); PG8_MMA(0, 1, At, B1); PG8_BAR;
            PG8_LDA(At, 1, 1); PG8_STAGE(PG8_SA(1, 0), a3, voffA);
            PG8_BAR; PG8_WAIT_L(0); PG8_MMA(1, 0, At, B0); PG8_BAR; PG8_SCHED;
            PG8_STAGE(PG8_SB(1, 1), b3 + hstepB, voffB);
            PG8_WAIT_V(6); PG8_BAR; PG8_MMA(1, 1, At, B1); PG8_BAR;
            }
        }
        if constexpr (ALIGN_EPI) { if (wr == 0) PG8_BAR; }
        if constexpr (!Epi::AFTER_DRAIN) { E(acc, cur, wr, wc, fr, fq); S.done(cur); }
        if (!has_next) break;
#pragma unroll
        for (int a = 0; a < 2; ++a)
#pragma unroll
            for (int b = 0; b < 2; ++b)
#pragma unroll
                for (int m = 0; m < 4; ++m)
#pragma unroll
                    for (int n = 0; n < 2; ++n) acc[a][b][m][n] = (f32x4){0.f, 0.f, 0.f, 0.f};
        cur = nxt; cA = nA; cB = nB; ++ui;
        if constexpr (ALIGN_EPI) { if (wr == 1) PG8_BAR; }
    }
    PG8_WAIT_V(0);
    if constexpr (!ALIGN_EPI) { if (wr == 0) PG8_BAR; }
    PG8_BAR;
    if constexpr (Epi::AFTER_DRAIN) { E.fused(acc, cur, wr, wc, fr, fq, lds, wid, lane); S.done(cur); }
#undef PG8_SA
#undef PG8_SB
#undef PG8_STAGE
#undef PG8_LDA
#undef PG8_LDB
#undef PG8_MMA
#undef PG8_WAIT_V
#undef PG8_WAIT_L
#undef PG8_BAR
#undef PG8_SCHED
}
}
#define GAS __attribute__((address_space(1)))
#define LAS __attribute__((address_space(3)))
typedef unsigned short bf16;
typedef unsigned v4u __attribute__((ext_vector_type(4)));
typedef float f32x4 __attribute__((ext_vector_type(4)));
typedef short bf16x8 __attribute__((ext_vector_type(8)));
typedef GAS unsigned gu32;
typedef GAS unsigned long long gu64;
#define RLX_AGENT __ATOMIC_RELAXED, __HIP_MEMORY_SCOPE_AGENT
#define LDS_WAIT() asm volatile("s_waitcnt lgkmcnt(0)" ::: "memory")
#define VM_WAIT() asm volatile("s_waitcnt vmcnt(0)" ::: "memory")
__device__ __forceinline__ unsigned long long rt() { return __builtin_amdgcn_s_memrealtime(); }
__device__ __forceinline__ unsigned f2bf(float f) { unsigned u = __builtin_bit_cast(unsigned, f); return (u + 0x7fffu + ((u >> 16) & 1u)) >> 16; }
__device__ __forceinline__ unsigned pk2(float lo, float hi) { return f2bf(lo) | (f2bf(hi) << 16); }

#define XB_TMO      128
#define XB_XCNT(j)  (256  + 64 * (j))
#define XB_XSUB(j)  (1280 + 64 * (j))
#define XB_XGEN(j)  (2304 + 64 * (j))
#define XB_TOP      3328
#define XB_TOPGEN   3392
#define XCD_BAR_WORDS 3456
#define XB_SPIN_CAP (1u << 18)

__device__ __forceinline__ unsigned xb_ld(unsigned* p)              { return __hip_atomic_load(p, __ATOMIC_RELAXED, __HIP_MEMORY_SCOPE_AGENT); }
__device__ __forceinline__ unsigned xb_add(unsigned* p, unsigned v) { return __hip_atomic_fetch_add(p, v, __ATOMIC_RELAXED, __HIP_MEMORY_SCOPE_AGENT); }
__device__ __forceinline__ unsigned xb_xcc_id() { return (unsigned)__builtin_amdgcn_s_getreg((3 << 11) | 20) & 0xFu; }
#define XB_SPIN(cond, bar) do { unsigned _sp = 0; while (cond) { __builtin_amdgcn_s_sleep(1); \
    if ((++_sp & 255u) == 0u) { if (xb_ld(&(bar)[XB_TMO])) break; if (_sp > XB_SPIN_CAP) { atomicAdd(&(bar)[XB_TMO], 1u); break; } } } } while (0)

struct XcdBarrier {
    unsigned* bar; unsigned x;
    volatile LAS unsigned* st;
};

__device__ __forceinline__ XcdBarrier xcd_barrier_post(unsigned* bar, volatile LAS unsigned* st) {
    XcdBarrier b; b.bar = bar; b.x = xb_xcc_id(); b.st = st;
    if (threadIdx.x == 0) (void)xb_add(&bar[XB_XCNT(b.x)], 1u);
    return b;
}
__device__ __forceinline__ void xcd_barrier_complete(unsigned* bar, unsigned x, unsigned& nloc, unsigned& nx) {
    const unsigned G = gridDim.x * gridDim.y * gridDim.z;
    unsigned sum, cnt, mine, sp = 0u;
    for (;;) {
        sum = 0u; cnt = 0u; mine = 0u;
#pragma unroll
        for (unsigned j = 0; j < 16; ++j) { const unsigned c = xb_ld(&bar[XB_XCNT(j)]); sum += c; cnt += (c > 0u) ? 1u : 0u; mine = (j == x) ? c : mine; }
        if (sum == G) break;
        __builtin_amdgcn_s_sleep(1);
        if ((++sp & 255u) == 0u) { if (xb_ld(&bar[XB_TMO])) break; if (sp > XB_SPIN_CAP) { atomicAdd(&bar[XB_TMO], 1u); break; } }
    }
    nloc = mine > 0u ? mine : 1u; nx = cnt > 0u ? cnt : 1u;
}

__device__ __forceinline__ void xcd_barrier(const XcdBarrier& b) {
    asm volatile("s_waitcnt vmcnt(0)" ::: "memory");
    __syncthreads();
    if (threadIdx.x == 0) {
        unsigned* bar = b.bar;
        __builtin_amdgcn_s_waitcnt(0);
        unsigned nloc = b.st[0], nx = b.st[1];
        if (nloc == 0u) { xcd_barrier_complete(bar, b.x, nloc, nx); b.st[0] = nloc; b.st[1] = nx; }
        const unsigned old = xb_add(&bar[XB_XSUB(b.x)], 1u);
        const unsigned gen = old / nloc;
        if (old + 1u == (gen + 1u) * nloc) {
            __builtin_amdgcn_fence(__ATOMIC_RELEASE, "agent");
            asm volatile("s_waitcnt vmcnt(0)" ::: "memory");
            const unsigned og = xb_add(&bar[XB_TOP], 1u);
            const unsigned tg = og / nx;
            if (og + 1u == (tg + 1u) * nx) xb_add(&bar[XB_TOPGEN], 1u);
            else XB_SPIN(xb_ld(&bar[XB_TOPGEN]) == tg, bar);
            __builtin_amdgcn_fence(__ATOMIC_ACQUIRE, "agent");
            xb_add(&bar[XB_XGEN(b.x)], 1u);
            asm volatile("s_waitcnt vmcnt(0)" ::: "memory");
        } else {
            XB_SPIN(xb_ld(&bar[XB_XGEN(b.x)]) == gen, bar);
            __builtin_amdgcn_fence(__ATOMIC_ACQUIRE, "agent");
            asm volatile("s_waitcnt vmcnt(0)" ::: "memory");
        }
    }
    __syncthreads();
}
constexpr int NWAVES = 8;
constexpr int BATCH = 16, SEQ = 2048, D = 1024, M = BATCH * SEQ;
constexpr int NP = 2816;
constexpr int IN_COLS = 2824;
constexpr int O_AK = 512, O_AV = 640, O_MQ = 768, O_MK = 1280, O_MV = 1792, O_MO = 2304, O_G = 2816;
constexpr int MEMLEN = 256, MMEM = BATCH * MEMLEN;
constexpr int FF = 2816, NU = 2 * FF;
constexpr float EPS = 1e-6f;
constexpr size_t MiB = 1u << 20;
constexpr size_t WS_CTL = 0, CTL_ZERO_BYTES = 1 * MiB;
constexpr size_t WS_RSTD0 = 1 * MiB;
constexpr size_t WS_RSTDM = WS_RSTD0 + 128 * 1024;
constexpr size_t WS_GPRE = 2 * MiB;
constexpr size_t WS_SSQ1 = 4 * MiB, WS_SSQ2 = 6 * MiB, WS_SSQ3 = 8 * MiB;
constexpr size_t WS_WIN = 16 * MiB, WS_WKV = 22 * MiB, WS_WOUT = 26 * MiB, WS_WQ = 28 * MiB, WS_WO = 30 * MiB, WS_WUP = 32 * MiB, WS_WDN = 43 * MiB;
constexpr size_t WS_MEMB = 49 * MiB;
constexpr size_t WS_KVM = 57 * MiB;
constexpr size_t WS_XB = 80 * MiB;
constexpr size_t WS_P = 144 * MiB;
constexpr size_t WS_MIX = 320 * MiB;
constexpr size_t WS_QX = 384 * MiB;
constexpr size_t WS_XO = 448 * MiB;
constexpr size_t WS_U = 144 * MiB;
constexpr size_t WS_END = 512 * MiB;
static_assert(WS_WDN + (size_t)D * FF * 2 <= WS_MEMB && WS_KVM + (size_t)MMEM * 2048 * 2 <= WS_XB && WS_XB + (size_t)M * D * 2 == WS_P && WS_P + (size_t)M * NP * 2 == WS_MIX && WS_U + (size_t)M * NU * 2 <= WS_END, "d_ws map");
constexpr int CW_TMO = 0, CW_CODE = 1;
constexpr int CW_BAR = 4096;
constexpr int N_BAR_REGIONS = 16;
static_assert((CW_BAR + N_BAR_REGIONS * XCD_BAR_WORDS) * 4 <= (int)CTL_ZERO_BYTES, "CTL words inside the memset region");
constexpr int RING_OFF = 0, RING_BYTES = 131072;
constexpr int LDS_BYTES = 163840;
constexpr int LDSCTL_OFF = LDS_BYTES - 512, MISC_OFF = LDSCTL_OFF + 320;
constexpr int PH_LDS = LDSCTL_OFF;

struct Args { const float* in[20]; float* out; unsigned char* ws; int ph_lo, ph_hi, li, pad; };

struct Frame {
    LAS unsigned char* lds; volatile LAS unsigned* MISC; gu32* ctl;
    int tid, lane, wave, vcu, G;
};
__device__ __forceinline__ float wave_sum(float v) {
#pragma unroll
    for (int o = 1; o < 64; o <<= 1) v += __shfl_xor(v, o);
    return v;
}
__device__ __forceinline__ float bf2f(unsigned short b) { return __builtin_bit_cast(float, (unsigned)b << 16); }
__device__ __forceinline__ float bflo(unsigned w) { return __builtin_bit_cast(float, w << 16); }
__device__ __forceinline__ float bfhi(unsigned w) { return __builtin_bit_cast(float, w & 0xffff0000u); }

__device__ __forceinline__ void p0_transpose_item(const float* W, int K, int ldw, int src_col0, const float* g, bf16* WT, int dst_row0, LAS float* scr, int kb, int lane) {
    const int k0 = 64 * kb;
    float wv[32];
#pragma unroll
    for (int i = 0; i < 32; ++i) wv[i] = W[(size_t)(k0 + 2 * i + (lane >> 5)) * ldw + src_col0 + (lane & 31)];
#pragma unroll
    for (int i = 0; i < 32; ++i) { const int kk = 2 * i + (lane >> 5); float w = wv[i]; if (g) w *= g[k0 + kk]; scr[kk * 33 + (lane & 31)] = w; }
    LDS_WAIT(); asm volatile("" ::: "memory");
    const int c = lane & 7;
#pragma unroll
    for (int j = 0; j < 4; ++j) { const int n = (lane >> 3) + 8 * j; const LAS float* s = scr + (8 * c) * 33 + n;
        v4u o; o.x = pk2(s[0 * 33], s[1 * 33]); o.y = pk2(s[2 * 33], s[3 * 33]); o.z = pk2(s[4 * 33], s[5 * 33]); o.w = pk2(s[6 * 33], s[7 * 33]);
        *(GAS v4u*)(WT + (size_t)(dst_row0 + n) * K + k0 + 8 * c) = o; }
    LDS_WAIT(); asm volatile("" ::: "memory");
}
__device__ __forceinline__ void row_load(const float* xrow, int lane, f32x4 (&v)[4]) {
    const GAS f32x4* xr = (const GAS f32x4*)xrow + lane;
#pragma unroll
    for (int j = 0; j < 4; ++j) v[j] = xr[64 * j];
}
__device__ __forceinline__ float row_to_bf16(bf16* orow, int lane, const f32x4 (&v)[4]) {
    float s = 0.f;
#pragma unroll
    for (int j = 0; j < 4; ++j) s += (v[j][0] * v[j][0] + v[j][1] * v[j][1]) + (v[j][2] * v[j][2] + v[j][3] * v[j][3]);
    GAS unsigned long long* o8 = (GAS unsigned long long*)orow + lane;
#pragma unroll
    for (int j = 0; j < 4; ++j) o8[64 * j] = (unsigned long long)pk2(v[j][0], v[j][1]) | ((unsigned long long)pk2(v[j][2], v[j][3]) << 32);
    return wave_sum(s);
}
typedef float f32x16 __attribute__((ext_vector_type(16)));
typedef short s16x4 __attribute__((ext_vector_type(4)));
__device__ __forceinline__ int crow(int r, int hi) { return (r & 3) + 8 * (r >> 2) + 4 * hi; }
__device__ __forceinline__ unsigned cvtpk(float lo, float hi) { typedef float f2 __attribute__((ext_vector_type(2))); typedef __bf16 b2 __attribute__((ext_vector_type(2))); f2 v = {lo, hi}; b2 b = __builtin_convertvector(v, b2); return __builtin_bit_cast(unsigned, b); }
__device__ __forceinline__ s16x4 ldtr(const LAS unsigned char* p) { typedef short v4i16 __attribute__((ext_vector_type(4))); return __builtin_bit_cast(s16x4, __builtin_amdgcn_ds_read_tr16_b64_v4i16((LAS v4i16*)p)); }
__device__ __forceinline__ bf16x8 pack8(const f32x16& p, int b) { v4u w; w.x = cvtpk(p[b], p[b + 1]); w.y = cvtpk(p[b + 2], p[b + 3]); w.z = cvtpk(p[b + 4], p[b + 5]); w.w = cvtpk(p[b + 6], p[b + 7]); return __builtin_bit_cast(bf16x8, w); }
#define GLDS16(gptr, ldsptr) __builtin_amdgcn_global_load_lds((const unsigned*)(gptr), (LAS unsigned*)(ldsptr), 16, 0, 0)

__device__ __forceinline__ void xattn_unit(Frame& F, int b, int xh, int qb, const bf16* QX, const float* ssq1, const bf16* KVM, bf16* XO) {
    const int lane = F.lane, w = F.wave, r32 = lane & 31, hi = lane >> 5;
    const size_t row = (size_t)b * SEQ + qb * 256 + w * 32 + r32;
    const bf16* Kg = KVM + (size_t)b * MEMLEN * 2048 + xh * 256;
    { const bf16* kp = Kg + (size_t)(2 * w + (lane >> 5)) * 2048 + (lane & 31) * 8;
#pragma unroll
      for (int i = 0; i < 16; ++i) GLDS16(kp + (size_t)i * 16 * 2048, F.lds + (w + 8 * i) * 1040); }
    const bf16* qp = QX + row * D + xh * 256 + hi * 8;
    bf16x8 qa[2], qc[2];
#pragma unroll
    for (int j = 0; j < 2; ++j) qa[j] = *(const bf16x8*)(qp + j * 16);
    const pg8::RsParts rs{ssq1};
    const float sc2 = rs.get((int)row) * (0.0625f * 1.4426950408889634f);
    asm volatile("s_waitcnt vmcnt(0)" ::: "memory"); __syncthreads();
    const LAS unsigned char* kbase = F.lds + (r32 >> 1) * 1040 + (r32 & 1) * 512 + hi * 16;
    f32x16 S[8];
#pragma unroll
    for (int kb = 0; kb < 8; ++kb) S[kb] = (f32x16){0.f, 0.f, 0.f, 0.f, 0.f, 0.f, 0.f, 0.f, 0.f, 0.f, 0.f, 0.f, 0.f, 0.f, 0.f, 0.f};
#define XQK(QF, G) do { _Pragma("unroll") for (int j = 0; j < 2; ++j) _Pragma("unroll") for (int kb = 0; kb < 8; ++kb) { \
            const bf16x8 a = *(const LAS bf16x8*)(kbase + kb * 16640 + (2 * (G) + j) * 32); \
            S[kb] = __builtin_amdgcn_mfma_f32_32x32x16_bf16(a, QF[j], S[kb], 0, 0, 0); } } while (0)
#define XQL(QF, G) do { _Pragma("unroll") for (int j = 0; j < 2; ++j) QF[j] = *(const bf16x8*)(qp + (2 * (G) + j) * 16); } while (0)
    XQL(qc, 1); asm volatile("" ::: "memory"); XQK(qa, 0); asm volatile("" ::: "memory");
    XQL(qa, 2); asm volatile("" ::: "memory"); XQK(qc, 1); asm volatile("" ::: "memory");
    XQL(qc, 3); asm volatile("" ::: "memory"); XQK(qa, 2); asm volatile("" ::: "memory");
    XQL(qa, 4); asm volatile("" ::: "memory"); XQK(qc, 3); asm volatile("" ::: "memory");
    XQL(qc, 5); asm volatile("" ::: "memory"); XQK(qa, 4); asm volatile("" ::: "memory");
    XQL(qa, 6); asm volatile("" ::: "memory"); XQK(qc, 5); asm volatile("" ::: "memory");
    XQL(qc, 7); asm volatile("" ::: "memory"); XQK(qa, 6); asm volatile("" ::: "memory");
    XQK(qc, 7);
#undef XQK
#undef XQL
    float mx = S[0][0];
#pragma unroll
    for (int kb = 0; kb < 8; ++kb)
#pragma unroll
        for (int r = 0; r < 16; ++r) mx = fmaxf(mx, S[kb][r]);
    mx = fmaxf(mx, __shfl_xor(mx, 32));
    const float mo = mx * sc2; float l = 0.f;
#pragma unroll
    for (int kb = 0; kb < 8; ++kb)
#pragma unroll
        for (int r = 0; r < 16; ++r) { const float e = __builtin_amdgcn_exp2f(S[kb][r] * sc2 - mo); S[kb][r] = e; l += e; }
    l += __shfl_xor(l, 32);
    const float inv = 1.0f / l;
    bf16x8 pf[8][2];
#pragma unroll
    for (int kb = 0; kb < 8; ++kb) { pf[kb][0] = pack8(S[kb], 0); pf[kb][1] = pack8(S[kb], 8); }
    __syncthreads();
    { const bf16* vp = KVM + (size_t)b * MEMLEN * 2048 + 1024 + xh * 256 + (size_t)(16 * w + (lane >> 2)) * 2048 + 8 * (lane & 3);
#pragma unroll
      for (int i = 0; i < 16; ++i) GLDS16(vp + (size_t)(i & 1) * 128 * 2048 + (i >> 1) * 32, F.lds + (w + 8 * i) * 1024); }
    asm volatile("s_waitcnt vmcnt(0)" ::: "memory"); __syncthreads();
    bf16* orow = XO + row * D + xh * 256 + 4 * hi;
    const int vbase = (4 * hi + ((lane & 15) >> 2)) * 64 + (16 * ((lane >> 4) & 1) + 4 * (lane & 3)) * 2;
#pragma unroll
    for (int db = 0; db < 8; ++db) {
        f32x16 o = (f32x16){0.f, 0.f, 0.f, 0.f, 0.f, 0.f, 0.f, 0.f, 0.f, 0.f, 0.f, 0.f, 0.f, 0.f, 0.f, 0.f};
#pragma unroll
        for (int kb = 0; kb < 8; ++kb)
#pragma unroll
            for (int s = 0; s < 2; ++s) {
                const LAS unsigned char* vp = F.lds + db * 16384 + (32 * kb + 16 * s) * 64 + vbase;
                const s16x4 lo = ldtr(vp), hh = ldtr(vp + 8 * 64);
                const bf16x8 a = (bf16x8){lo[0], lo[1], lo[2], lo[3], hh[0], hh[1], hh[2], hh[3]};
                o = __builtin_amdgcn_mfma_f32_32x32x16_bf16(a, pf[kb][s], o, 0, 0, 0);
            }
#pragma unroll
        for (int g = 0; g < 4; ++g) { typedef unsigned u2 __attribute__((ext_vector_type(2))); u2 wv; wv.x = cvtpk(o[4 * g] * inv, o[4 * g + 1] * inv); wv.y = cvtpk(o[4 * g + 2] * inv, o[4 * g + 3] * inv);
            *(u2*)(orow + 32 * db + 8 * g) = wv; }
    }
    __syncthreads();
}
__device__ __forceinline__ void p5_xattn(Frame& F, const Args& a) {
    const bf16* QX = (const bf16*)(a.ws + WS_QX); const bf16* KVM = (const bf16*)(a.ws + WS_KVM); bf16* XO = (bf16*)(a.ws + WS_XO); const float* ssq1 = (const float*)(a.ws + WS_SSQ1);
    constexpr int NUNIT = BATCH * 4 * (SEQ / 256);
    for (int u = F.vcu; u < NUNIT; u += F.G) { const int qb = u & 7, xh = (u >> 3) & 3, b = u >> 5; xattn_unit(F, b, xh, qb, QX, ssq1, KVM, XO); }
}
__device__ __forceinline__ void swa_unit(Frame& F, int b, int hk, int n, const bf16* P, const float* sinks, bf16* MIX) {
    const int lane = F.lane, w = F.wave, r32 = lane & 31, hi = lane >> 5, wq = w & 3;
    LAS unsigned char* Kl = F.lds; LAS unsigned char* Vl = F.lds + 32768;
    const int np = n > 0 ? n - 1 : 0;
    {
        const int z = (4 * w + (lane >> 4)) & 7;
        const bf16* kp = P + (size_t)(b * SEQ + 8 * w + (lane >> 3)) * NP + O_AK + hk * 64 + (((lane & 7) ^ z) * 8);
#pragma unroll
        for (int i = 0; i < 4; ++i) GLDS16(kp + (size_t)(128 * (i < 2 ? np : n) + 64 * (i & 1)) * NP, Kl + (w + 8 * i) * 1024);
        const bf16* vp = P + (size_t)(b * SEQ + 16 * w + (lane >> 2)) * NP + O_AV + hk * 64 + 8 * (lane & 3);
#pragma unroll
        for (int i = 0; i < 4; ++i) GLDS16(vp + (size_t)(128 * ((i & 1) ? n : np)) * NP + 32 * (i >> 1), Vl + (w + 8 * i) * 1024);
    }
    const size_t row = (size_t)b * SEQ + n * 128 + wq * 32 + r32;
    bf16x8 qf[2][4];
#pragma unroll
    for (int gi = 0; gi < 2; ++gi) { const bf16* qp = P + row * NP + (hk * 4 + 2 * (w >> 2) + gi) * 64 + hi * 8;
#pragma unroll
        for (int ks = 0; ks < 4; ++ks) qf[gi][ks] = *(const bf16x8*)(qp + ks * 16); }
    asm volatile("s_waitcnt vmcnt(0)" ::: "memory"); __syncthreads();
    const int zk = (r32 >> 1) & 7;
    const LAS unsigned char* krow = Kl + (32 * wq + r32) * 128;
    const int vlane = (4 * hi + ((lane & 15) >> 2)) * 64 + (16 * ((lane >> 4) & 1) + 4 * (lane & 3)) * 2;
    const int dl = r32 - 4 * hi;
#pragma unroll
    for (int gi = 0; gi < 2; ++gi) {
        const int h = hk * 4 + 2 * (w >> 2) + gi;
        const float slope2 = exp2f(-(float)(h + 1)) * 1.4426950408889634f, sink2 = sinks[h] * 1.4426950408889634f;
        constexpr float sc = 0.125f * 1.4426950408889634f;
        f32x16 S[5];
#pragma unroll
        for (int jb = 0; jb < 5; ++jb) S[jb] = (f32x16){0.f, 0.f, 0.f, 0.f, 0.f, 0.f, 0.f, 0.f, 0.f, 0.f, 0.f, 0.f, 0.f, 0.f, 0.f, 0.f};
#pragma unroll
        for (int ks = 0; ks < 4; ++ks) { const int co = ((2 * ks + hi) ^ zk) * 16;
#pragma unroll
            for (int jb = 0; jb < 5; ++jb) { const bf16x8 a = *(const LAS bf16x8*)(krow + jb * 4096 + co); S[jb] = __builtin_amdgcn_mfma_f32_32x32x16_bf16(a, qf[gi][ks], S[jb], 0, 0, 0); } }
        int dlo = dl; float bbase = -slope2 * (float)(dl + 128);
        asm volatile("" : "+v"(dlo), "+v"(bbase));
        float mx = sink2;
#pragma unroll
        for (int jb = 0; jb < 5; ++jb) { const bool dead = (n == 0) && (wq + jb < 4);
#pragma unroll
            for (int r = 0; r < 16; ++r) { const int cr = 32 * jb + (r & 3) + 8 * (r >> 2);
                float v = __builtin_fmaf(S[jb][r], sc, __builtin_fmaf(slope2, (float)cr, bbase));
                if (jb == 0) v = (dlo >= cr) ? -1e30f : v;
                if (jb == 4) v = (dlo < cr - 128) ? -1e30f : v;
                v = dead ? -1e30f : v;
                S[jb][r] = v; mx = fmaxf(mx, v); } }
        mx = fmaxf(mx, __shfl_xor(mx, 32));
        float l = 0.f;
#pragma unroll
        for (int jb = 0; jb < 5; ++jb)
#pragma unroll
            for (int r = 0; r < 16; ++r) { const float e = __builtin_amdgcn_exp2f(S[jb][r] - mx); S[jb][r] = e; l += e; }
        l += __shfl_xor(l, 32);
        const float inv = 1.0f / (l + __builtin_amdgcn_exp2f(sink2 - mx));
        bf16x8 pf[5][2];
#pragma unroll
        for (int jb = 0; jb < 5; ++jb) { pf[jb][0] = pack8(S[jb], 0); pf[jb][1] = pack8(S[jb], 8); }
        bf16* orow = MIX + row * D + h * 64 + 4 * hi;
#pragma unroll
        for (int db = 0; db < 2; ++db) {
            f32x16 o = (f32x16){0.f, 0.f, 0.f, 0.f, 0.f, 0.f, 0.f, 0.f, 0.f, 0.f, 0.f, 0.f, 0.f, 0.f, 0.f, 0.f};
#pragma unroll
            for (int jb = 0; jb < 5; ++jb)
#pragma unroll
                for (int s = 0; s < 2; ++s) { const LAS unsigned char* vp = Vl + db * 16384 + (32 * (wq + jb) + 16 * s) * 64 + vlane;
                    const s16x4 lo = ldtr(vp), hh = ldtr(vp + 8 * 64);
                    const bf16x8 a = (bf16x8){lo[0], lo[1], lo[2], lo[3], hh[0], hh[1], hh[2], hh[3]};
                    o = __builtin_amdgcn_mfma_f32_32x32x16_bf16(a, pf[jb][s], o, 0, 0, 0); }
#pragma unroll
            for (int g4 = 0; g4 < 4; ++g4) { typedef unsigned u2 __attribute__((ext_vector_type(2))); u2 wv; wv.x = cvtpk(o[4 * g4] * inv, o[4 * g4 + 1] * inv); wv.y = cvtpk(o[4 * g4 + 2] * inv, o[4 * g4 + 3] * inv);
                *(u2*)(orow + 32 * db + 8 * g4) = wv; }
        }
        __builtin_amdgcn_sched_barrier(0);
    }
    __syncthreads();
}
namespace ml {
constexpr int QS = 0, KS = 16384, KT = 32768, VS0 = 49152, VS1 = 65536, CT0 = 81920, CT1 = 114688, NS = 147456, PS = 148480, GS = 156672, WS = 157696, END = 162816;
static_assert(END <= PH_LDS, "mLSTM LDS map");
constexpr float L2E = 1.4426950408889634f;
}
__device__ __forceinline__ void mlstm_seq(Frame& F, int b, int h, const bf16* P, const float* gpre, const float* bg, const float* cw, const float* cb, bf16* MIX) {
    using namespace ml;
    const int tid = F.tid, lane = F.lane, w = F.wave, r32 = lane & 31, hi = lane >> 5, vb = w & 3, tb = w >> 2;
    LAS unsigned char* L = F.lds;
    const int chg = tid & 31, run = tid >> 5, cc = chg & 15, t0 = 4 * run; const bool isk = chg >= 16;
    const int cch = (isk ? 512 : 0) + h * 128 + 8 * cc;
    for (int i = tid; i < 32768 / 16; i += NWAVES * 64) *(LAS v4u*)(L + CT0 + 16 * i) = (v4u){0u, 0u, 0u, 0u};
    if (tid < 256) ((LAS float*)(L + NS))[tid] = 0.f;
    if (run == 0) { LAS float* wl = (LAS float*)(L + WS) + chg * 40;
        for (int j = 0; j < 4; ++j) for (int e = 0; e < 8; ++e) wl[j * 8 + e] = cw[j * 1024 + cch + e];
        for (int e = 0; e < 8; ++e) wl[32 + e] = cb[cch + e]; }
    const float bi = bg[h], bfb = bg[4 + h];
    float mprev = 0.f;
    f32x16 Cacc[2];
#pragma unroll
    for (int i = 0; i < 2; ++i) Cacc[i] = (f32x16){0.f, 0.f, 0.f, 0.f, 0.f, 0.f, 0.f, 0.f, 0.f, 0.f, 0.f, 0.f, 0.f, 0.f, 0.f, 0.f};
    const size_t rowb = (size_t)b * SEQ;
    const bf16* rawp = P + O_MQ + cch;
    const bf16* vsrc = P + (rowb + (lane >> 2)) * NP + O_MV + h * 128 + 8 * (lane & 3);
    v4u raw[7]; float gin, gfn;
#pragma unroll
    for (int k = 0; k < 7; ++k) { const int t = t0 - 3 + k; raw[k] = (t >= 0) ? *(const v4u*)(rawp + (rowb + t) * NP) : (v4u){0u, 0u, 0u, 0u}; }
    gin = gpre[(rowb + lane) * 8 + h]; gfn = gpre[(rowb + lane) * 8 + 4 + h];
#pragma unroll
    for (int i = 0; i < 2; ++i) { const int p = w + 8 * i; GLDS16(vsrc + (size_t)(16 * (p & 3)) * NP + 32 * (p >> 2), L + VS0 + p * 1024); }
    __syncthreads();
    const int zsw = (r32 & 15);
    const int vlane = (4 * hi + ((lane & 15) >> 2)) * 64 + (16 * ((lane >> 4) & 1) + 4 * (lane & 3)) * 2;
    for (int c = 0; c < SEQ / 64; ++c) {
        const int par = c & 1;
        const float gi = gin + bi, gf = gfn + bfb;
        const float lf = fminf(gf, 0.f) - log1pf(__expf(-fabsf(gf)));
        float bs = lf;
#pragma unroll
        for (int o = 1; o < 64; o <<= 1) { const float v = __shfl_up(bs, o); if (lane >= o) bs += v; }
        const float u = gi - bs; float pm = u;
#pragma unroll
        for (int o = 1; o < 64; o <<= 1) { const float v = __shfl_up(pm, o); if (lane >= o) pm = fmaxf(pm, v); }
        const float Mt = fmaxf(mprev, pm);
        const float M63 = __shfl(Mt, 63), b63 = __shfl(bs, 63);
        const float decay = __expf(mprev - M63);
        const float wsl = __expf(u - M63);
        if (w == 0) { LAS float* g = (LAS float*)(L + GS); g[lane] = u * L2E; g[64 + lane] = Mt * L2E; g[128 + lane] = __expf(mprev - Mt); g[192 + lane] = __expf(-(bs + Mt)); }
        {
            const LAS float* wl = (const LAS float*)(L + WS) + chg * 40;
            float wt[4][8], bb[8];
#pragma unroll
            for (int j = 0; j < 4; ++j) { const f32x4 a = *(const LAS f32x4*)(wl + j * 8), bq = *(const LAS f32x4*)(wl + j * 8 + 4);
#pragma unroll
                for (int e = 0; e < 4; ++e) { wt[j][e] = a[e]; wt[j][4 + e] = bq[e]; } }
            { const f32x4 a = *(const LAS f32x4*)(wl + 32), bq = *(const LAS f32x4*)(wl + 36);
#pragma unroll
              for (int e = 0; e < 4; ++e) { bb[e] = a[e]; bb[4 + e] = bq[e]; } }
            float psum[8];
#pragma unroll
            for (int e = 0; e < 8; ++e) psum[e] = 0.f;
#pragma unroll
            for (int i = 0; i < 4; ++i) {
                const int t = t0 + i; const float wsr = __shfl(wsl, t);
                float y[8];
#pragma unroll
                for (int e = 0; e < 8; ++e) y[e] = bb[e];
#pragma unroll
                for (int j = 0; j < 4; ++j)
#pragma unroll
                    for (int q = 0; q < 4; ++q) { y[2 * q] += wt[j][2 * q] * bflo(raw[i + j][q]); y[2 * q + 1] += wt[j][2 * q + 1] * bfhi(raw[i + j][q]); }
#pragma unroll
                for (int e = 0; e < 8; ++e) y[e] = y[e] / (1.0f + __expf(-y[e]));
                const int sw = (cc ^ (t & 15)) * 16;
                if (!isk) { v4u o;
#pragma unroll
                    for (int q = 0; q < 4; ++q) o[q] = cvtpk(y[2 * q] * 0.08838834764831845f, y[2 * q + 1] * 0.08838834764831845f);
                    *(LAS v4u*)(L + QS + t * 256 + sw) = o;
                } else { v4u o, o2;
#pragma unroll
                    for (int q = 0; q < 4; ++q) { o[q] = cvtpk(y[2 * q], y[2 * q + 1]); o2[q] = cvtpk(y[2 * q] * wsr, y[2 * q + 1] * wsr); }
#pragma unroll
                    for (int e = 0; e < 8; ++e) psum[e] += y[e] * wsr;
                    *(LAS v4u*)(L + KS + t * 256 + sw) = o;
                    *(LAS v4u*)(L + KT + (cc >> 2) * 4096 + t * 64 + (cc & 3) * 16) = o2;
                }
            }
            if (isk) { LAS float* ps = (LAS float*)(L + PS) + run * 128 + 8 * cc; *(LAS f32x4*)ps = (f32x4){psum[0], psum[1], psum[2], psum[3]}; *(LAS f32x4*)(ps + 4) = (f32x4){psum[4], psum[5], psum[6], psum[7]}; }
        }
        asm volatile("s_waitcnt vmcnt(0)" ::: "memory"); __syncthreads();
        const size_t row0 = rowb + (size_t)c * 64;
        if (c + 1 < SEQ / 64) {
#pragma unroll
            for (int k = 0; k < 7; ++k) raw[k] = *(const v4u*)(rawp + (row0 + 64 + t0 - 3 + k) * NP);
            gin = gpre[(row0 + 64 + lane) * 8 + h]; gfn = gpre[(row0 + 64 + lane) * 8 + 4 + h];
#pragma unroll
            for (int i = 0; i < 2; ++i) { const int p = w + 8 * i; GLDS16(vsrc + (size_t)((c + 1) * 64 + 16 * (p & 3)) * NP + 32 * (p >> 2), L + (par ? VS0 : VS1) + p * 1024); }
        }
        const size_t trow = row0 + 32 * tb + r32;
        typedef unsigned u2 __attribute__((ext_vector_type(2)));
        u2 mo[4];
#pragma unroll
        for (int g4 = 0; g4 < 4; ++g4) mo[g4] = *(const u2*)(P + trow * NP + O_MO + h * 128 + 32 * vb + 8 * g4 + 4 * hi);
        const LAS unsigned char* Vl = L + (par ? VS1 : VS0);
        const LAS unsigned char* Cr = L + (par ? CT1 : CT0); LAS unsigned char* Cw = L + (par ? CT0 : CT1);
        const LAS float* nr = (const LAS float*)(L + NS) + par * 128; LAS float* nw = (LAS float*)(L + NS) + (par ^ 1) * 128;
        const LAS float* g = (const LAS float*)(L + GS);
        const int tl = 32 * tb + r32;
        const float M2 = g[64 + tl], wi = g[128 + tl], ef = g[192 + tl];
        bf16x8 qf[8];
#pragma unroll
        for (int ks = 0; ks < 8; ++ks) qf[ks] = *(const LAS bf16x8*)(L + QS + tl * 256 + (((2 * ks + hi) ^ zsw) * 16));
        float qn = 0.f;
#pragma unroll
        for (int ks = 0; ks < 8; ++ks) { const f32x4 n0 = *(const LAS f32x4*)(nr + 16 * ks + 8 * hi), n1 = *(const LAS f32x4*)(nr + 16 * ks + 8 * hi + 4);
#pragma unroll
            for (int j = 0; j < 4; ++j) { qn += bf2f((unsigned short)qf[ks][j]) * n0[j]; qn += bf2f((unsigned short)qf[ks][4 + j]) * n1[j]; } }
        qn += __shfl_xor(qn, 32);
        f32x16 o = (f32x16){0.f, 0.f, 0.f, 0.f, 0.f, 0.f, 0.f, 0.f, 0.f, 0.f, 0.f, 0.f, 0.f, 0.f, 0.f, 0.f};
#pragma unroll
        for (int ks = 0; ks < 8; ++ks) { const bf16x8 a = *(const LAS bf16x8*)(Cr + (32 * vb + r32) * 256 + (((2 * ks + hi) ^ zsw) * 16)); o = __builtin_amdgcn_mfma_f32_32x32x16_bf16(a, qf[ks], o, 0, 0, 0); }
#pragma unroll
        for (int r = 0; r < 16; ++r) o[r] *= wi;
        bf16x8 vf[4];
#pragma unroll
        for (int s4 = 0; s4 < 4; ++s4) { const LAS unsigned char* vp = Vl + vb * 4096 + (16 * s4) * 64 + vlane; const s16x4 lo = ldtr(vp), hh = ldtr(vp + 8 * 64);
            vf[s4] = (bf16x8){lo[0], lo[1], lo[2], lo[3], hh[0], hh[1], hh[2], hh[3]}; }
        float dsum = 0.f;
#pragma unroll
        for (int sb = 0; sb < 2; ++sb) if (sb <= tb) {
            f32x16 S = (f32x16){0.f, 0.f, 0.f, 0.f, 0.f, 0.f, 0.f, 0.f, 0.f, 0.f, 0.f, 0.f, 0.f, 0.f, 0.f, 0.f};
#pragma unroll
            for (int ks = 0; ks < 8; ++ks) { const bf16x8 a = *(const LAS bf16x8*)(L + KS + (32 * sb + r32) * 256 + (((2 * ks + hi) ^ zsw) * 16)); S = __builtin_amdgcn_mfma_f32_32x32x16_bf16(a, qf[ks], S, 0, 0, 0); }
#pragma unroll
            for (int g4 = 0; g4 < 4; ++g4) { const f32x4 uu = *(const LAS f32x4*)(g + 32 * sb + 8 * g4 + 4 * hi);
#pragma unroll
                for (int e = 0; e < 4; ++e) { const int r = 4 * g4 + e; const int sl = 32 * sb + 8 * g4 + 4 * hi + e;
                    const float gm = (sl <= tl) ? __builtin_amdgcn_exp2f(uu[e] - M2) : 0.f; const float v = S[r] * gm; S[r] = v; dsum += v; } }
            o = __builtin_amdgcn_mfma_f32_32x32x16_bf16(vf[2 * sb], pack8(S, 0), o, 0, 0, 0);
            o = __builtin_amdgcn_mfma_f32_32x32x16_bf16(vf[2 * sb + 1], pack8(S, 8), o, 0, 0, 0);
        }
        dsum += __shfl_xor(dsum, 32);
        const float den = wi * qn + dsum;
        const float rden = 1.0f / fmaxf(fabsf(den), ef);
        { bf16* op = MIX + trow * D + 512 + h * 128 + 32 * vb + 4 * hi;
#pragma unroll
          for (int g4 = 0; g4 < 4; ++g4) { float x[4];
#pragma unroll
              for (int e = 0; e < 4; ++e) { const float og = (e & 1) ? bfhi(mo[g4][e >> 1]) : bflo(mo[g4][e >> 1]); x[e] = o[4 * g4 + e] * rden / (1.0f + __expf(-og)); }
              u2 wv; wv.x = cvtpk(x[0], x[1]); wv.y = cvtpk(x[2], x[3]); *(u2*)(op + 8 * g4) = wv; } }
#pragma unroll
        for (int i = 0; i < 2; ++i) {
#pragma unroll
            for (int r = 0; r < 16; ++r) Cacc[i][r] *= decay;
#pragma unroll
            for (int s4 = 0; s4 < 4; ++s4) { const LAS unsigned char* kp = L + KT + (2 * tb + i) * 4096 + (16 * s4) * 64 + vlane; const s16x4 lo = ldtr(kp), hh = ldtr(kp + 8 * 64);
                const bf16x8 a = (bf16x8){lo[0], lo[1], lo[2], lo[3], hh[0], hh[1], hh[2], hh[3]};
                Cacc[i] = __builtin_amdgcn_mfma_f32_32x32x16_bf16(a, vf[s4], Cacc[i], 0, 0, 0); }
            const int dv = 32 * vb + r32;
#pragma unroll
            for (int g4 = 0; g4 < 4; ++g4) { const int ch = 4 * (2 * tb + i) + g4; u2 wv; wv.x = cvtpk(Cacc[i][4 * g4], Cacc[i][4 * g4 + 1]); wv.y = cvtpk(Cacc[i][4 * g4 + 2], Cacc[i][4 * g4 + 3]);
                *(LAS u2*)(Cw + dv * 256 + ((ch ^ (dv & 15)) * 16) + 8 * hi) = wv; }
        }
        if (tid < 128) { float s = 0.f; const LAS float* ps = (const LAS float*)(L + PS) + tid;
#pragma unroll
            for (int q = 0; q < 16; ++q) s += ps[q * 128];
            nw[tid] = decay * nr[tid] + s; }
        mprev = b63 + M63;
        __syncthreads();
    }
}
__device__ __forceinline__ void p2_mix(Frame& F, const Args& a) {
    const bf16* P = (const bf16*)(a.ws + WS_P); bf16* MIX = (bf16*)(a.ws + WS_MIX);
    const int NSEQ = BATCH * 4;
    if ((int)blockIdx.x < NSEQ && F.G > NSEQ) {
        mlstm_seq(F, (int)blockIdx.x >> 2, (int)blockIdx.x & 3, P, (const float*)(a.ws + WS_GPRE), a.in[4], a.in[5], a.in[6], MIX);
    } else {
        const int nb = F.G > NSEQ ? F.G - NSEQ : F.G, b0 = F.G > NSEQ ? (int)blockIdx.x - NSEQ : (int)blockIdx.x;
        for (int u = b0; u < BATCH * 2 * 16; u += nb) swa_unit(F, u >> 5, (u >> 4) & 1, u & 15, P, a.in[7], MIX);
    }
}
__device__ __forceinline__ void p0_prologue(Frame& F, const Args& a) {
    unsigned char* ws = a.ws;
    LAS float* scr = (LAS float*)(F.lds + F.wave * 8448);
    LAS float* wgT = (LAS float*)(F.lds + 73728);
    const int gw = F.vcu * NWAVES + F.wave, NGW = F.G * NWAVES;
    {
        const float* w_in = a.in[3]; const float* gm = a.in[2];
        for (int i = F.tid; i < 8192; i += NWAVES * 64) { const int k = i >> 3, c = i & 7; wgT[c * 1024 + k] = gm[k] * w_in[(size_t)k * IN_COLS + O_G + c]; }
    }
    constexpr int I_IN = 16 * (NP / 32), I_KV = 16 * 64, I_SQ = 16 * 32, I_UP = 16 * (NU / 32), I_DN = (FF / 64) * 32;
    constexpr int NITEMS = I_IN + I_KV + 3 * I_SQ + I_UP + I_DN;
    for (int it = gw; it < NITEMS; it += NGW) {
        int r = it;
        if (r < I_IN) { const int nb = r % (NP / 32), kb = r / (NP / 32); p0_transpose_item(a.in[3], D, IN_COLS, 32 * nb, a.in[2], (bf16*)(ws + WS_WIN), 32 * nb, scr, kb, F.lane); continue; } r -= I_IN;
        if (r < I_KV) { const int nb = r % 64, kb = r / 64; p0_transpose_item(a.in[12], D, 2048, 32 * nb, a.in[10], (bf16*)(ws + WS_WKV), 32 * nb, scr, kb, F.lane); continue; } r -= I_KV;
        if (r < I_SQ) { const int nb = r % 32, kb = r / 32; p0_transpose_item(a.in[8], D, D, 32 * nb, nullptr, (bf16*)(ws + WS_WOUT), 32 * nb, scr, kb, F.lane); continue; } r -= I_SQ;
        if (r < I_SQ) { const int nb = r % 32, kb = r / 32; p0_transpose_item(a.in[11], D, D, 32 * nb, a.in[9], (bf16*)(ws + WS_WQ), 32 * nb, scr, kb, F.lane); continue; } r -= I_SQ;
        if (r < I_SQ) { const int nb = r % 32, kb = r / 32; p0_transpose_item(a.in[13], D, D, 32 * nb, nullptr, (bf16*)(ws + WS_WO), 32 * nb, scr, kb, F.lane); continue; } r -= I_SQ;
        if (r < I_UP) { const int nb = r % (NU / 32), kb = r / (NU / 32); p0_transpose_item(a.in[15], D, NU, 32 * nb, a.in[14], (bf16*)(ws + WS_WUP), 32 * nb, scr, kb, F.lane); continue; } r -= I_UP;
        { const int nb = r % 32, kb = r / 32; p0_transpose_item(a.in[18], FF, D, 32 * nb, nullptr, (bf16*)(ws + WS_WDN), 32 * nb, scr, kb, F.lane); }
    }
    __syncthreads();
    float* rstd0 = (float*)(ws + WS_RSTD0); float* gpre = (float*)(ws + WS_GPRE); bf16* XB = (bf16*)(ws + WS_XB);
    for (int m = gw; m < M; m += 2 * NGW) {
        f32x4 va[4], vc[4];
        row_load(a.in[0] + (size_t)m * D, F.lane, va); row_load(a.in[0] + (size_t)(m + NGW) * D, F.lane, vc);
#pragma unroll
        for (int hlf = 0; hlf < 2; ++hlf) {
            const int mm = m + hlf * NGW; const f32x4 (&v)[4] = hlf ? vc : va;
            const float ssq = row_to_bf16(XB + (size_t)mm * D, F.lane, v);
            const float rstd = 1.0f / sqrtf(ssq * (1.0f / D) + EPS);
            float ga[8];
#pragma unroll
            for (int c = 0; c < 8; ++c) { float s = 0.f;
#pragma unroll
                for (int j = 0; j < 4; ++j) { const f32x4 w = *(const LAS f32x4*)(wgT + c * 1024 + 256 * j + 4 * F.lane); s += (v[j][0] * w[0] + v[j][1] * w[1]) + (v[j][2] * w[2] + v[j][3] * w[3]); }
                ga[c] = wave_sum(s) * rstd; }
            if (F.lane == 0) { rstd0[mm] = rstd; *(f32x4*)(gpre + (size_t)mm * 8) = (f32x4){ga[0], ga[1], ga[2], ga[3]}; *(f32x4*)(gpre + (size_t)mm * 8 + 4) = (f32x4){ga[4], ga[5], ga[6], ga[7]}; }
        }
    }
    float* rstdm = (float*)(ws + WS_RSTDM); bf16* MEMB = (bf16*)(ws + WS_MEMB);
    for (int m = gw; m < MMEM; m += NGW) {
        f32x4 v[4];
        row_load(a.in[1] + (size_t)m * D, F.lane, v);
        const float ssq = row_to_bf16(MEMB + (size_t)m * D, F.lane, v);
        if (F.lane == 0) rstdm[m] = 1.0f / sqrtf(ssq * (1.0f / D) + EPS);
    }
}
__device__ __forceinline__ void p8_act(Frame& F, const Args& a) {
    bf16* U = (bf16*)(a.ws + WS_U); const float* cw = a.in[16]; const float* cb = a.in[17];
    constexpr int NCH = FF / 8, RUN = 16, NIT = (M / RUN) * NCH;
    for (int it = blockIdx.x * (NWAVES * 64) + F.tid; it < NIT; it += F.G * NWAVES * 64) {
        const int ch = it % NCH, r = it / NCH, row0 = r * RUN, t0 = row0 % SEQ, c0 = ch * 8;
        float w0[8], w1[8], w2[8], bb[8];
#pragma unroll
        for (int e = 0; e < 8; e += 4) { const f32x4 x0 = *(const f32x4*)(cw + c0 + e), x1 = *(const f32x4*)(cw + FF + c0 + e), x2 = *(const f32x4*)(cw + 2 * FF + c0 + e), x3 = *(const f32x4*)(cb + c0 + e);
#pragma unroll
            for (int q = 0; q < 4; ++q) { w0[e + q] = x0[q]; w1[e + q] = x1[q]; w2[e + q] = x2[q]; bb[e + q] = x3[q]; } }
        v4u gm2 = (v4u){0u, 0u, 0u, 0u}, gm1 = gm2;
        if (t0 >= 2) { gm2 = *(const v4u*)(U + (size_t)(row0 - 2) * NU + c0); gm1 = *(const v4u*)(U + (size_t)(row0 - 1) * NU + c0); }
#pragma unroll 4
        for (int i = 0; i < RUN; ++i) {
            bf16* rp = U + (size_t)(row0 + i) * NU;
            const v4u g0 = *(const v4u*)(rp + c0), vv = *(const v4u*)(rp + FF + c0);
            v4u o;
#pragma unroll
            for (int q = 0; q < 4; ++q) {
                const float ga = w0[2 * q] * bflo(gm2[q]) + w1[2 * q] * bflo(gm1[q]) + w2[2 * q] * bflo(g0[q]) + bb[2 * q];
                const float gb = w0[2 * q + 1] * bfhi(gm2[q]) + w1[2 * q + 1] * bfhi(gm1[q]) + w2[2 * q + 1] * bfhi(g0[q]) + bb[2 * q + 1];
                const float ra = ga / (1.0f + __expf(-ga)) * bflo(vv[q]), rb = gb / (1.0f + __expf(-gb)) * bfhi(vv[q]);
                o[q] = pk2(ra, rb);
            }
            *(v4u*)(rp + FF + c0) = o;
            gm2 = gm1; gm1 = g0;
        }
    }
}
__device__ __forceinline__ void p10_final(Frame& F, const Args& a) {
    const int gw = F.vcu * NWAVES + F.wave, NGW = F.G * NWAVES;
    const float* gf = a.in[19]; const pg8::RsParts rs{(const float*)(a.ws + WS_SSQ3)};
    f32x4 gv[4];
#pragma unroll
    for (int j = 0; j < 4; ++j) gv[j] = ((const f32x4*)gf)[64 * j + F.lane];
    for (int m = gw; m < M; m += NGW) {
        const float r = rs.get(m);
        GAS f32x4* xr = (GAS f32x4*)(a.out + (size_t)m * D) + F.lane;
#pragma unroll
        for (int j = 0; j < 4; ++j) { const f32x4 v = xr[64 * j]; xr[64 * j] = v * r * gv[j]; }
    }
}

#ifndef PROBE_REP
#define PROBE_REP (-1)
#endif
#ifndef PG8_SP2
#define PG8_SP2 true
#endif
#ifndef PG8_ALIGN
#define PG8_ALIGN true
#endif
enum { PH_PRO = 0, PH_G1 = 1, PH_MIX = 2, PH_G2 = 3, PH_G3 = 4, PH_XAT = 5, PH_G4 = 6, PH_G5 = 7, PH_ACT = 8, PH_G6 = 9, PH_FIN = 10, PH_N = 11 };

__device__ __forceinline__ bool phase_in(Frame& F, int lo, int hi, int k) {
    if (!(lo <= k && k < hi)) return false;
    int t_ = threadIdx.x; asm volatile("" : "+v"(t_)); F.tid = t_; F.lane = t_ & 63; return true;
}
__global__ void __launch_bounds__(NWAVES * 64, 2) mk_fwd(Args args) {
    extern __shared__ __attribute__((aligned(16))) unsigned char lds[];
    Frame F;
    F.lds = (LAS unsigned char*)lds;
    F.MISC = (volatile LAS unsigned*)(F.lds + MISC_OFF);
    F.tid = threadIdx.x; F.lane = F.tid & 63; F.wave = __builtin_amdgcn_readfirstlane(F.tid >> 6);
    F.G = gridDim.x; { const int bx = blockIdx.x; F.vcu = (F.G % 8 == 0) ? (bx % 8) * (F.G / 8) + bx / 8 : bx; }
    unsigned char* ws = args.ws;
    F.ctl = (gu32*)(ws + WS_CTL);
    for (int u = F.tid; u < (LDS_BYTES - LDSCTL_OFF) / 4; u += NWAVES * 64) ((LAS unsigned*)(F.lds + LDSCTL_OFF))[u] = 0u;
    __syncthreads();
    const int lo = args.ph_lo, hi = args.ph_hi;
    XcdBarrier bar = xcd_barrier_post((unsigned*)(F.ctl + CW_BAR) + args.li * XCD_BAR_WORDS, F.MISC + 8);
#define IN(k) (phase_in(F, lo, hi, (k)))
#define SEAM(k) do { if (lo <= (k) && (k) + 1 < hi) xcd_barrier(bar); } while (0)
    bf16* XB = (bf16*)(ws + WS_XB); bf16* P = (bf16*)(ws + WS_P); bf16* MIX = (bf16*)(ws + WS_MIX); bf16* QX = (bf16*)(ws + WS_QX); bf16* XO = (bf16*)(ws + WS_XO); bf16* U = (bf16*)(ws + WS_U);
    const int G = F.G, bx = (int)blockIdx.x;

    if (IN(PH_PRO)) { p0_prologue(F, args); SEAM(PH_PRO); }
    if (IN(PH_G1)) {
        { pg8::Gemm g{XB, D, (const bf16*)(ws + WS_WIN), M, NP, D}; pg8::StaticOrder S; S.init(M, NP, G, bx);
          pg8::EpiScaleBf16<pg8::RsArr> E{P, NP, {(const float*)(ws + WS_RSTD0)}};
          pg8::gemm_phase<pg8::EpiScaleBf16<pg8::RsArr>, pg8::StaticOrder, PG8_ALIGN, PG8_SP2>(F.lds + RING_OFF, g, S, E); }
        { pg8::Gemm g{(const bf16*)(ws + WS_MEMB), D, (const bf16*)(ws + WS_WKV), MMEM, 2048, D}; pg8::StaticOrder S; S.init(MMEM, 2048, G, (bx + G / 2) % G);
          pg8::EpiScaleBf16<pg8::RsArr> E{(bf16*)(ws + WS_KVM), 2048, {(const float*)(ws + WS_RSTDM)}};
          pg8::gemm_phase<pg8::EpiScaleBf16<pg8::RsArr>, pg8::StaticOrder, PG8_ALIGN, PG8_SP2>(F.lds + RING_OFF, g, S, E); }
        SEAM(PH_G1);
    }
    if (IN(PH_MIX)) { p2_mix(F, args); SEAM(PH_MIX); }
    if (IN(PH_G2)) {
        pg8::Gemm g{MIX, D, (const bf16*)(ws + WS_WOUT), M, D, D}; pg8::StaticOrder S; S.init(M, D, G, bx);
        pg8::EpiResid<true> E{args.in[0], args.out, XB, (float*)(ws + WS_SSQ1), D};
        pg8::gemm_phase<pg8::EpiResid<true>, pg8::StaticOrder, PG8_ALIGN, PG8_SP2>(F.lds + RING_OFF, g, S, E);
        SEAM(PH_G2);
    }
    if (IN(PH_G3)) {
        pg8::Gemm g{XB, D, (const bf16*)(ws + WS_WQ), M, D, D}; pg8::StaticOrder S; S.init(M, D, G, bx);
        pg8::EpiScaleBf16<pg8::RsOne> E{QX, D, {}};
        pg8::gemm_phase<pg8::EpiScaleBf16<pg8::RsOne>, pg8::StaticOrder, PG8_ALIGN, PG8_SP2>(F.lds + RING_OFF, g, S, E);
        SEAM(PH_G3);
    }
    if (IN(PH_XAT)) { p5_xattn(F, args); SEAM(PH_XAT); }
    if (IN(PH_G4)) {
        pg8::Gemm g{XO, D, (const bf16*)(ws + WS_WO), M, D, D}; pg8::StaticOrder S; S.init(M, D, G, bx);
        pg8::EpiResid<true> E{args.out, args.out, XB, (float*)(ws + WS_SSQ2), D};
        pg8::gemm_phase<pg8::EpiResid<true>, pg8::StaticOrder, PG8_ALIGN, PG8_SP2>(F.lds + RING_OFF, g, S, E);
        SEAM(PH_G4);
    }
    if (IN(PH_G5)) {
        pg8::Gemm g{XB, D, (const bf16*)(ws + WS_WUP), M, NU, D}; pg8::StaticOrder S; S.init(M, NU, G, bx);
        pg8::EpiScaleBf16<pg8::RsParts> E{U, NU, {(const float*)(ws + WS_SSQ2)}};
        pg8::gemm_phase<pg8::EpiScaleBf16<pg8::RsParts>, pg8::StaticOrder, PG8_ALIGN, PG8_SP2>(F.lds + RING_OFF, g, S, E);
        SEAM(PH_G5);
    }
    if (IN(PH_ACT)) { p8_act(F, args); SEAM(PH_ACT); }
    if (IN(PH_G6)) {
        pg8::Gemm g{U + FF, NU, (const bf16*)(ws + WS_WDN), M, D, FF}; pg8::StaticOrder S; S.init(M, D, G, bx);
        pg8::EpiResid<false> E{args.out, args.out, nullptr, (float*)(ws + WS_SSQ3), D};
        pg8::gemm_phase<pg8::EpiResid<false>, pg8::StaticOrder, PG8_ALIGN, PG8_SP2>(F.lds + RING_OFF, g, S, E);
        SEAM(PH_G6);
    }
    if (IN(PH_FIN)) { p10_final(F, args); }
#undef IN
#undef SEAM
}
extern "C" void kernel_launch(void* const* d_in, const int* in_sizes, int n_in, void* d_out, int out_size, void* d_ws, size_t ws_size, hipStream_t stream) {
    static int grid = 0;
    if (grid == 0) {
        if (n_in != 20 || in_sizes[0] != M * D || out_size != M * D || ws_size < WS_END) { fprintf(stderr, "kernel_launch: shape/workspace mismatch: n_in %d in0 %d out %d ws %zu (need %zu)\n", n_in, n_in > 0 ? in_sizes[0] : -1, out_size, ws_size, (size_t)WS_END); grid = -1; return; }
        int dev = 0, cus = 0, per_cu = 0;
        if (hipGetDevice(&dev) != hipSuccess || hipDeviceGetAttribute(&cus, hipDeviceAttributeMultiprocessorCount, dev) != hipSuccess) { fprintf(stderr, "kernel_launch: device query failed\n"); grid = -1; return; }
        if (hipFuncSetAttribute((const void*)mk_fwd, hipFuncAttributeMaxDynamicSharedMemorySize, LDS_BYTES) != hipSuccess) { fprintf(stderr, "kernel_launch: hipFuncSetAttribute failed\n"); grid = -1; return; }
        if (hipOccupancyMaxActiveBlocksPerMultiprocessor(&per_cu, (const void*)mk_fwd, NWAVES * 64, LDS_BYTES) != hipSuccess || per_cu < 1) { fprintf(stderr, "kernel_launch: occupancy query reports %d workgroups per CU\n", per_cu); (void)hipGetLastError(); grid = -1; return; }
        grid = cus;
    }
    if (grid < 0) return;
    (void)hipMemsetAsync((char*)d_ws + WS_CTL, 0, CTL_ZERO_BYTES, stream);
    Args a{};
    for (int i = 0; i < 20; ++i) a.in[i] = (const float*)d_in[i];
    a.out = (float*)d_out; a.ws = (unsigned char*)d_ws;
    unsigned char* ws = (unsigned char*)d_ws;
    auto launch = [&](int lo, int hi, int li) { a.ph_lo = lo; a.ph_hi = hi; a.li = li; hipLaunchKernelGGL(mk_fwd, dim3(grid), dim3(NWAVES * 64), LDS_BYTES, stream, a); };
#if PROBE_REP >= 0
    launch(PH_PRO, PROBE_REP + 1, 0); launch(PROBE_REP, PH_N, 1);
#else
    launch(PH_PRO, PH_N, 0);
#endif
}
```

```cpp
#include <hip/hip_runtime.h>
#include <cstdio>
#include <cstdint>
namespace pg8 {
#define PG8_LAS __attribute__((address_space(3)))
typedef unsigned short bf16_t;
typedef short bf16x8 __attribute__((ext_vector_type(8)));
typedef float f32x4 __attribute__((ext_vector_type(4)));
typedef unsigned u32x4 __attribute__((ext_vector_type(4)));
constexpr int BM = 256, BK = 64, HALF = 128, HTB = HALF * BK * 2  , STAGE_BYTES = 8 * HTB, NXCD = 8, WGM = 8;

__host__ __device__ __forceinline__ int lds_byte(int r, int c) { const int st = (r >> 4) * 2 + (c >> 5), rr = r & 15, cc = c & 31, ob = rr * 64 + cc * 2; return st * 1024 + (ob ^ (((ob >> 9) & 1) << 5)); }
__host__ __device__ __forceinline__ void stage_rc(int b, int& R, int& C) { const int st = b / 1024, sb = b % 1024, swz = sb ^ (((sb >> 9) & 1) << 5); R = (st >> 1) * 16 + swz / 64; C = (st & 1) * 32 + (swz % 64) / 2; }
__host__ __device__ __forceinline__ int perm32(int rho) { const int n = rho >> 4, i = rho & 15; return 8 * (i >> 2) + 4 * n + (i & 3); }

struct Unit { int pm, pn; };
struct Gemm { const bf16_t* A; int lda; const bf16_t* Bt; int M, N, K; };

struct StaticOrder {
    int nM, nN, nwg, G, c;
    __host__ __device__ void init(int M, int N, int G_, int c_) { nM = M / BM; nN = N / BM; nwg = nM * nN; G = G_; c = c_; }
    __host__ __device__ bool next(int i, Unit& u) const {
        const long L = (long)i * G + c; if (L >= nwg) return false;
        int wgid = (int)L; { const int q = nwg / NXCD, r = nwg % NXCD, xcd = wgid % NXCD, off = wgid / NXCD; wgid = (xcd < r ? xcd * (q + 1) : r * (q + 1) + (xcd - r) * q) + off; }
        const int nig = WGM * nN, gid = wgid / nig, fm = gid * WGM, gsz = (nM - fm) < WGM ? (nM - fm) : WGM;
        u.pm = fm + ((wgid % nig) % gsz); u.pn = (wgid % nig) / gsz; return true;
    }
    __device__ __forceinline__ void a_ready(const Unit&) const {}
    __device__ __forceinline__ void done(const Unit&) const {}
};

__device__ __forceinline__ unsigned cvt_pk_bf16(float lo, float hi) { unsigned r; asm volatile("v_cvt_pk_bf16_f32 %0, %1, %2" : "=v"(r) : "v"(lo), "v"(hi)); return r; }
typedef float f32x2 __attribute__((ext_vector_type(2)));
constexpr float RMS_EPS = 1e-6f;
struct RsOne   { __device__ __forceinline__ float get(int) const { return 1.0f; } };
struct RsArr   { const float* r; __device__ __forceinline__ float get(int row) const { return r[row]; } };
struct RsParts { const float* p;
    __device__ __forceinline__ float get(int row) const { const f32x4* q = (const f32x4*)(p + (size_t)row * 16); const f32x4 a = q[0], b = q[1], c = q[2], d = q[3];
        const float s = ((a[0] + a[1]) + (a[2] + a[3])) + ((b[0] + b[1]) + (b[2] + b[3])) + ((c[0] + c[1]) + (c[2] + c[3])) + ((d[0] + d[1]) + (d[2] + d[3]));
        return 1.0f / sqrtf(s * (1.0f / 1024.0f) + RMS_EPS); } };
template <class RS> struct EpiScaleBf16 {
    static constexpr bool PERM = true, AFTER_DRAIN = false;
    bf16_t* O; int ldc; RS rs;
    __device__ __forceinline__ void operator()(const f32x4 (&acc)[2][2][4][2], const Unit& u, int wr, int wc, int fr, int fq) const {
        const int row0 = u.pm * BM + wr * 64 + fr, col0 = u.pn * BM + wc * 32 + 8 * fq;
#pragma unroll
        for (int ai = 0; ai < 2; ++ai)
#pragma unroll
            for (int m = 0; m < 4; ++m) { const int row = row0 + ai * HALF + m * 16; const float sc = rs.get(row); bf16_t* rowp = O + (size_t)row * ldc + col0;
#pragma unroll
                for (int bj = 0; bj < 2; ++bj) { const f32x4 v0 = acc[ai][bj][m][0] * sc, v1 = acc[ai][bj][m][1] * sc;
                    u32x4 w; w.x = cvt_pk_bf16(v0[0], v0[1]); w.y = cvt_pk_bf16(v0[2], v0[3]); w.z = cvt_pk_bf16(v1[0], v1[1]); w.w = cvt_pk_bf16(v1[2], v1[3]);
                    *(u32x4*)(rowp + bj * HALF) = w; } }
    }
};
template <bool WRITE_BF16> struct EpiResid {
    static constexpr bool PERM = false, AFTER_DRAIN = false;
    const float* base; float* out; bf16_t* xb; float* ssq; int ldc;
    __device__ __forceinline__ void operator()(const f32x4 (&acc)[2][2][4][2], const Unit& u, int wr, int wc, int fr, int fq) const {
        typedef unsigned u32x2v __attribute__((ext_vector_type(2)));
        const int row0 = u.pm * BM + wr * 64 + fr, col0 = u.pn * BM + wc * 32 + 4 * fq;
#pragma unroll
        for (int ai = 0; ai < 2; ++ai) {
            f32x4 pre[4][2][2];
#pragma unroll
            for (int m = 0; m < 4; ++m) { const size_t off = (size_t)(row0 + ai * HALF + m * 16) * ldc + col0;
#pragma unroll
                for (int bj = 0; bj < 2; ++bj)
#pragma unroll
                    for (int n = 0; n < 2; ++n) pre[m][bj][n] = *(const f32x4*)(base + off + bj * HALF + n * 16); }
#pragma unroll
            for (int m = 0; m < 4; ++m) { const int row = row0 + ai * HALF + m * 16; const size_t off = (size_t)row * ldc + col0; float ss = 0.f;
#pragma unroll
                for (int bj = 0; bj < 2; ++bj)
#pragma unroll
                    for (int n = 0; n < 2; ++n) { const size_t o2 = off + bj * HALF + n * 16; const f32x4 o = pre[m][bj][n] + acc[ai][bj][m][n];
                        *(f32x4*)(out + o2) = o; ss += (o[0] * o[0] + o[1] * o[1]) + (o[2] * o[2] + o[3] * o[3]);
                        if (WRITE_BF16) { u32x2v w; w.x = cvt_pk_bf16(o[0], o[1]); w.y = cvt_pk_bf16(o[2], o[3]); *(u32x2v*)(xb + o2) = w; } }
                ss += __shfl_xor(ss, 16); ss += __shfl_xor(ss, 32);
                if (fq == 0) ssq[(size_t)row * 16 + u.pn * 4 + wc] = ss; }
            asm volatile("" ::: "memory");
        }
    }
};
template <class Epi, class Sched, bool ALIGN_EPI = false, bool SP2 = false>
__device__ __forceinline__ void gemm_phase(PG8_LAS unsigned char* lds, const Gemm g, const Sched& S, const Epi& E) {
    const int tid = threadIdx.x, wid = __builtin_amdgcn_readfirstlane(tid >> 6), lane = tid & 63, wr = wid >> 2, wc = wid & 3, fr = lane & 15, fq = lane >> 4;
    const int K = g.K, nt = K / BK;
    unsigned voffA[2], voffB[2];
#pragma unroll
    for (int i = 0; i < 2; ++i) { int R, C; stage_rc(tid * 16 + i * 8192, R, C); const int Rb = Epi::PERM ? ((R & ~31) + perm32(R & 31)) : R;
        voffA[i] = (unsigned)(R * g.lda + C) * 2u; voffB[i] = (unsigned)(Rb * K + C) * 2u; }
    const size_t kstep = (size_t)(BK * 2);
    const size_t hstepA = (size_t)HALF * g.lda * 2, hstepB = (size_t)HALF * K * 2;
    const size_t tstepA = 2 * hstepA, tstepB = 2 * hstepB;
    const unsigned ldsw = (unsigned)wid * 1024u;
    const int aoff = lds_byte(wr * 64 + fr, fq * 8), boff = lds_byte(wc * 32 + fr, fq * 8);
#define PG8_SA(b, h) (((b) * 2 + (h)) * HTB)
#define PG8_SB(b, h) ((4 + (b) * 2 + (h)) * HTB)
#define PG8_STAGE(bufoff, gbase, voff) do { _Pragma("unroll") for (int _i = 0; _i < 2; ++_i) \
        __builtin_amdgcn_global_load_lds((const unsigned*)((const char*)(gbase) + (voff)[_i]), (PG8_LAS unsigned*)(lds + (bufoff) + ldsw + _i * 8192), 16, 0, 0); } while (0)
#define PG8_LDA(dst, b, h) do { _Pragma("unroll") for (int m = 0; m < 4; ++m) _Pragma("unroll") for (int k = 0; k < 2; ++k) dst[m][k] = *(const PG8_LAS bf16x8*)(lds + PG8_SA(b, h) + aoff + m * 2048 + k * 1024); } while (0)
#define PG8_LDB(dst, b, h) do { _Pragma("unroll") for (int n = 0; n < 2; ++n) _Pragma("unroll") for (int k = 0; k < 2; ++k) dst[n][k] = *(const PG8_LAS bf16x8*)(lds + PG8_SB(b, h) + boff + n * 2048 + k * 1024); } while (0)
#define PG8_MMA(ai, bj, At, Bt) do { __builtin_amdgcn_s_setprio(1); _Pragma("unroll") for (int m = 0; m < 4; ++m) _Pragma("unroll") for (int n = 0; n < 2; ++n) _Pragma("unroll") for (int k = 0; k < 2; ++k) \
        acc[ai][bj][m][n] = __builtin_amdgcn_mfma_f32_16x16x32_bf16(Bt[n][k], At[m][k], acc[ai][bj][m][n], 0, 0, 0); __builtin_amdgcn_s_setprio(0); } while (0)
#define PG8_WAIT_V(n) asm volatile("s_waitcnt vmcnt(" #n ")" ::: "memory")
#define PG8_WAIT_L(n) asm volatile("s_waitcnt lgkmcnt(" #n ")" ::: "memory")
#define PG8_BAR __builtin_amdgcn_s_barrier()
#define PG8_SCHED __builtin_amdgcn_sched_barrier(0)
    Unit cur, nxt; int ui = 0;
    if (!S.next(0, cur)) return;
    f32x4 acc[2][2][4][2];
#pragma unroll
    for (int a = 0; a < 2; ++a)
#pragma unroll
        for (int b = 0; b < 2; ++b)
#pragma unroll
            for (int m = 0; m < 4; ++m)
#pragma unroll
                for (int n = 0; n < 2; ++n) acc[a][b][m][n] = (f32x4){0.f, 0.f, 0.f, 0.f};
    bf16x8 At[4][2], B0[2][2], B1[2][2];
    const char* cA = (const char*)g.A + (size_t)cur.pm * tstepA; const char* cB = (const char*)g.Bt + (size_t)cur.pn * tstepB;
    S.a_ready(cur);
    if constexpr (SP2) {
        PG8_STAGE(PG8_SB(0, 0), cB, voffB); PG8_STAGE(PG8_SB(0, 1), cB + hstepB, voffB); PG8_STAGE(PG8_SA(0, 0), cA, voffA); PG8_STAGE(PG8_SA(0, 1), cA + hstepA, voffA);
        if (wr == 1) PG8_BAR;
        PG8_WAIT_V(2); PG8_BAR;
        PG8_STAGE(PG8_SB(1, 0), cB + kstep, voffB); PG8_STAGE(PG8_SA(1, 0), cA + kstep, voffA); PG8_STAGE(PG8_SB(1, 1), cB + hstepB + kstep, voffB);
        PG8_WAIT_V(6); PG8_BAR;
    } else {
        PG8_STAGE(PG8_SB(0, 0), cB, voffB); PG8_STAGE(PG8_SA(0, 0), cA, voffA); PG8_STAGE(PG8_SB(0, 1), cB + hstepB, voffB); PG8_STAGE(PG8_SA(0, 1), cA + hstepA, voffA);
        if (wr == 1) PG8_BAR;
        PG8_WAIT_V(4); PG8_BAR;
        PG8_STAGE(PG8_SB(1, 0), cB + kstep, voffB); PG8_STAGE(PG8_SA(1, 0), cA + kstep, voffA); PG8_STAGE(PG8_SB(1, 1), cB + hstepB + kstep, voffB);
        PG8_WAIT_V(6); PG8_BAR;
    }
    for (;;) {
        const bool has_next = S.next(ui + 1, nxt);
        const char* nA = has_next ? (const char*)g.A + (size_t)nxt.pm * tstepA : cA; const char* nB = has_next ? (const char*)g.Bt + (size_t)nxt.pn * tstepB : cB;
        for (int t = 0; t < nt; t += 2) {
            const bool last = (t == nt - 2);
            const char* a1 = cA + (size_t)(t + 1) * kstep;
            const char* a2 = last ? nA : cA + (size_t)(t + 2) * kstep; const char* b2 = last ? nB : cB + (size_t)(t + 2) * kstep;
            const char* a3 = a2 + kstep; const char* b3 = b2 + kstep;
            if (last && has_next) S.a_ready(nxt);
            if constexpr (SP2) {
            PG8_LDB(B0, 0, 0); PG8_LDB(B1, 0, 1); PG8_SCHED; PG8_LDA(At, 0, 0); PG8_STAGE(PG8_SA(1, 1), a1 + hstepA, voffA);
            PG8_WAIT_V(8); PG8_WAIT_L(0); PG8_BAR; PG8_MMA(0, 0, At, B0); PG8_MMA(0, 1, At, B1); PG8_BAR; PG8_SCHED;
            PG8_LDA(At, 0, 1); PG8_STAGE(PG8_SB(0, 0), b2, voffB); PG8_STAGE(PG8_SB(0, 1), b2 + hstepB, voffB); PG8_STAGE(PG8_SA(0, 0), a2, voffA);
            PG8_WAIT_V(8); PG8_WAIT_L(0); PG8_BAR; PG8_MMA(1, 0, At, B0); PG8_MMA(1, 1, At, B1); PG8_BAR; PG8_SCHED;
            PG8_LDB(B0, 1, 0); PG8_LDB(B1, 1, 1); PG8_SCHED; PG8_LDA(At, 1, 0); PG8_STAGE(PG8_SA(0, 1), a2 + hstepA, voffA);
            PG8_WAIT_V(8); PG8_WAIT_L(0); PG8_BAR; PG8_MMA(0, 0, At, B0); PG8_MMA(0, 1, At, B1); PG8_BAR; PG8_SCHED;
            PG8_LDA(At, 1, 1); PG8_STAGE(PG8_SB(1, 0), b3, voffB); PG8_STAGE(PG8_SB(1, 1), b3 + hstepB, voffB); PG8_STAGE(PG8_SA(1, 0), a3, voffA);
            PG8_WAIT_V(8); PG8_WAIT_L(0); PG8_BAR; PG8_MMA(1, 0, At, B0); PG8_MMA(1, 1, At, B1); PG8_BAR; PG8_SCHED;
            } else {
            PG8_LDB(B0, 0, 0); PG8_SCHED; PG8_LDA(At, 0, 0); PG8_STAGE(PG8_SA(1, 1), a1 + hstepA, voffA);
            PG8_WAIT_L(8); PG8_BAR; PG8_WAIT_L(0); PG8_MMA(0, 0, At, B0); PG8_BAR; PG8_SCHED;
            PG8_LDB(B1, 0, 1); PG8_STAGE(PG8_SB(0, 0), b2, voffB);
            PG8_BAR; PG8_WAIT_L(0); PG8_MMA(0, 1, At, B1); PG8_BAR;
            PG8_LDA(At, 0, 1); PG8_STAGE(PG8_SA(0, 0), a2, voffA);
            PG8_BAR; PG8_WAIT_L(0); PG8_MMA(1, 0, At, B0); PG8_BAR; PG8_SCHED;
            PG8_STAGE(PG8_SB(0, 1), b2 + hstepB, voffB);
            PG8_WAIT_V(6); PG8_BAR; PG8_MMA(1, 1, At, B1); PG8_BAR;
            PG8_LDB(B0, 1, 0); PG8_SCHED; PG8_LDA(At, 1, 0); PG8_STAGE(PG8_SA(0, 1), a2 + hstepA, voffA);
            PG8_WAIT_L(8); PG8_BAR; PG8_WAIT_L(0); PG8_MMA(0, 0, At, B0); PG8_BAR; PG8_SCHED;
            PG8_LDB(B1, 1, 1); PG8_STAGE(PG8_SB(1, 0), b3, voffB);
            PG8_BAR; PG8_WAIT_L(0); PG8_MMA(0, 1, At, B1); PG8_BAR;
            PG8_LDA(At, 1, 1); PG8_STAGE(PG8_SA(1, 0), a3, voffA);
            PG8_BAR; PG8_WAIT_L(0); PG8_MMA(1, 0, At, B0); PG8_BAR; PG8_SCHED;
            PG8_STAGE(PG8_SB(1, 1), b3 + hstepB, voffB);
            PG8_WAIT_V(6); PG8_BAR; PG8_MMA(1, 1, At, B1); PG8_BAR;
            }
        }
        if constexpr (ALIGN_EPI) { if (wr == 0) PG8_BAR; }
        if constexpr (!Epi::AFTER_DRAIN) { E(acc, cur, wr, wc, fr, fq); S.done(cur); }
        if (!has_next) break;
#pragma unroll
        for (int a = 0; a < 2; ++a)
#pragma unroll
            for (int b = 0; b < 2; ++b)
#pragma unroll
                for (int m = 0; m < 4; ++m)
#pragma unroll
                    for (int n = 0; n < 2; ++n) acc[a][b][m][n] = (f32x4){0.f, 0.f, 0.f, 0.f};
        cur = nxt; cA = nA; cB = nB; ++ui;
        if constexpr (ALIGN_EPI) { if (wr == 1) PG8_BAR; }
    }
    PG8_WAIT_V(0);
    if constexpr (!ALIGN_EPI) { if (wr == 0) PG8_BAR; }
    PG8_BAR;
    if constexpr (Epi::AFTER_DRAIN) { E.fused(acc, cur, wr, wc, fr, fq, lds, wid, lane); S.done(cur); }
#undef PG8_SA
#undef PG8_SB
#undef PG8_STAGE
#undef PG8_LDA
#undef PG8_LDB
#undef PG8_MMA
#undef PG8_WAIT_V
#undef PG8_WAIT_L
#undef PG8_BAR
#undef PG8_SCHED
}
}
#define GAS __attribute__((address_space(1)))
#define LAS __attribute__((address_space(3)))
typedef unsigned short bf16;
typedef unsigned v4u __attribute__((ext_vector_type(4)));
typedef float f32x4 __attribute__((ext_vector_type(4)));
typedef short bf16x8 __attribute__((ext_vector_type(8)));
typedef GAS unsigned gu32;
typedef GAS unsigned long long gu64;
#define RLX_AGENT __ATOMIC_RELAXED, __HIP_MEMORY_SCOPE_AGENT
#define LDS_WAIT() asm volatile("s_waitcnt lgkmcnt(0)" ::: "memory")
#define VM_WAIT() asm volatile("s_waitcnt vmcnt(0)" ::: "memory")
__device__ __forceinline__ unsigned long long rt() { return __builtin_amdgcn_s_memrealtime(); }
__device__ __forceinline__ unsigned f2bf(float f) { unsigned u = __builtin_bit_cast(unsigned, f); return (u + 0x7fffu + ((u >> 16) & 1u)) >> 16; }
__device__ __forceinline__ unsigned pk2(float lo, float hi) { return f2bf(lo) | (f2bf(hi) << 16); }

#define XB_TMO      128
#define XB_XCNT(j)  (256  + 64 * (j))
#define XB_XSUB(j)  (1280 + 64 * (j))
#define XB_XGEN(j)  (2304 + 64 * (j))
#define XB_TOP      3328
#define XB_TOPGEN   3392
#define XCD_BAR_WORDS 3456
#define XB_SPIN_CAP (1u << 18)

__device__ __forceinline__ unsigned xb_ld(unsigned* p)              { return __hip_atomic_load(p, __ATOMIC_RELAXED, __HIP_MEMORY_SCOPE_AGENT); }
__device__ __forceinline__ unsigned xb_add(unsigned* p, unsigned v) { return __hip_atomic_fetch_add(p, v, __ATOMIC_RELAXED, __HIP_MEMORY_SCOPE_AGENT); }
__device__ __forceinline__ unsigned xb_xcc_id() { return (unsigned)__builtin_amdgcn_s_getreg((3 << 11) | 20) & 0xFu; }
#define XB_SPIN(cond, bar) do { unsigned _sp = 0; while (cond) { __builtin_amdgcn_s_sleep(1); \
    if ((++_sp & 255u) == 0u) { if (xb_ld(&(bar)[XB_TMO])) break; if (_sp > XB_SPIN_CAP) { atomicAdd(&(bar)[XB_TMO], 1u); break; } } } } while (0)

struct XcdBarrier {
    unsigned* bar; unsigned x;
    volatile LAS unsigned* st;
};

__device__ __forceinline__ XcdBarrier xcd_barrier_post(unsigned* bar, volatile LAS unsigned* st) {
    XcdBarrier b; b.bar = bar; b.x = xb_xcc_id(); b.st = st;
    if (threadIdx.x == 0) (void)xb_add(&bar[XB_XCNT(b.x)], 1u);
    return b;
}
__device__ __forceinline__ void xcd_barrier_complete(unsigned* bar, unsigned x, unsigned& nloc, unsigned& nx) {
    const unsigned G = gridDim.x * gridDim.y * gridDim.z;
    unsigned sum, cnt, mine, sp = 0u;
    for (;;) {
        sum = 0u; cnt = 0u; mine = 0u;
#pragma unroll
        for (unsigned j = 0; j < 16; ++j) { const unsigned c = xb_ld(&bar[XB_XCNT(j)]); sum += c; cnt += (c > 0u) ? 1u : 0u; mine = (j == x) ? c : mine; }
        if (sum == G) break;
        __builtin_amdgcn_s_sleep(1);
        if ((++sp & 255u) == 0u) { if (xb_ld(&bar[XB_TMO])) break; if (sp > XB_SPIN_CAP) { atomicAdd(&bar[XB_TMO], 1u); break; } }
    }
    nloc = mine > 0u ? mine : 1u; nx = cnt > 0u ? cnt : 1u;
}

__device__ __forceinline__ void xcd_barrier(const XcdBarrier& b) {
    asm volatile("s_waitcnt vmcnt(0)" ::: "memory");
    __syncthreads();
    if (threadIdx.x == 0) {
        unsigned* bar = b.bar;
        __builtin_amdgcn_s_waitcnt(0);
        unsigned nloc = b.st[0], nx = b.st[1];
        if (nloc == 0u) { xcd_barrier_complete(bar, b.x, nloc, nx); b.st[0] = nloc; b.st[1] = nx; }
        const unsigned old = xb_add(&bar[XB_XSUB(b.x)], 1u);
        const unsigned gen = old / nloc;
        if (old + 1u == (gen + 1u) * nloc) {
            __builtin_amdgcn_fence(__ATOMIC_RELEASE, "agent");
            asm volatile("s_waitcnt vmcnt(0)" ::: "memory");
            const unsigned og = xb_add(&bar[XB_TOP], 1u);
            const unsigned tg = og / nx;
            if (og + 1u == (tg + 1u) * nx) xb_add(&bar[XB_TOPGEN], 1u);
            else XB_SPIN(xb_ld(&bar[XB_TOPGEN]) == tg, bar);
            __builtin_amdgcn_fence(__ATOMIC_ACQUIRE, "agent");
            xb_add(&bar[XB_XGEN(b.x)], 1u);
            asm volatile("s_waitcnt vmcnt(0)" ::: "memory");
        } else {
            XB_SPIN(xb_ld(&bar[XB_XGEN(b.x)]) == gen, bar);
            __builtin_amdgcn_fence(__ATOMIC_ACQUIRE, "agent");
            asm volatile("s_waitcnt vmcnt(0)" ::: "memory");
        }
    }
    __syncthreads();
}
constexpr int NWAVES = 8;
constexpr int BATCH = 16, SEQ = 2048, D = 1024, M = BATCH * SEQ;
constexpr int NP = 2816;
constexpr int IN_COLS = 2824;
constexpr int O_AK = 512, O_AV = 640, O_MQ = 768, O_MK = 1280, O_MV = 1792, O_MO = 2304, O_G = 2816;
constexpr int MEMLEN = 256, MMEM = BATCH * MEMLEN;
constexpr int FF = 2816, NU = 2 * FF;
constexpr float EPS = 1e-6f;
constexpr size_t MiB = 1u << 20;
constexpr size_t WS_CTL = 0, CTL_ZERO_BYTES = 1 * MiB;
constexpr size_t WS_RSTD0 = 1 * MiB;
constexpr size_t WS_RSTDM = WS_RSTD0 + 128 * 1024;
constexpr size_t WS_GPRE = 2 * MiB;
constexpr size_t WS_SSQ1 = 4 * MiB, WS_SSQ2 = 6 * MiB, WS_SSQ3 = 8 * MiB;
constexpr size_t WS_WIN = 16 * MiB, WS_WKV = 22 * MiB, WS_WOUT = 26 * MiB, WS_WQ = 28 * MiB, WS_WO = 30 * MiB, WS_WUP = 32 * MiB, WS_WDN = 43 * MiB;
constexpr size_t WS_MEMB = 49 * MiB;
constexpr size_t WS_KVM = 57 * MiB;
constexpr size_t WS_XB = 80 * MiB;
constexpr size_t WS_P = 144 * MiB;
constexpr size_t WS_MIX = 320 * MiB;
constexpr size_t WS_QX = 384 * MiB;
constexpr size_t WS_XO = 448 * MiB;
constexpr size_t WS_U = 144 * MiB;
constexpr size_t WS_END = 512 * MiB;
static_assert(WS_WDN + (size_t)D * FF * 2 <= WS_MEMB && WS_KVM + (size_t)MMEM * 2048 * 2 <= WS_XB && WS_XB + (size_t)M * D * 2 == WS_P && WS_P + (size_t)M * NP * 2 == WS_MIX && WS_U + (size_t)M * NU * 2 <= WS_END, "d_ws map");
constexpr int CW_TMO = 0, CW_CODE = 1;
constexpr int CW_BAR = 4096;
constexpr int N_BAR_REGIONS = 16;
static_assert((CW_BAR + N_BAR_REGIONS * XCD_BAR_WORDS) * 4 <= (int)CTL_ZERO_BYTES, "CTL words inside the memset region");
constexpr int RING_OFF = 0, RING_BYTES = 131072;
constexpr int LDS_BYTES = 163840;
constexpr int LDSCTL_OFF = LDS_BYTES - 512, MISC_OFF = LDSCTL_OFF + 320;
constexpr int PH_LDS = LDSCTL_OFF;

struct Args { const float* in[20]; float* out; unsigned char* ws; int ph_lo, ph_hi, li, pad; };

struct Frame {
    LAS unsigned char* lds; volatile LAS unsigned* MISC; gu32* ctl;
    int tid, lane, wave, vcu, G;
};
__device__ __forceinline__ float wave_sum(float v) {
#pragma unroll
    for (int o = 1; o < 64; o <<= 1) v += __shfl_xor(v, o);
    return v;
}
__device__ __forceinline__ float bf2f(unsigned short b) { return __builtin_bit_cast(float, (unsigned)b << 16); }
__device__ __forceinline__ float bflo(unsigned w) { return __builtin_bit_cast(float, w << 16); }
__device__ __forceinline__ float bfhi(unsigned w) { return __builtin_bit_cast(float, w & 0xffff0000u); }

__device__ __forceinline__ void p0_transpose_item(const float* W, int K, int ldw, int src_col0, const float* g, bf16* WT, int dst_row0, LAS float* scr, int kb, int lane) {
    const int k0 = 64 * kb;
    float wv[32];
#pragma unroll
    for (int i = 0; i < 32; ++i) wv[i] = W[(size_t)(k0 + 2 * i + (lane >> 5)) * ldw + src_col0 + (lane & 31)];
#pragma unroll
    for (int i = 0; i < 32; ++i) { const int kk = 2 * i + (lane >> 5); float w = wv[i]; if (g) w *= g[k0 + kk]; scr[kk * 33 + (lane & 31)] = w; }
    LDS_WAIT(); asm volatile("" ::: "memory");
    const int c = lane & 7;
#pragma unroll
    for (int j = 0; j < 4; ++j) { const int n = (lane >> 3) + 8 * j; const LAS float* s = scr + (8 * c) * 33 + n;
        v4u o; o.x = pk2(s[0 * 33], s[1 * 33]); o.y = pk2(s[2 * 33], s[3 * 33]); o.z = pk2(s[4 * 33], s[5 * 33]); o.w = pk2(s[6 * 33], s[7 * 33]);
        *(GAS v4u*)(WT + (size_t)(dst_row0 + n) * K + k0 + 8 * c) = o; }
    LDS_WAIT(); asm volatile("" ::: "memory");
}
__device__ __forceinline__ void row_load(const float* xrow, int lane, f32x4 (&v)[4]) {
    const GAS f32x4* xr = (const GAS f32x4*)xrow + lane;
#pragma unroll
    for (int j = 0; j < 4; ++j) v[j] = xr[64 * j];
}
__device__ __forceinline__ float row_to_bf16(bf16* orow, int lane, const f32x4 (&v)[4]) {
    float s = 0.f;
#pragma unroll
    for (int j = 0; j < 4; ++j) s += (v[j][0] * v[j][0] + v[j][1] * v[j][1]) + (v[j][2] * v[j][2] + v[j][3] * v[j][3]);
    GAS unsigned long long* o8 = (GAS unsigned long long*)orow + lane;
#pragma unroll
    for (int j = 0; j < 4; ++j) o8[64 * j] = (unsigned long long)pk2(v[j][0], v[j][1]) | ((unsigned long long)pk2(v[j][2], v[j][3]) << 32);
    return wave_sum(s);
}
typedef float f32x16 __attribute__((ext_vector_type(16)));
typedef short s16x4 __attribute__((ext_vector_type(4)));
__device__ __forceinline__ int crow(int r, int hi) { return (r & 3) + 8 * (r >> 2) + 4 * hi; }
__device__ __forceinline__ unsigned cvtpk(float lo, float hi) { typedef float f2 __attribute__((ext_vector_type(2))); typedef __bf16 b2 __attribute__((ext_vector_type(2))); f2 v = {lo, hi}; b2 b = __builtin_convertvector(v, b2); return __builtin_bit_cast(unsigned, b); }
__device__ __forceinline__ s16x4 ldtr(const LAS unsigned char* p) { typedef short v4i16 __attribute__((ext_vector_type(4))); return __builtin_bit_cast(s16x4, __builtin_amdgcn_ds_read_tr16_b64_v4i16((LAS v4i16*)p)); }
__device__ __forceinline__ bf16x8 pack8(const f32x16& p, int b) { v4u w; w.x = cvtpk(p[b], p[b + 1]); w.y = cvtpk(p[b + 2], p[b + 3]); w.z = cvtpk(p[b + 4], p[b + 5]); w.w = cvtpk(p[b + 6], p[b + 7]); return __builtin_bit_cast(bf16x8, w); }
#define GLDS16(gptr, ldsptr) __builtin_amdgcn_global_load_lds((const unsigned*)(gptr), (LAS unsigned*)(ldsptr), 16, 0, 0)

__device__ __forceinline__ void xattn_unit(Frame& F, int b, int xh, int qb, const bf16* QX, const float* ssq1, const bf16* KVM, bf16* XO) {
    const int lane = F.lane, w = F.wave, r32 = lane & 31, hi = lane >> 5;
    const size_t row = (size_t)b * SEQ + qb * 256 + w * 32 + r32;
    const bf16* Kg = KVM + (size_t)b * MEMLEN * 2048 + xh * 256;
    { const bf16* kp = Kg + (size_t)(2 * w + (lane >> 5)) * 2048 + (lane & 31) * 8;
#pragma unroll
      for (int i = 0; i < 16; ++i) GLDS16(kp + (size_t)i * 16 * 2048, F.lds + (w + 8 * i) * 1040); }
    const bf16* qp = QX + row * D + xh * 256 + hi * 8;
    bf16x8 qa[2], qc[2];
#pragma unroll
    for (int j = 0; j < 2; ++j) qa[j] = *(const bf16x8*)(qp + j * 16);
    const pg8::RsParts rs{ssq1};
    const float sc2 = rs.get((int)row) * (0.0625f * 1.4426950408889634f);
    asm volatile("s_waitcnt vmcnt(0)" ::: "memory"); __syncthreads();
    const LAS unsigned char* kbase = F.lds + (r32 >> 1) * 1040 + (r32 & 1) * 512 + hi * 16;
    f32x16 S[8];
#pragma unroll
    for (int kb = 0; kb < 8; ++kb) S[kb] = (f32x16){0.f, 0.f, 0.f, 0.f, 0.f, 0.f, 0.f, 0.f, 0.f, 0.f, 0.f, 0.f, 0.f, 0.f, 0.f, 0.f};
#define XQK(QF, G) do { _Pragma("unroll") for (int j = 0; j < 2; ++j) _Pragma("unroll") for (int kb = 0; kb < 8; ++kb) { \
            const bf16x8 a = *(const LAS bf16x8*)(kbase + kb * 16640 + (2 * (G) + j) * 32); \
            S[kb] = __builtin_amdgcn_mfma_f32_32x32x16_bf16(a, QF[j], S[kb], 0, 0, 0); } } while (0)
#define XQL(QF, G) do { _Pragma("unroll") for (int j = 0; j < 2; ++j) QF[j] = *(const bf16x8*)(qp + (2 * (G) + j) * 16); } while (0)
    XQL(qc, 1); asm volatile("" ::: "memory"); XQK(qa, 0); asm volatile("" ::: "memory");
    XQL(qa, 2); asm volatile("" ::: "memory"); XQK(qc, 1); asm volatile("" ::: "memory");
    XQL(qc, 3); asm volatile("" ::: "memory"); XQK(qa, 2); asm volatile("" ::: "memory");
    XQL(qa, 4); asm volatile("" ::: "memory"); XQK(qc, 3); asm volatile("" ::: "memory");
    XQL(qc, 5); asm volatile("" ::: "memory"); XQK(qa, 4); asm volatile("" ::: "memory");
    XQL(qa, 6); asm volatile("" ::: "memory"); XQK(qc, 5); asm volatile("" ::: "memory");
    XQL(qc, 7); asm volatile("" ::: "memory"); XQK(qa, 6); asm volatile("" ::: "memory");
    XQK(qc, 7);
#undef XQK
#undef XQL
    float mx = S[0][0];
#pragma unroll
    for (int kb = 0; kb < 8; ++kb)
#pragma unroll
        for (int r = 0; r < 16; ++r) mx = fmaxf(mx, S[kb][r]);
    mx = fmaxf(mx, __shfl_xor(mx, 32));
    const float mo = mx * sc2; float l = 0.f;
#pragma unroll
    for (int kb = 0; kb < 8; ++kb)
#pragma unroll
        for (int r = 0; r < 16; ++r) { const float e = __builtin_amdgcn_exp2f(S[kb][r] * sc2 - mo); S[kb][r] = e; l += e; }
    l += __shfl_xor(l, 32);
    const float inv = 1.0f / l;
    bf16x8 pf[8][2];
#pragma unroll
    for (int kb = 0; kb < 8; ++kb) { pf[kb][0] = pack8(S[kb], 0); pf[kb][1] = pack8(S[kb], 8); }
    __syncthreads();
    { const bf16* vp = KVM + (size_t)b * MEMLEN * 2048 + 1024 + xh * 256 + (size_t)(16 * w + (lane >> 2)) * 2048 + 8 * (lane & 3);
#pragma unroll
      for (int i = 0; i < 16; ++i) GLDS16(vp + (size_t)(i & 1) * 128 * 2048 + (i >> 1) * 32, F.lds + (w + 8 * i) * 1024); }
    asm volatile("s_waitcnt vmcnt(0)" ::: "memory"); __syncthreads();
    bf16* orow = XO + row * D + xh * 256 + 4 * hi;
    const int vbase = (4 * hi + ((lane & 15) >> 2)) * 64 + (16 * ((lane >> 4) & 1) + 4 * (lane & 3)) * 2;
#pragma unroll
    for (int db = 0; db < 8; ++db) {
        f32x16 o = (f32x16){0.f, 0.f, 0.f, 0.f, 0.f, 0.f, 0.f, 0.f, 0.f, 0.f, 0.f, 0.f, 0.f, 0.f, 0.f, 0.f};
#pragma unroll
        for (int kb = 0; kb < 8; ++kb)
#pragma unroll
            for (int s = 0; s < 2; ++s) {
                const LAS unsigned char* vp = F.lds + db * 16384 + (32 * kb + 16 * s) * 64 + vbase;
                const s16x4 lo = ldtr(vp), hh = ldtr(vp + 8 * 64);
                const bf16x8 a = (bf16x8){lo[0], lo[1], lo[2], lo[3], hh[0], hh[1], hh[2], hh[3]};
                o = __builtin_amdgcn_mfma_f32_32x32x16_bf16(a, pf[kb][s], o, 0, 0, 0);
            }
#pragma unroll
        for (int g = 0; g < 4; ++g) { typedef unsigned u2 __attribute__((ext_vector_type(2))); u2 wv; wv.x = cvtpk(o[4 * g] * inv, o[4 * g + 1] * inv); wv.y = cvtpk(o[4 * g + 2] * inv, o[4 * g + 3] * inv);
            *(u2*)(orow + 32 * db + 8 * g) = wv; }
    }
    __syncthreads();
}
__device__ __forceinline__ void p5_xattn(Frame& F, const Args& a) {
    const bf16* QX = (const bf16*)(a.ws + WS_QX); const bf16* KVM = (const bf16*)(a.ws + WS_KVM); bf16* XO = (bf16*)(a.ws + WS_XO); const float* ssq1 = (const float*)(a.ws + WS_SSQ1);
    constexpr int NUNIT = BATCH * 4 * (SEQ / 256);
    for (int u = F.vcu; u < NUNIT; u += F.G) { const int qb = u & 7, xh = (u >> 3) & 3, b = u >> 5; xattn_unit(F, b, xh, qb, QX, ssq1, KVM, XO); }
}
__device__ __forceinline__ void swa_unit(Frame& F, int b, int hk, int n, const bf16* P, const float* sinks, bf16* MIX) {
    const int lane = F.lane, w = F.wave, r32 = lane & 31, hi = lane >> 5, wq = w & 3;
    LAS unsigned char* Kl = F.lds; LAS unsigned char* Vl = F.lds + 32768;
    const int np = n > 0 ? n - 1 : 0;
    {
        const int z = (4 * w + (lane >> 4)) & 7;
        const bf16* kp = P + (size_t)(b * SEQ + 8 * w + (lane >> 3)) * NP + O_AK + hk * 64 + (((lane & 7) ^ z) * 8);
#pragma unroll
        for (int i = 0; i < 4; ++i) GLDS16(kp + (size_t)(128 * (i < 2 ? np : n) + 64 * (i & 1)) * NP, Kl + (w + 8 * i) * 1024);
        const bf16* vp = P + (size_t)(b * SEQ + 16 * w + (lane >> 2)) * NP + O_AV + hk * 64 + 8 * (lane & 3);
#pragma unroll
        for (int i = 0; i < 4; ++i) GLDS16(vp + (size_t)(128 * ((i & 1) ? n : np)) * NP + 32 * (i >> 1), Vl + (w + 8 * i) * 1024);
    }
    const size_t row = (size_t)b * SEQ + n * 128 + wq * 32 + r32;
    bf16x8 qf[2][4];
#pragma unroll
    for (int gi = 0; gi < 2; ++gi) { const bf16* qp = P + row * NP + (hk * 4 + 2 * (w >> 2) + gi) * 64 + hi * 8;
#pragma unroll
        for (int ks = 0; ks < 4; ++ks) qf[gi][ks] = *(const bf16x8*)(qp + ks * 16); }
    asm volatile("s_waitcnt vmcnt(0)" ::: "memory"); __syncthreads();
    const int zk = (r32 >> 1) & 7;
    const LAS unsigned char* krow = Kl + (32 * wq + r32) * 128;
    const int vlane = (4 * hi + ((lane & 15) >> 2)) * 64 + (16 * ((lane >> 4) & 1) + 4 * (lane & 3)) * 2;
    const int dl = r32 - 4 * hi;
#pragma unroll
    for (int gi = 0; gi < 2; ++gi) {
        const int h = hk * 4 + 2 * (w >> 2) + gi;
        const float slope2 = exp2f(-(float)(h + 1)) * 1.4426950408889634f, sink2 = sinks[h] * 1.4426950408889634f;
        constexpr float sc = 0.125f * 1.4426950408889634f;
        f32x16 S[5];
#pragma unroll
        for (int jb = 0; jb < 5; ++jb) S[jb] = (f32x16){0.f, 0.f, 0.f, 0.f, 0.f, 0.f, 0.f, 0.f, 0.f, 0.f, 0.f, 0.f, 0.f, 0.f, 0.f, 0.f};
#pragma unroll
        for (int ks = 0; ks < 4; ++ks) { const int co = ((2 * ks + hi) ^ zk) * 16;
#pragma unroll
            for (int jb = 0; jb < 5; ++jb) { const bf16x8 a = *(const LAS bf16x8*)(krow + jb * 4096 + co); S[jb] = __builtin_amdgcn_mfma_f32_32x32x16_bf16(a, qf[gi][ks], S[jb], 0, 0, 0); } }
        int dlo = dl; float bbase = -slope2 * (float)(dl + 128);
        asm volatile("" : "+v"(dlo), "+v"(bbase));
        float mx = sink2;
#pragma unroll
        for (int jb = 0; jb < 5; ++jb) { const bool dead = (n == 0) && (wq + jb < 4);
#pragma unroll
            for (int r = 0; r < 16; ++r) { const int cr = 32 * jb + (r & 3) + 8 * (r >> 2);
                float v = __builtin_fmaf(S[jb][r], sc, __builtin_fmaf(slope2, (float)cr, bbase));
                if (jb == 0) v = (dlo >= cr) ? -1e30f : v;
                if (jb == 4) v = (dlo < cr - 128) ? -1e30f : v;
                v = dead ? -1e30f : v;
                S[jb][r] = v; mx = fmaxf(mx, v); } }
        mx = fmaxf(mx, __shfl_xor(mx, 32));
        float l = 0.f;
#pragma unroll
        for (int jb = 0; jb < 5; ++jb)
#pragma unroll
            for (int r = 0; r < 16; ++r) { const float e = __builtin_amdgcn_exp2f(S[jb][r] - mx); S[jb][r] = e; l += e; }
        l += __shfl_xor(l, 32);
        const float inv = 1.0f / (l + __builtin_amdgcn_exp2f(sink2 - mx));
        bf16x8 pf[5][2];
#pragma unroll
        for (int jb = 0; jb < 5; ++jb) { pf[jb][0] = pack8(S[jb], 0); pf[jb][1] = pack8(S[jb], 8); }
        bf16* orow = MIX + row * D + h * 64 + 4 * hi;
#pragma unroll
        for (int db = 0; db < 2; ++db) {
            f32x16 o = (f32x16){0.f, 0.f, 0.f, 0.f, 0.f, 0.f, 0.f, 0.f, 0.f, 0.f, 0.f, 0.f, 0.f, 0.f, 0.f, 0.f};
#pragma unroll
            for (int jb = 0; jb < 5; ++jb)
#pragma unroll
                for (int s = 0; s < 2; ++s) { const LAS unsigned char* vp = Vl + db * 16384 + (32 * (wq + jb) + 16 * s) * 64 + vlane;
                    const s16x4 lo = ldtr(vp), hh = ldtr(vp + 8 * 64);
                    const bf16x8 a = (bf16x8){lo[0], lo[1], lo[2], lo[3], hh[0], hh[1], hh[2], hh[3]};
                    o = __builtin_amdgcn_mfma_f32_32x32x16_bf16(a, pf[jb][s], o, 0, 0, 0); }
#pragma unroll
            for (int g4 = 0; g4 < 4; ++g4) { typedef unsigned u2 __attribute__((ext_vector_type(2))); u2 wv; wv.x = cvtpk(o[4 * g4] * inv, o[4 * g4 + 1] * inv); wv.y = cvtpk(o[4 * g4 + 2] * inv, o[4 * g4 + 3] * inv);
                *(u2*)(orow + 32 * db + 8 * g4) = wv; }
        }
        __builtin_amdgcn_sched_barrier(0);
    }
    __syncthreads();
}
namespace ml {
constexpr int QS = 0, KS = 16384, KT = 32768, VS0 = 49152, PS = 65536, GS = 73728, WS = 74752, END1 = 79872;
constexpr int Q0 = 0, Q1 = 16384, CT0 = 32768, CT1 = 32768 + 33280, END2 = 32768 + 2 * 33280 + 8192;
static_assert(END1 <= PH_LDS && END2 <= PH_LDS, "mLSTM LDS maps");
constexpr float L2E = 1.4426950408889634f;
constexpr int NCH = SEQ / 64, NCID = BATCH * 4 * NCH;
constexpr size_t WS_KL = WS_XB;
constexpr size_t WS_HL = WS_QX;
constexpr size_t WS_QG = WS_QX + 32 * MiB;
constexpr size_t WS_SM = WS_XO;
constexpr size_t WS_NL = WS_XO + 2 * MiB;
}
__device__ __forceinline__ float fast_silu(float y) { return y * __builtin_amdgcn_rcpf(1.0f + __builtin_amdgcn_exp2f(-1.4426950408889634f * y)); }
__device__ __forceinline__ float fast_sigmoid(float y) { return __builtin_amdgcn_rcpf(1.0f + __builtin_amdgcn_exp2f(-1.4426950408889634f * y)); }

__device__ __forceinline__ void mlstm_local_unit(Frame& F, int cid, const bf16* P, const float* gpre, const float* bg, const float* cw, const float* cb, unsigned char* ws) {
    using namespace ml;
    const int tid = F.tid, lane = F.lane, w = F.wave, r32 = lane & 31, hi = lane >> 5, vb = w & 3, tb = w >> 2;
    const int c = cid & (NCH - 1), bh = cid >> 5, h = bh & 3, b = bh >> 2;
    LAS unsigned char* L = F.lds;
    const int chg = tid & 31, run = tid >> 5, cc = chg & 15, t0 = 4 * run; const bool isk = chg >= 16;
    const int cch = (isk ? 512 : 0) + h * 128 + 8 * cc;
    const size_t row0 = (size_t)b * SEQ + (size_t)c * 64;
    v4u raw[7];
    { const bf16* rawp = P + O_MQ + cch;
#pragma unroll
      for (int k = 0; k < 7; ++k) { const int t = c * 64 + t0 - 3 + k; raw[k] = (t >= 0) ? *(const v4u*)(rawp + (row0 + t0 - 3 + k) * NP) : (v4u){0u, 0u, 0u, 0u}; } }
    const float gi = gpre[(row0 + lane) * 8 + h] + bg[h], gf = gpre[(row0 + lane) * 8 + 4 + h] + bg[4 + h];
    float wt[4][8], bb[8];
#pragma unroll
    for (int j = 0; j < 4; ++j) { const f32x4 a = *(const f32x4*)(cw + j * 1024 + cch), bq = *(const f32x4*)(cw + j * 1024 + cch + 4);
#pragma unroll
        for (int e = 0; e < 4; ++e) { wt[j][e] = a[e]; wt[j][4 + e] = bq[e]; } }
    { const f32x4 a = *(const f32x4*)(cb + cch), bq = *(const f32x4*)(cb + cch + 4);
#pragma unroll
      for (int e = 0; e < 4; ++e) { bb[e] = a[e]; bb[4 + e] = bq[e]; } }
    { const bf16* vsrc = P + (row0 + (lane >> 2)) * NP + O_MV + h * 128 + 8 * (lane & 3);
#pragma unroll
      for (int i = 0; i < 2; ++i) { const int p = w + 8 * i; GLDS16(vsrc + (size_t)(16 * (p & 3)) * NP + 32 * (p >> 2), L + VS0 + p * 1024); } }
    const float lf = fminf(gf, 0.f) - log1pf(__expf(-fabsf(gf)));
    float bs = lf;
#pragma unroll
    for (int o = 1; o < 64; o <<= 1) { const float v = __shfl_up(bs, o); if (lane >= o) bs += v; }
    const float u = gi - bs; float pm = u;
#pragma unroll
    for (int o = 1; o < 64; o <<= 1) { const float v = __shfl_up(pm, o); if (lane >= o) pm = fmaxf(pm, v); }
    const float pm63 = __shfl(pm, 63);
    const float wsl = __expf(u - pm63);
    if (w == 0) { LAS float* g = (LAS float*)(L + GS); g[lane] = u * L2E; g[64 + lane] = pm * L2E;
        float* sm = (float*)(ws + WS_SM) + (size_t)cid * 192; sm[64 + lane] = pm; sm[128 + lane] = bs; }
    {
        float psum[8];
#pragma unroll
        for (int e = 0; e < 8; ++e) psum[e] = 0.f;
        bf16* qg = (bf16*)(ws + WS_QG) + (size_t)cid * 8192;
#pragma unroll
        for (int i = 0; i < 4; ++i) {
            const int t = t0 + i; const float wsr = __shfl(wsl, t);
            float y[8];
#pragma unroll
            for (int e = 0; e < 8; ++e) y[e] = bb[e];
#pragma unroll
            for (int j = 0; j < 4; ++j)
#pragma unroll
                for (int q = 0; q < 4; ++q) { y[2 * q] += wt[j][2 * q] * bflo(raw[i + j][q]); y[2 * q + 1] += wt[j][2 * q + 1] * bfhi(raw[i + j][q]); }
#pragma unroll
            for (int e = 0; e < 8; ++e) y[e] = fast_silu(y[e]);
            const int sw = (cc ^ (t & 15)) * 16;
            if (!isk) { v4u o;
#pragma unroll
                for (int q = 0; q < 4; ++q) o[q] = cvtpk(y[2 * q] * 0.08838834764831845f, y[2 * q + 1] * 0.08838834764831845f);
                *(LAS v4u*)(L + QS + t * 256 + sw) = o; *(v4u*)((unsigned char*)qg + t * 256 + sw) = o;
            } else { v4u o, o2;
#pragma unroll
                for (int q = 0; q < 4; ++q) { o[q] = cvtpk(y[2 * q], y[2 * q + 1]); o2[q] = cvtpk(y[2 * q] * wsr, y[2 * q + 1] * wsr); }
#pragma unroll
                for (int e = 0; e < 8; ++e) psum[e] += y[e] * wsr;
                *(LAS v4u*)(L + KS + t * 256 + sw) = o;
                *(LAS v4u*)(L + KT + (cc >> 2) * 4096 + t * 64 + (cc & 3) * 16) = o2;
            }
        }
        if (isk) { LAS float* ps = (LAS float*)(L + PS) + run * 128 + 8 * cc; *(LAS f32x4*)ps = (f32x4){psum[0], psum[1], psum[2], psum[3]}; *(LAS f32x4*)(ps + 4) = (f32x4){psum[4], psum[5], psum[6], psum[7]}; }
    }
    asm volatile("s_waitcnt vmcnt(0)" ::: "memory"); __syncthreads();
    const int zsw = (r32 & 15);
    const int vlane = (4 * hi + ((lane & 15) >> 2)) * 64 + (16 * ((lane >> 4) & 1) + 4 * (lane & 3)) * 2;
    const LAS float* g = (const LAS float*)(L + GS);
    const int tl = 32 * tb + r32;
    const float pm2 = g[64 + tl];
    bf16x8 qf[8];
#pragma unroll
    for (int ks = 0; ks < 8; ++ks) qf[ks] = *(const LAS bf16x8*)(L + QS + tl * 256 + (((2 * ks + hi) ^ zsw) * 16));
    bf16x8 vf[4];
#pragma unroll
    for (int s4 = 0; s4 < 4; ++s4) { const LAS unsigned char* vp = L + VS0 + vb * 4096 + (16 * s4) * 64 + vlane; const s16x4 lo = ldtr(vp), hh = ldtr(vp + 8 * 64);
        vf[s4] = (bf16x8){lo[0], lo[1], lo[2], lo[3], hh[0], hh[1], hh[2], hh[3]}; }
    f32x16 o = (f32x16){0.f, 0.f, 0.f, 0.f, 0.f, 0.f, 0.f, 0.f, 0.f, 0.f, 0.f, 0.f, 0.f, 0.f, 0.f, 0.f};
    float dsum = 0.f;
#pragma unroll
    for (int sb = 0; sb < 2; ++sb) if (sb <= tb) {
        f32x16 S = (f32x16){0.f, 0.f, 0.f, 0.f, 0.f, 0.f, 0.f, 0.f, 0.f, 0.f, 0.f, 0.f, 0.f, 0.f, 0.f, 0.f};
#pragma unroll
        for (int ks = 0; ks < 8; ++ks) { const bf16x8 a = *(const LAS bf16x8*)(L + KS + (32 * sb + r32) * 256 + (((2 * ks + hi) ^ zsw) * 16)); S = __builtin_amdgcn_mfma_f32_32x32x16_bf16(a, qf[ks], S, 0, 0, 0); }
#pragma unroll
        for (int g4 = 0; g4 < 4; ++g4) { const f32x4 uu = *(const LAS f32x4*)(g + 32 * sb + 8 * g4 + 4 * hi);
#pragma unroll
            for (int e = 0; e < 4; ++e) { const int r = 4 * g4 + e; const int sl = 32 * sb + 8 * g4 + 4 * hi + e;
                const float gm = (sl <= tl) ? __builtin_amdgcn_exp2f(uu[e] - pm2) : 0.f; const float v = S[r] * gm; S[r] = v; dsum += v; } }
        o = __builtin_amdgcn_mfma_f32_32x32x16_bf16(vf[2 * sb], pack8(S, 0), o, 0, 0, 0);
        o = __builtin_amdgcn_mfma_f32_32x32x16_bf16(vf[2 * sb + 1], pack8(S, 8), o, 0, 0, 0);
    }
    dsum += __shfl_xor(dsum, 32);
    if (vb == 0 && hi == 0) ((float*)(ws + WS_SM) + (size_t)cid * 192)[tl] = dsum;
    { v4u* hp = (v4u*)((bf16*)(ws + WS_HL) + ((size_t)(cid * 8 + w) * 64 + lane) * 16);
      v4u a; a.x = cvtpk(o[0], o[1]); a.y = cvtpk(o[2], o[3]); a.z = cvtpk(o[4], o[5]); a.w = cvtpk(o[6], o[7]); hp[0] = a;
      a.x = cvtpk(o[8], o[9]); a.y = cvtpk(o[10], o[11]); a.z = cvtpk(o[12], o[13]); a.w = cvtpk(o[14], o[15]); hp[1] = a; }
#pragma unroll
    for (int i = 0; i < 2; ++i) {
        f32x16 kacc = (f32x16){0.f, 0.f, 0.f, 0.f, 0.f, 0.f, 0.f, 0.f, 0.f, 0.f, 0.f, 0.f, 0.f, 0.f, 0.f, 0.f};
#pragma unroll
        for (int s4 = 0; s4 < 4; ++s4) { const LAS unsigned char* kp = L + KT + (2 * tb + i) * 4096 + (16 * s4) * 64 + vlane; const s16x4 lo = ldtr(kp), hh = ldtr(kp + 8 * 64);
            const bf16x8 a = (bf16x8){lo[0], lo[1], lo[2], lo[3], hh[0], hh[1], hh[2], hh[3]};
            kacc = __builtin_amdgcn_mfma_f32_32x32x16_bf16(a, vf[s4], kacc, 0, 0, 0); }
        v4u* kp2 = (v4u*)((bf16*)(ws + WS_KL) + (((size_t)(cid * 8 + w) * 2 + i) * 64 + lane) * 16);
        v4u a; a.x = cvtpk(kacc[0], kacc[1]); a.y = cvtpk(kacc[2], kacc[3]); a.z = cvtpk(kacc[4], kacc[5]); a.w = cvtpk(kacc[6], kacc[7]); kp2[0] = a;
        a.x = cvtpk(kacc[8], kacc[9]); a.y = cvtpk(kacc[10], kacc[11]); a.z = cvtpk(kacc[12], kacc[13]); a.w = cvtpk(kacc[14], kacc[15]); kp2[1] = a;
    }
    if (tid < 128) { float s = 0.f; const LAS float* ps = (const LAS float*)(L + PS) + tid;
#pragma unroll
        for (int q = 0; q < 16; ++q) s += ps[q * 128];
        ((float*)(ws + WS_NL))[(size_t)cid * 128 + tid] = s; }
    __syncthreads();
}

__device__ __forceinline__ void mlstm_scan(Frame& F, int b, int h, const bf16* P, bf16* MIX, unsigned char* ws) {
    using namespace ml;
    typedef unsigned u2 __attribute__((ext_vector_type(2)));
    const int tid = F.tid, lane = F.lane, w = F.wave, r32 = lane & 31, hi = lane >> 5, vb = w & 3, tb = w >> 2;
    LAS unsigned char* L = F.lds;
    const int cid0 = (b * 4 + h) * NCH;
    for (int i = tid; i < (33280 + 8192) / 16; i += NWAVES * 64) *(LAS v4u*)(L + CT0 + 16 * i) = (v4u){0u, 0u, 0u, 0u};
    f32x16 Cacc[2];
#pragma unroll
    for (int i = 0; i < 2; ++i) Cacc[i] = (f32x16){0.f, 0.f, 0.f, 0.f, 0.f, 0.f, 0.f, 0.f, 0.f, 0.f, 0.f, 0.f, 0.f, 0.f, 0.f, 0.f};
    float nreg = 0.f, mprev = 0.f;
    const size_t rowb = (size_t)b * SEQ;
    const int zsw = (r32 & 15), tl = 32 * tb + r32;
    v4u hln[2], kln[2][2]; u2 mon[4]; float dln, pmn, bsn, nln;
#define ML_PREFETCH(cc_) do { const int cid_ = cid0 + (cc_); \
        const v4u* hp_ = (const v4u*)((const bf16*)(ws + WS_HL) + ((size_t)(cid_ * 8 + w) * 64 + lane) * 16); hln[0] = hp_[0]; hln[1] = hp_[1]; \
        _Pragma("unroll") for (int i_ = 0; i_ < 2; ++i_) { const v4u* kp_ = (const v4u*)((const bf16*)(ws + WS_KL) + (((size_t)(cid_ * 8 + w) * 2 + i_) * 64 + lane) * 16); kln[i_][0] = kp_[0]; kln[i_][1] = kp_[1]; } \
        const size_t tr_ = rowb + (size_t)(cc_) * 64 + tl; \
        _Pragma("unroll") for (int g_ = 0; g_ < 4; ++g_) mon[g_] = *(const u2*)(P + tr_ * NP + O_MO + h * 128 + 32 * vb + 8 * g_ + 4 * hi); \
        const float* sm_ = (const float*)(ws + WS_SM) + (size_t)cid_ * 192; dln = sm_[lane]; pmn = sm_[64 + lane]; bsn = sm_[128 + lane]; \
        nln = (tid < 128) ? ((const float*)(ws + WS_NL))[(size_t)cid_ * 128 + tid] : 0.f; \
        { const unsigned char* qg_ = (const unsigned char*)(ws + WS_QG) + (size_t)cid_ * 16384; \
          _Pragma("unroll") for (int i_ = 0; i_ < 2; ++i_) GLDS16(qg_ + (w + 8 * i_) * 1024 + lane * 16, L + (((cc_) & 1) ? Q1 : Q0) + (w + 8 * i_) * 1024); } } while (0)
    ML_PREFETCH(0);
    for (int c = 0; c < NCH; ++c) {
        const int par = c & 1;
        const v4u hl0 = hln[0], hl1 = hln[1]; v4u kl[2][2]; kl[0][0] = kln[0][0]; kl[0][1] = kln[0][1]; kl[1][0] = kln[1][0]; kl[1][1] = kln[1][1];
        u2 mo[4]; mo[0] = mon[0]; mo[1] = mon[1]; mo[2] = mon[2]; mo[3] = mon[3];
        const float dl = dln, pm = pmn, bs = bsn, nl = nln;
        asm volatile("s_waitcnt vmcnt(0)" ::: "memory"); __syncthreads();
        if (c + 1 < NCH) ML_PREFETCH(c + 1);
        const float Mt = fmaxf(mprev, pm);
        const float M63 = __shfl(Mt, 63), b63 = __shfl(bs, 63), pm63 = __shfl(pm, 63);
        const float wi_l = __expf(mprev - Mt), ft_l = __expf(pm - Mt), ef_l = __expf(-(bs + Mt));
        const float wi = __shfl(wi_l, tl), ft = __shfl(ft_l, tl), ef = __shfl(ef_l, tl), dlt = __shfl(dl, tl);
        const float decay = __expf(mprev - M63), f2 = __expf(pm63 - M63);
        const LAS unsigned char* Ql = L + (par ? Q1 : Q0);
        const LAS unsigned char* Cr = L + (par ? CT1 : CT0); LAS unsigned char* Cw = L + (par ? CT0 : CT1);
        bf16x8 qf[8];
#pragma unroll
        for (int ks = 0; ks < 8; ++ks) qf[ks] = *(const LAS bf16x8*)(Ql + tl * 256 + (((2 * ks + hi) ^ zsw) * 16));
        f32x16 o = (f32x16){0.f, 0.f, 0.f, 0.f, 0.f, 0.f, 0.f, 0.f, 0.f, 0.f, 0.f, 0.f, 0.f, 0.f, 0.f, 0.f};
        f32x16 on = (f32x16){0.f, 0.f, 0.f, 0.f, 0.f, 0.f, 0.f, 0.f, 0.f, 0.f, 0.f, 0.f, 0.f, 0.f, 0.f, 0.f};
#pragma unroll
        for (int ks = 0; ks < 8; ++ks) { const bf16x8 a = *(const LAS bf16x8*)(Cr + (32 * vb + r32) * 256 + (((2 * ks + hi) ^ zsw) * 16)); o = __builtin_amdgcn_mfma_f32_32x32x16_bf16(a, qf[ks], o, 0, 0, 0); }
#pragma unroll
        for (int ks = 0; ks < 8; ++ks) { const bf16x8 a = *(const LAS bf16x8*)(Cr + (128 + r32) * 256 + (2 * ks + hi) * 16); on = __builtin_amdgcn_mfma_f32_32x32x16_bf16(a, qf[ks], on, 0, 0, 0); }
        const float qn = __shfl(on[0], r32);
        const float den = wi * qn + ft * dlt;
        const float rden = 1.0f / fmaxf(fabsf(den), ef);
        { bf16* op = MIX + (rowb + (size_t)c * 64 + tl) * D + 512 + h * 128 + 32 * vb + 4 * hi;
#pragma unroll
          for (int g4 = 0; g4 < 4; ++g4) { const unsigned hw0 = g4 < 2 ? hl0[2 * g4] : hl1[2 * g4 - 4], hw1 = g4 < 2 ? hl0[2 * g4 + 1] : hl1[2 * g4 - 3];
              float x[4]; const float hv[4] = {bflo(hw0), bfhi(hw0), bflo(hw1), bfhi(hw1)};
#pragma unroll
              for (int e = 0; e < 4; ++e) { const float og = (e & 1) ? bfhi(mo[g4][e >> 1]) : bflo(mo[g4][e >> 1]); x[e] = (wi * o[4 * g4 + e] + ft * hv[e]) * rden * fast_sigmoid(og); }
              u2 wv; wv.x = cvtpk(x[0], x[1]); wv.y = cvtpk(x[2], x[3]); *(u2*)(op + 8 * g4) = wv; } }
        const int dv = 32 * vb + r32;
#pragma unroll
        for (int i = 0; i < 2; ++i) {
#pragma unroll
            for (int r = 0; r < 16; ++r) { const unsigned kw = kl[i][r >> 3][(r >> 1) & 3]; const float kv = (r & 1) ? bfhi(kw) : bflo(kw); Cacc[i][r] = decay * Cacc[i][r] + f2 * kv; }
#pragma unroll
            for (int g4 = 0; g4 < 4; ++g4) { const int ch = 4 * (2 * tb + i) + g4; u2 wv; wv.x = cvtpk(Cacc[i][4 * g4], Cacc[i][4 * g4 + 1]); wv.y = cvtpk(Cacc[i][4 * g4 + 2], Cacc[i][4 * g4 + 3]);
                *(LAS u2*)(Cw + dv * 256 + ((ch ^ (dv & 15)) * 16) + 8 * hi) = wv; }
        }
        if (tid < 128) { nreg = decay * nreg + f2 * nl; *(LAS unsigned short*)(Cw + 128 * 256 + tid * 2) = (unsigned short)f2bf(nreg); }
        mprev = b63 + M63;
    }
    __syncthreads();
#undef ML_PREFETCH
}
template <class BAR> __device__ __forceinline__ void p2_mix(Frame& F, const Args& a, const BAR& bar) {
    const bf16* P = (const bf16*)(a.ws + WS_P); bf16* MIX = (bf16*)(a.ws + WS_MIX);
    const int NSEQ = BATCH * 4;
    for (int u = F.vcu; u < ml::NCID; u += F.G) mlstm_local_unit(F, u, P, (const float*)(a.ws + WS_GPRE), a.in[4], a.in[5], a.in[6], a.ws);
    xcd_barrier(bar);
    { int t_ = threadIdx.x; asm volatile("" : "+v"(t_)); F.tid = t_; F.lane = t_ & 63; }
    if ((int)blockIdx.x < NSEQ && F.G > NSEQ) {
        mlstm_scan(F, (int)blockIdx.x >> 2, (int)blockIdx.x & 3, P, MIX, a.ws);
    } else {
        const int nb = F.G > NSEQ ? F.G - NSEQ : F.G, b0 = F.G > NSEQ ? (int)blockIdx.x - NSEQ : (int)blockIdx.x;
        for (int u = b0; u < BATCH * 2 * 16; u += nb) swa_unit(F, u >> 5, (u >> 4) & 1, u & 15, P, a.in[7], MIX);
    }
}
__device__ __forceinline__ void p0_prologue(Frame& F, const Args& a) {
    unsigned char* ws = a.ws;
    LAS float* scr = (LAS float*)(F.lds + F.wave * 8448);
    LAS float* wgT = (LAS float*)(F.lds + 73728);
    const int gw = F.vcu * NWAVES + F.wave, NGW = F.G * NWAVES;
    {
        const float* w_in = a.in[3]; const float* gm = a.in[2];
        for (int i = F.tid; i < 8192; i += NWAVES * 64) { const int k = i >> 3, c = i & 7; wgT[c * 1024 + k] = gm[k] * w_in[(size_t)k * IN_COLS + O_G + c]; }
    }
    constexpr int I_IN = 16 * (NP / 32), I_KV = 16 * 64, I_SQ = 16 * 32, I_UP = 16 * (NU / 32), I_DN = (FF / 64) * 32;
    constexpr int NITEMS = I_IN + I_KV + 3 * I_SQ + I_UP + I_DN;
    for (int it = gw; it < NITEMS; it += NGW) {
        int r = it;
        if (r < I_IN) { const int nb = r % (NP / 32), kb = r / (NP / 32); p0_transpose_item(a.in[3], D, IN_COLS, 32 * nb, a.in[2], (bf16*)(ws + WS_WIN), 32 * nb, scr, kb, F.lane); continue; } r -= I_IN;
        if (r < I_KV) { const int nb = r % 64, kb = r / 64; p0_transpose_item(a.in[12], D, 2048, 32 * nb, a.in[10], (bf16*)(ws + WS_WKV), 32 * nb, scr, kb, F.lane); continue; } r -= I_KV;
        if (r < I_SQ) { const int nb = r % 32, kb = r / 32; p0_transpose_item(a.in[8], D, D, 32 * nb, nullptr, (bf16*)(ws + WS_WOUT), 32 * nb, scr, kb, F.lane); continue; } r -= I_SQ;
        if (r < I_SQ) { const int nb = r % 32, kb = r / 32; p0_transpose_item(a.in[11], D, D, 32 * nb, a.in[9], (bf16*)(ws + WS_WQ), 32 * nb, scr, kb, F.lane); continue; } r -= I_SQ;
        if (r < I_SQ) { const int nb = r % 32, kb = r / 32; p0_transpose_item(a.in[13], D, D, 32 * nb, nullptr, (bf16*)(ws + WS_WO), 32 * nb, scr, kb, F.lane); continue; } r -= I_SQ;
        if (r < I_UP) { const int nb = r % (NU / 32), kb = r / (NU / 32); p0_transpose_item(a.in[15], D, NU, 32 * nb, a.in[14], (bf16*)(ws + WS_WUP), 32 * nb, scr, kb, F.lane); continue; } r -= I_UP;
        { const int nb = r % 32, kb = r / 32; p0_transpose_item(a.in[18], FF, D, 32 * nb, nullptr, (bf16*)(ws + WS_WDN), 32 * nb, scr, kb, F.lane); }
    }
    __syncthreads();
    float* rstd0 = (float*)(ws + WS_RSTD0); float* gpre = (float*)(ws + WS_GPRE); bf16* XB = (bf16*)(ws + WS_XB);
    for (int m = gw; m < M; m += 2 * NGW) {
        f32x4 va[4], vc[4];
        row_load(a.in[0] + (size_t)m * D, F.lane, va); row_load(a.in[0] + (size_t)(m + NGW) * D, F.lane, vc);
#pragma unroll
        for (int hlf = 0; hlf < 2; ++hlf) {
            const int mm = m + hlf * NGW; const f32x4 (&v)[4] = hlf ? vc : va;
            const float ssq = row_to_bf16(XB + (size_t)mm * D, F.lane, v);
            const float rstd = 1.0f / sqrtf(ssq * (1.0f / D) + EPS);
            float ga[8];
#pragma unroll
            for (int c = 0; c < 8; ++c) { float s = 0.f;
#pragma unroll
                for (int j = 0; j < 4; ++j) { const f32x4 w = *(const LAS f32x4*)(wgT + c * 1024 + 256 * j + 4 * F.lane); s += (v[j][0] * w[0] + v[j][1] * w[1]) + (v[j][2] * w[2] + v[j][3] * w[3]); }
                ga[c] = wave_sum(s) * rstd; }
            if (F.lane == 0) { rstd0[mm] = rstd; *(f32x4*)(gpre + (size_t)mm * 8) = (f32x4){ga[0], ga[1], ga[2], ga[3]}; *(f32x4*)(gpre + (size_t)mm * 8 + 4) = (f32x4){ga[4], ga[5], ga[6], ga[7]}; }
        }
    }
    float* rstdm = (float*)(ws + WS_RSTDM); bf16* MEMB = (bf16*)(ws + WS_MEMB);
    for (int m = gw; m < MMEM; m += NGW) {
        f32x4 v[4];
        row_load(a.in[1] + (size_t)m * D, F.lane, v);
        const float ssq = row_to_bf16(MEMB + (size_t)m * D, F.lane, v);
        if (F.lane == 0) rstdm[m] = 1.0f / sqrtf(ssq * (1.0f / D) + EPS);
    }
}
__device__ __forceinline__ void p8_act(Frame& F, const Args& a) {
    bf16* U = (bf16*)(a.ws + WS_U); const float* cw = a.in[16]; const float* cb = a.in[17];
    constexpr int NCH = FF / 8, RUN = 16, NIT = (M / RUN) * NCH;
    for (int it = blockIdx.x * (NWAVES * 64) + F.tid; it < NIT; it += F.G * NWAVES * 64) {
        const int ch = it % NCH, r = it / NCH, row0 = r * RUN, t0 = row0 % SEQ, c0 = ch * 8;
        float w0[8], w1[8], w2[8], bb[8];
#pragma unroll
        for (int e = 0; e < 8; e += 4) { const f32x4 x0 = *(const f32x4*)(cw + c0 + e), x1 = *(const f32x4*)(cw + FF + c0 + e), x2 = *(const f32x4*)(cw + 2 * FF + c0 + e), x3 = *(const f32x4*)(cb + c0 + e);
#pragma unroll
            for (int q = 0; q < 4; ++q) { w0[e + q] = x0[q]; w1[e + q] = x1[q]; w2[e + q] = x2[q]; bb[e + q] = x3[q]; } }
        v4u gm2 = (v4u){0u, 0u, 0u, 0u}, gm1 = gm2;
        if (t0 >= 2) { gm2 = *(const v4u*)(U + (size_t)(row0 - 2) * NU + c0); gm1 = *(const v4u*)(U + (size_t)(row0 - 1) * NU + c0); }
#pragma unroll 4
        for (int i = 0; i < RUN; ++i) {
            bf16* rp = U + (size_t)(row0 + i) * NU;
            const v4u g0 = *(const v4u*)(rp + c0), vv = *(const v4u*)(rp + FF + c0);
            v4u o;
#pragma unroll
            for (int q = 0; q < 4; ++q) {
                const float ga = w0[2 * q] * bflo(gm2[q]) + w1[2 * q] * bflo(gm1[q]) + w2[2 * q] * bflo(g0[q]) + bb[2 * q];
                const float gb = w0[2 * q + 1] * bfhi(gm2[q]) + w1[2 * q + 1] * bfhi(gm1[q]) + w2[2 * q + 1] * bfhi(g0[q]) + bb[2 * q + 1];
                const float ra = ga / (1.0f + __expf(-ga)) * bflo(vv[q]), rb = gb / (1.0f + __expf(-gb)) * bfhi(vv[q]);
                o[q] = pk2(ra, rb);
            }
            *(v4u*)(rp + FF + c0) = o;
            gm2 = gm1; gm1 = g0;
        }
    }
}
__device__ __forceinline__ void p10_final(Frame& F, const Args& a) {
    const int gw = F.vcu * NWAVES + F.wave, NGW = F.G * NWAVES;
    const float* gf = a.in[19]; const pg8::RsParts rs{(const float*)(a.ws + WS_SSQ3)};
    f32x4 gv[4];
#pragma unroll
    for (int j = 0; j < 4; ++j) gv[j] = ((const f32x4*)gf)[64 * j + F.lane];
    for (int m = gw; m < M; m += NGW) {
        const float r = rs.get(m);
        GAS f32x4* xr = (GAS f32x4*)(a.out + (size_t)m * D) + F.lane;
#pragma unroll
        for (int j = 0; j < 4; ++j) { const f32x4 v = xr[64 * j]; xr[64 * j] = v * r * gv[j]; }
    }
}

#ifndef PROBE_REP
#define PROBE_REP (-1)
#endif
#ifndef PG8_SP2
#define PG8_SP2 true
#endif
#ifndef PG8_ALIGN
#define PG8_ALIGN true
#endif
enum { PH_PRO = 0, PH_G1 = 1, PH_MIX = 2, PH_G2 = 3, PH_G3 = 4, PH_XAT = 5, PH_G4 = 6, PH_G5 = 7, PH_ACT = 8, PH_G6 = 9, PH_FIN = 10, PH_N = 11 };

__device__ __forceinline__ bool phase_in(Frame& F, int lo, int hi, int k) {
    if (!(lo <= k && k < hi)) return false;
    int t_ = threadIdx.x; asm volatile("" : "+v"(t_)); F.tid = t_; F.lane = t_ & 63; return true;
}
__global__ void __launch_bounds__(NWAVES * 64, 2) mk_fwd(Args args) {
    extern __shared__ __attribute__((aligned(16))) unsigned char lds[];
    Frame F;
    F.lds = (LAS unsigned char*)lds;
    F.MISC = (volatile LAS unsigned*)(F.lds + MISC_OFF);
    F.tid = threadIdx.x; F.lane = F.tid & 63; F.wave = __builtin_amdgcn_readfirstlane(F.tid >> 6);
    F.G = gridDim.x; { const int bx = blockIdx.x; F.vcu = (F.G % 8 == 0) ? (bx % 8) * (F.G / 8) + bx / 8 : bx; }
    unsigned char* ws = args.ws;
    F.ctl = (gu32*)(ws + WS_CTL);
    for (int u = F.tid; u < (LDS_BYTES - LDSCTL_OFF) / 4; u += NWAVES * 64) ((LAS unsigned*)(F.lds + LDSCTL_OFF))[u] = 0u;
    __syncthreads();
    const int lo = args.ph_lo, hi = args.ph_hi;
    XcdBarrier bar = xcd_barrier_post((unsigned*)(F.ctl + CW_BAR) + args.li * XCD_BAR_WORDS, F.MISC + 8);
#define IN(k) (phase_in(F, lo, hi, (k)))
#define SEAM(k) do { if (lo <= (k) && (k) + 1 < hi) xcd_barrier(bar); } while (0)
    bf16* XB = (bf16*)(ws + WS_XB); bf16* P = (bf16*)(ws + WS_P); bf16* MIX = (bf16*)(ws + WS_MIX); bf16* QX = (bf16*)(ws + WS_QX); bf16* XO = (bf16*)(ws + WS_XO); bf16* U = (bf16*)(ws + WS_U);
    const int G = F.G, bx = (int)blockIdx.x;

    if (IN(PH_PRO)) { p0_prologue(F, args); SEAM(PH_PRO); }
    if (IN(PH_G1)) {
        { pg8::Gemm g{XB, D, (const bf16*)(ws + WS_WIN), M, NP, D}; pg8::StaticOrder S; S.init(M, NP, G, bx);
          pg8::EpiScaleBf16<pg8::RsArr> E{P, NP, {(const float*)(ws + WS_RSTD0)}};
          pg8::gemm_phase<pg8::EpiScaleBf16<pg8::RsArr>, pg8::StaticOrder, PG8_ALIGN, PG8_SP2>(F.lds + RING_OFF, g, S, E); }
        { pg8::Gemm g{(const bf16*)(ws + WS_MEMB), D, (const bf16*)(ws + WS_WKV), MMEM, 2048, D}; pg8::StaticOrder S; S.init(MMEM, 2048, G, (bx + G / 2) % G);
          pg8::EpiScaleBf16<pg8::RsArr> E{(bf16*)(ws + WS_KVM), 2048, {(const float*)(ws + WS_RSTDM)}};
          pg8::gemm_phase<pg8::EpiScaleBf16<pg8::RsArr>, pg8::StaticOrder, PG8_ALIGN, PG8_SP2>(F.lds + RING_OFF, g, S, E); }
        SEAM(PH_G1);
    }
    if (IN(PH_MIX)) { p2_mix(F, args, bar); SEAM(PH_MIX); }
    if (IN(PH_G2)) {
        pg8::Gemm g{MIX, D, (const bf16*)(ws + WS_WOUT), M, D, D}; pg8::StaticOrder S; S.init(M, D, G, bx);
        pg8::EpiResid<true> E{args.in[0], args.out, XB, (float*)(ws + WS_SSQ1), D};
        pg8::gemm_phase<pg8::EpiResid<true>, pg8::StaticOrder, PG8_ALIGN, PG8_SP2>(F.lds + RING_OFF, g, S, E);
        SEAM(PH_G2);
    }
    if (IN(PH_G3)) {
        pg8::Gemm g{XB, D, (const bf16*)(ws + WS_WQ), M, D, D}; pg8::StaticOrder S; S.init(M, D, G, bx);
        pg8::EpiScaleBf16<pg8::RsOne> E{QX, D, {}};
        pg8::gemm_phase<pg8::EpiScaleBf16<pg8::RsOne>, pg8::StaticOrder, PG8_ALIGN, PG8_SP2>(F.lds + RING_OFF, g, S, E);
        SEAM(PH_G3);
    }
    if (IN(PH_XAT)) { p5_xattn(F, args); SEAM(PH_XAT); }
    if (IN(PH_G4)) {
        pg8::Gemm g{XO, D, (const bf16*)(ws + WS_WO), M, D, D}; pg8::StaticOrder S; S.init(M, D, G, bx);
        pg8::EpiResid<true> E{args.out, args.out, XB, (float*)(ws + WS_SSQ2), D};
        pg8::gemm_phase<pg8::EpiResid<true>, pg8::StaticOrder, PG8_ALIGN, PG8_SP2>(F.lds + RING_OFF, g, S, E);
        SEAM(PH_G4);
    }
    if (IN(PH_G5)) {
        pg8::Gemm g{XB, D, (const bf16*)(ws + WS_WUP), M, NU, D}; pg8::StaticOrder S; S.init(M, NU, G, bx);
        pg8::EpiScaleBf16<pg8::RsParts> E{U, NU, {(const float*)(ws + WS_SSQ2)}};
        pg8::gemm_phase<pg8::EpiScaleBf16<pg8::RsParts>, pg8::StaticOrder, PG8_ALIGN, PG8_SP2>(F.lds + RING_OFF, g, S, E);
        SEAM(PH_G5);
    }
    if (IN(PH_ACT)) { p8_act(F, args); SEAM(PH_ACT); }
    if (IN(PH_G6)) {
        pg8::Gemm g{U + FF, NU, (const bf16*)(ws + WS_WDN), M, D, FF}; pg8::StaticOrder S; S.init(M, D, G, bx);
        pg8::EpiResid<false> E{args.out, args.out, nullptr, (float*)(ws + WS_SSQ3), D};
        pg8::gemm_phase<pg8::EpiResid<false>, pg8::StaticOrder, PG8_ALIGN, PG8_SP2>(F.lds + RING_OFF, g, S, E);
        SEAM(PH_G6);
    }
    if (IN(PH_FIN)) { p10_final(F, args); }
#undef IN
#undef SEAM
}
extern "C" void kernel_launch(void* const* d_in, const int* in_sizes, int n_in, void* d_out, int out_size, void* d_ws, size_t ws_size, hipStream_t stream) {
    static int grid = 0;
    if (grid == 0) {
        if (n_in != 20 || in_sizes[0] != M * D || out_size != M * D || ws_size < WS_END) { fprintf(stderr, "kernel_launch: shape/workspace mismatch: n_in %d in0 %d out %d ws %zu (need %zu)\n", n_in, n_in > 0 ? in_sizes[0] : -1, out_size, ws_size, (size_t)WS_END); grid = -1; return; }
        int dev = 0, cus = 0, per_cu = 0;
        if (hipGetDevice(&dev) != hipSuccess || hipDeviceGetAttribute(&cus, hipDeviceAttributeMultiprocessorCount, dev) != hipSuccess) { fprintf(stderr, "kernel_launch: device query failed\n"); grid = -1; return; }
        if (hipFuncSetAttribute((const void*)mk_fwd, hipFuncAttributeMaxDynamicSharedMemorySize, LDS_BYTES) != hipSuccess) { fprintf(stderr, "kernel_launch: hipFuncSetAttribute failed\n"); grid = -1; return; }
        if (hipOccupancyMaxActiveBlocksPerMultiprocessor(&per_cu, (const void*)mk_fwd, NWAVES * 64, LDS_BYTES) != hipSuccess || per_cu < 1) { fprintf(stderr, "kernel_launch: occupancy query reports %d workgroups per CU\n", per_cu); (void)hipGetLastError(); grid = -1; return; }
        grid = cus;
    }
    if (grid < 0) return;
    (void)hipMemsetAsync((char*)d_ws + WS_CTL, 0, CTL_ZERO_BYTES, stream);
    Args a{};
    for (int i = 0; i < 20; ++i) a.in[i] = (const float*)d_in[i];
    a.out = (float*)d_out; a.ws = (unsigned char*)d_ws;
    unsigned char* ws = (unsigned char*)d_ws;
    auto launch = [&](int lo, int hi, int li) { a.ph_lo = lo; a.ph_hi = hi; a.li = li; hipLaunchKernelGGL(mk_fwd, dim3(grid), dim3(NWAVES * 64), LDS_BYTES, stream, a); };
#if PROBE_REP >= 0
    launch(PH_PRO, PROBE_REP + 1, 0); launch(PROBE_REP, PH_N, 1);
#else
    launch(PH_PRO, PH_N, 0);
#endif
}
```

```cpp
#include <hip/hip_runtime.h>
#include <cstdio>
#include <cstdint>
namespace pg8 {
#define PG8_LAS __attribute__((address_space(3)))
typedef unsigned short bf16_t;
typedef short bf16x8 __attribute__((ext_vector_type(8)));
typedef float f32x4 __attribute__((ext_vector_type(4)));
typedef unsigned u32x4 __attribute__((ext_vector_type(4)));
constexpr int BM = 256, BK = 64, HALF = 128, HTB = HALF * BK * 2  , STAGE_BYTES = 8 * HTB, NXCD = 8, WGM = 8;

__host__ __device__ __forceinline__ int lds_byte(int r, int c) { const int st = (r >> 4) * 2 + (c >> 5), rr = r & 15, cc = c & 31, ob = rr * 64 + cc * 2; return st * 1024 + (ob ^ (((ob >> 9) & 1) << 5)); }
__host__ __device__ __forceinline__ void stage_rc(int b, int& R, int& C) { const int st = b / 1024, sb = b % 1024, swz = sb ^ (((sb >> 9) & 1) << 5); R = (st >> 1) * 16 + swz / 64; C = (st & 1) * 32 + (swz % 64) / 2; }
__host__ __device__ __forceinline__ int perm32(int rho) { const int n = rho >> 4, i = rho & 15; return 8 * (i >> 2) + 4 * n + (i & 3); }

struct Unit { int pm, pn; };
struct Gemm { const bf16_t* A; int lda; const bf16_t* Bt; int M, N, K; };

struct StaticOrder {
    int nM, nN, nwg, G, c;
    __host__ __device__ void init(int M, int N, int G_, int c_) { nM = M / BM; nN = N / BM; nwg = nM * nN; G = G_; c = c_; }
    __host__ __device__ bool next(int i, Unit& u) const {
        const long L = (long)i * G + c; if (L >= nwg) return false;
        int wgid = (int)L; { const int q = nwg / NXCD, r = nwg % NXCD, xcd = wgid % NXCD, off = wgid / NXCD; wgid = (xcd < r ? xcd * (q + 1) : r * (q + 1) + (xcd - r) * q) + off; }
        const int nig = WGM * nN, gid = wgid / nig, fm = gid * WGM, gsz = (nM - fm) < WGM ? (nM - fm) : WGM;
        u.pm = fm + ((wgid % nig) % gsz); u.pn = (wgid % nig) / gsz; return true;
    }
    __device__ __forceinline__ void a_ready(const Unit&) const {}
    __device__ __forceinline__ void done(const Unit&) const {}
};

__device__ __forceinline__ unsigned cvt_pk_bf16(float lo, float hi) { unsigned r; asm volatile("v_cvt_pk_bf16_f32 %0, %1, %2" : "=v"(r) : "v"(lo), "v"(hi)); return r; }
typedef float f32x2 __attribute__((ext_vector_type(2)));
constexpr float RMS_EPS = 1e-6f;
struct RsOne   { __device__ __forceinline__ float get(int) const { return 1.0f; } };
struct RsArr   { const float* r; __device__ __forceinline__ float get(int row) const { return r[row]; } };
struct RsParts { const float* p;
    __device__ __forceinline__ float get(int row) const { const f32x4* q = (const f32x4*)(p + (size_t)row * 16); const f32x4 a = q[0], b = q[1], c = q[2], d = q[3];
        const float s = ((a[0] + a[1]) + (a[2] + a[3])) + ((b[0] + b[1]) + (b[2] + b[3])) + ((c[0] + c[1]) + (c[2] + c[3])) + ((d[0] + d[1]) + (d[2] + d[3]));
        return 1.0f / sqrtf(s * (1.0f / 1024.0f) + RMS_EPS); } };
template <class RS> struct EpiScaleBf16 {
    static constexpr bool PERM = true, AFTER_DRAIN = false;
    bf16_t* O; int ldc; RS rs;
    __device__ __forceinline__ void operator()(const f32x4 (&acc)[2][2][4][2], const Unit& u, int wr, int wc, int fr, int fq) const {
        const int row0 = u.pm * BM + wr * 64 + fr, col0 = u.pn * BM + wc * 32 + 8 * fq;
#pragma unroll
        for (int ai = 0; ai < 2; ++ai)
#pragma unroll
            for (int m = 0; m < 4; ++m) { const int row = row0 + ai * HALF + m * 16; const float sc = rs.get(row); bf16_t* rowp = O + (size_t)row * ldc + col0;
#pragma unroll
                for (int bj = 0; bj < 2; ++bj) { const f32x4 v0 = acc[ai][bj][m][0] * sc, v1 = acc[ai][bj][m][1] * sc;
                    u32x4 w; w.x = cvt_pk_bf16(v0[0], v0[1]); w.y = cvt_pk_bf16(v0[2], v0[3]); w.z = cvt_pk_bf16(v1[0], v1[1]); w.w = cvt_pk_bf16(v1[2], v1[3]);
                    *(u32x4*)(rowp + bj * HALF) = w; } }
    }
};
template <bool WRITE_BF16> struct EpiResid {
    static constexpr bool PERM = false, AFTER_DRAIN = false;
    const float* base; float* out; bf16_t* xb; float* ssq; int ldc;
    __device__ __forceinline__ void operator()(const f32x4 (&acc)[2][2][4][2], const Unit& u, int wr, int wc, int fr, int fq) const {
        typedef unsigned u32x2v __attribute__((ext_vector_type(2)));
        const int row0 = u.pm * BM + wr * 64 + fr, col0 = u.pn * BM + wc * 32 + 4 * fq;
#pragma unroll
        for (int ai = 0; ai < 2; ++ai) {
            f32x4 pre[4][2][2];
#pragma unroll
            for (int m = 0; m < 4; ++m) { const size_t off = (size_t)(row0 + ai * HALF + m * 16) * ldc + col0;
#pragma unroll
                for (int bj = 0; bj < 2; ++bj)
#pragma unroll
                    for (int n = 0; n < 2; ++n) pre[m][bj][n] = *(const f32x4*)(base + off + bj * HALF + n * 16); }
#pragma unroll
            for (int m = 0; m < 4; ++m) { const int row = row0 + ai * HALF + m * 16; const size_t off = (size_t)row * ldc + col0; float ss = 0.f;
#pragma unroll
                for (int bj = 0; bj < 2; ++bj)
#pragma unroll
                    for (int n = 0; n < 2; ++n) { const size_t o2 = off + bj * HALF + n * 16; const f32x4 o = pre[m][bj][n] + acc[ai][bj][m][n];
                        *(f32x4*)(out + o2) = o; ss += (o[0] * o[0] + o[1] * o[1]) + (o[2] * o[2] + o[3] * o[3]);
                        if (WRITE_BF16) { u32x2v w; w.x = cvt_pk_bf16(o[0], o[1]); w.y = cvt_pk_bf16(o[2], o[3]); *(u32x2v*)(xb + o2) = w; } }
                ss += __shfl_xor(ss, 16); ss += __shfl_xor(ss, 32);
                if (fq == 0) ssq[(size_t)row * 16 + u.pn * 4 + wc] = ss; }
            asm volatile("" ::: "memory");
        }
    }
};
__device__ __forceinline__ float dpp_shr1(float cur, float prv) {
    const int t = __builtin_amdgcn_update_dpp(0, __builtin_bit_cast(int, prv), 0x121, 0xf, 0xf, false);
    return __builtin_bit_cast(float, __builtin_amdgcn_update_dpp(t, __builtin_bit_cast(int, cur), 0x111, 0xf, 0xf, false)); }
__device__ __forceinline__ float dpp_shr2(float cur, float prv) {
    const int t = __builtin_amdgcn_update_dpp(0, __builtin_bit_cast(int, prv), 0x122, 0xf, 0xf, false);
    return __builtin_bit_cast(float, __builtin_amdgcn_update_dpp(t, __builtin_bit_cast(int, cur), 0x112, 0xf, 0xf, false)); }
struct EpiGateConv {
    static constexpr bool PERM = true, AFTER_DRAIN = false;
    static constexpr int FFD = 2816;
    bf16_t* ACT; RsParts rs; const float* cw; const float* cb; float* SB;
    __device__ __forceinline__ void operator()(const f32x4 (&acc)[2][2][4][2], const Unit& u, int wr, int wc, int fr, int fq) const {
        const int ch0 = 128 * u.pn + 32 * wc + 8 * fq;
        f32x4 w0[2], w1[2], w2[2], bb[2];
#pragma unroll
        for (int n = 0; n < 2; ++n) { w0[n] = *(const f32x4*)(cw + ch0 + 4 * n); w1[n] = *(const f32x4*)(cw + FFD + ch0 + 4 * n); w2[n] = *(const f32x4*)(cw + 2 * FFD + ch0 + 4 * n); bb[n] = *(const f32x4*)(cb + ch0 + 4 * n); }
#pragma unroll
        for (int ai = 0; ai < 2; ++ai) {
            f32x4 Gp[2] = {(f32x4){0.f, 0.f, 0.f, 0.f}, (f32x4){0.f, 0.f, 0.f, 0.f}};
            const int grow = u.pm * BM + ai * HALF + wr * 64, grp = grow >> 6;
#pragma unroll
            for (int m = 0; m < 4; ++m) {
                const int row = grow + m * 16 + fr; const float sc = rs.get(row);
                f32x4 G[2], V[2]; u32x4 w;
#pragma unroll
                for (int n = 0; n < 2; ++n) { G[n] = acc[ai][0][m][n] * sc; V[n] = acc[ai][1][m][n] * sc; }
#pragma unroll
                for (int n = 0; n < 2; ++n) { float a[4];
#pragma unroll
                    for (int e = 0; e < 4; ++e) { const float g1 = dpp_shr1(G[n][e], Gp[n][e]), g2 = dpp_shr2(G[n][e], Gp[n][e]);
                        const float y = __builtin_fmaf(w2[n][e], G[n][e], __builtin_fmaf(w1[n][e], g1, __builtin_fmaf(w0[n][e], g2, bb[n][e])));
                        a[e] = y * __builtin_amdgcn_rcpf(1.0f + __builtin_amdgcn_exp2f(-1.4426950408889634f * y)) * V[n][e]; }
                    w[2 * n] = cvt_pk_bf16(a[0], a[1]); w[2 * n + 1] = cvt_pk_bf16(a[2], a[3]); }
                if (!(m == 0 && fr < 2)) *(u32x4*)(ACT + (size_t)row * FFD + ch0) = w;
                if (m == 0 && fr < 2) { float* sb = SB + ((size_t)grp * 6 + 2 + fr) * FFD + ch0; *(f32x4*)sb = G[0]; *(f32x4*)(sb + 4) = G[1]; sb += 2 * FFD; *(f32x4*)sb = V[0]; *(f32x4*)(sb + 4) = V[1]; }
                if (m == 3 && fr >= 14) { float* sb = SB + ((size_t)grp * 6 + (fr - 14)) * FFD + ch0; *(f32x4*)sb = G[0]; *(f32x4*)(sb + 4) = G[1]; }
                Gp[0] = G[0]; Gp[1] = G[1];
            }
        }
    }
};
template <class Epi, class Sched, bool ALIGN_EPI = false, bool SP2 = false>
__device__ __forceinline__ void gemm_phase(PG8_LAS unsigned char* lds, const Gemm g, const Sched& S, const Epi& E) {
    const int tid = threadIdx.x, wid = __builtin_amdgcn_readfirstlane(tid >> 6), lane = tid & 63, wr = wid >> 2, wc = wid & 3, fr = lane & 15, fq = lane >> 4;
    const int K = g.K, nt = K / BK;
    unsigned voffA[2], voffB[2];
#pragma unroll
    for (int i = 0; i < 2; ++i) { int R, C; stage_rc(tid * 16 + i * 8192, R, C); const int Rb = Epi::PERM ? ((R & ~31) + perm32(R & 31)) : R;
        voffA[i] = (unsigned)(R * g.lda + C) * 2u; voffB[i] = (unsigned)(Rb * K + C) * 2u; }
    const size_t kstep = (size_t)(BK * 2);
    const size_t hstepA = (size_t)HALF * g.lda * 2, hstepB = (size_t)HALF * K * 2;
    const size_t tstepA = 2 * hstepA, tstepB = 2 * hstepB;
    const unsigned ldsw = (unsigned)wid * 1024u;
    const int aoff = lds_byte(wr * 64 + fr, fq * 8), boff = lds_byte(wc * 32 + fr, fq * 8);
#define PG8_SA(b, h) (((b) * 2 + (h)) * HTB)
#define PG8_SB(b, h) ((4 + (b) * 2 + (h)) * HTB)
#define PG8_STAGE(bufoff, gbase, voff) do { _Pragma("unroll") for (int _i = 0; _i < 2; ++_i) \
        __builtin_amdgcn_global_load_lds((const unsigned*)((const char*)(gbase) + (voff)[_i]), (PG8_LAS unsigned*)(lds + (bufoff) + ldsw + _i * 8192), 16, 0, 0); } while (0)
#define PG8_LDA(dst, b, h) do { _Pragma("unroll") for (int m = 0; m < 4; ++m) _Pragma("unroll") for (int k = 0; k < 2; ++k) dst[m][k] = *(const PG8_LAS bf16x8*)(lds + PG8_SA(b, h) + aoff + m * 2048 + k * 1024); } while (0)
#define PG8_LDB(dst, b, h) do { _Pragma("unroll") for (int n = 0; n < 2; ++n) _Pragma("unroll") for (int k = 0; k < 2; ++k) dst[n][k] = *(const PG8_LAS bf16x8*)(lds + PG8_SB(b, h) + boff + n * 2048 + k * 1024); } while (0)
#define PG8_MMA(ai, bj, At, Bt) do { __builtin_amdgcn_s_setprio(1); _Pragma("unroll") for (int m = 0; m < 4; ++m) _Pragma("unroll") for (int n = 0; n < 2; ++n) _Pragma("unroll") for (int k = 0; k < 2; ++k) \
        acc[ai][bj][m][n] = __builtin_amdgcn_mfma_f32_16x16x32_bf16(Bt[n][k], At[m][k], acc[ai][bj][m][n], 0, 0, 0); __builtin_amdgcn_s_setprio(0); } while (0)
#define PG8_WAIT_V(n) asm volatile("s_waitcnt vmcnt(" #n ")" ::: "memory")
#define PG8_WAIT_L(n) asm volatile("s_waitcnt lgkmcnt(" #n ")" ::: "memory")
#define PG8_BAR __builtin_amdgcn_s_barrier()
#define PG8_SCHED __builtin_amdgcn_sched_barrier(0)
    Unit cur, nxt; int ui = 0;
    if (!S.next(0, cur)) return;
    f32x4 acc[2][2][4][2];
#pragma unroll
    for (int a = 0; a < 2; ++a)
#pragma unroll
        for (int b = 0; b < 2; ++b)
#pragma unroll
            for (int m = 0; m < 4; ++m)
#pragma unroll
                for (int n = 0; n < 2; ++n) acc[a][b][m][n] = (f32x4){0.f, 0.f, 0.f, 0.f};
    bf16x8 At[4][2], B0[2][2], B1[2][2];
    const char* cA = (const char*)g.A + (size_t)cur.pm * tstepA; const char* cB = (const char*)g.Bt + (size_t)cur.pn * tstepB;
    S.a_ready(cur);
    if constexpr (SP2) {
        PG8_STAGE(PG8_SB(0, 0), cB, voffB); PG8_STAGE(PG8_SB(0, 1), cB + hstepB, voffB); PG8_STAGE(PG8_SA(0, 0), cA, voffA); PG8_STAGE(PG8_SA(0, 1), cA + hstepA, voffA);
        if (wr == 1) PG8_BAR;
        PG8_WAIT_V(2); PG8_BAR;
        PG8_STAGE(PG8_SB(1, 0), cB + kstep, voffB); PG8_STAGE(PG8_SA(1, 0), cA + kstep, voffA); PG8_STAGE(PG8_SB(1, 1), cB + hstepB + kstep, voffB);
        PG8_WAIT_V(6); PG8_BAR;
    } else {
        PG8_STAGE(PG8_SB(0, 0), cB, voffB); PG8_STAGE(PG8_SA(0, 0), cA, voffA); PG8_STAGE(PG8_SB(0, 1), cB + hstepB, voffB); PG8_STAGE(PG8_SA(0, 1), cA + hstepA, voffA);
        if (wr == 1) PG8_BAR;
        PG8_WAIT_V(4); PG8_BAR;
        PG8_STAGE(PG8_SB(1, 0), cB + kstep, voffB); PG8_STAGE(PG8_SA(1, 0), cA + kstep, voffA); PG8_STAGE(PG8_SB(1, 1), cB + hstepB + kstep, voffB);
        PG8_WAIT_V(6); PG8_BAR;
    }
    for (;;) {
        const bool has_next = S.next(ui + 1, nxt);
        const char* nA = has_next ? (const char*)g.A + (size_t)nxt.pm * tstepA : cA; const char* nB = has_next ? (const char*)g.Bt + (size_t)nxt.pn * tstepB : cB;
        for (int t = 0; t < nt; t += 2) {
            const bool last = (t == nt - 2);
            const char* a1 = cA + (size_t)(t + 1) * kstep;
            const char* a2 = last ? nA : cA + (size_t)(t + 2) * kstep; const char* b2 = last ? nB : cB + (size_t)(t + 2) * kstep;
            const char* a3 = a2 + kstep; const char* b3 = b2 + kstep;
            if (last && has_next) S.a_ready(nxt);
            if constexpr (SP2) {
            PG8_LDB(B0, 0, 0); PG8_LDB(B1, 0, 1); PG8_SCHED; PG8_LDA(At, 0, 0); PG8_STAGE(PG8_SA(1, 1), a1 + hstepA, voffA);
            PG8_WAIT_V(8); PG8_WAIT_L(0); PG8_BAR; PG8_MMA(0, 0, At, B0); PG8_MMA(0, 1, At, B1); PG8_BAR; PG8_SCHED;
            PG8_LDA(At, 0, 1); PG8_STAGE(PG8_SB(0, 0), b2, voffB); PG8_STAGE(PG8_SB(0, 1), b2 + hstepB, voffB); PG8_STAGE(PG8_SA(0, 0), a2, voffA);
            PG8_WAIT_V(8); PG8_WAIT_L(0); PG8_BAR; PG8_MMA(1, 0, At, B0); PG8_MMA(1, 1, At, B1); PG8_BAR; PG8_SCHED;
            PG8_LDB(B0, 1, 0); PG8_LDB(B1, 1, 1); PG8_SCHED; PG8_LDA(At, 1, 0); PG8_STAGE(PG8_SA(0, 1), a2 + hstepA, voffA);
            PG8_WAIT_V(8); PG8_WAIT_L(0); PG8_BAR; PG8_MMA(0, 0, At, B0); PG8_MMA(0, 1, At, B1); PG8_BAR; PG8_SCHED;
            PG8_LDA(At, 1, 1); PG8_STAGE(PG8_SB(1, 0), b3, voffB); PG8_STAGE(PG8_SB(1, 1), b3 + hstepB, voffB); PG8_STAGE(PG8_SA(1, 0), a3, voffA);
            PG8_WAIT_V(8); PG8_WAIT_L(0); PG8_BAR; PG8_MMA(1, 0, At, B0); PG8_MMA(1, 1, At, B1); PG8_BAR; PG8_SCHED;
            } else {
            PG8_LDB(B0, 0, 0); PG8_SCHED; PG8_LDA(At, 0, 0); PG8_STAGE(PG8_SA(1, 1), a1 + hstepA, voffA);
            PG8_WAIT_L(8); PG8_BAR; PG8_WAIT_L(0); PG8_MMA(0, 0, At, B0); PG8_BAR; PG8_SCHED;
            PG8_LDB(B1, 0, 1); PG8_STAGE(PG8_SB(0, 0), b2, voffB);
            PG8_BAR; PG8_WAIT_L(0); PG8_MMA(0, 1, At, B1); PG8_BAR;
            PG8_LDA(At, 0, 1); PG8_STAGE(PG8_SA(0, 0), a2, voffA);
            PG8_BAR; PG8_WAIT_L(0); PG8_MMA(1, 0, At, B0); PG8_BAR; PG8_SCHED;
            PG8_STAGE(PG8_SB(0, 1), b2 + hstepB, voffB);
            PG8_WAIT_V(6); PG8_BAR; PG8_MMA(1, 1, At, B1); PG8_BAR;
            PG8_LDB(B0, 1, 0); PG8_SCHED; PG8_LDA(At, 1, 0); PG8_STAGE(PG8_SA(0, 1), a2 + hstepA, voffA);
            PG8_WAIT_L(8); PG8_BAR; PG8_WAIT_L(0); PG8_MMA(0, 0, At, B0); PG8_BAR; PG8_SCHED;
            PG8_LDB(B1, 1, 1); PG8_STAGE(PG8_SB(1, 0), b3, voffB);
            PG8_BAR; PG8_WAIT_L(0); PG8_MMA(0, 1, At, B1); PG8_BAR;
            PG8_LDA(At, 1, 1); PG8_STAGE(PG8_SA(1, 0), a3, voffA);
            PG8_BAR; PG8_WAIT_L(0); PG8_MMA(1, 0, At, B0); PG8_BAR; PG8_SCHED;
            PG8_STAGE(PG8_SB(1, 1), b3 + hstepB, voffB);
            PG8_WAIT_V(6); PG8_BAR; PG8_MMA(1, 1, At, B1); PG8_BAR;
            }
        }
        if constexpr (ALIGN_EPI) { if (wr == 0) PG8_BAR; }
        if constexpr (!Epi::AFTER_DRAIN) { E(acc, cur, wr, wc, fr, fq); S.done(cur); }
        if (!has_next) break;
#pragma unroll
        for (int a = 0; a < 2; ++a)
#pragma unroll
            for (int b = 0; b < 2; ++b)
#pragma unroll
                for (int m = 0; m < 4; ++m)
#pragma unroll
                    for (int n = 0; n < 2; ++n) acc[a][b][m][n] = (f32x4){0.f, 0.f, 0.f, 0.f};
        cur = nxt; cA = nA; cB = nB; ++ui;
        if constexpr (ALIGN_EPI) { if (wr == 1) PG8_BAR; }
    }
    PG8_WAIT_V(0);
    if constexpr (!ALIGN_EPI) { if (wr == 0) PG8_BAR; }
    PG8_BAR;
    if constexpr (Epi::AFTER_DRAIN) { E.fused(acc, cur, wr, wc, fr, fq, lds, wid, lane); S.done(cur); }
#undef PG8_SA
#undef PG8_SB
#undef PG8_STAGE
#undef PG8_LDA
#undef PG8_LDB
#undef PG8_MMA
#undef PG8_WAIT_V
#undef PG8_WAIT_L
#undef PG8_BAR
#undef PG8_SCHED
}
}
#define GAS __attribute__((address_space(1)))
#define LAS __attribute__((address_space(3)))
typedef unsigned short bf16;
typedef unsigned v4u __attribute__((ext_vector_type(4)));
typedef float f32x4 __attribute__((ext_vector_type(4)));
typedef short bf16x8 __attribute__((ext_vector_type(8)));
typedef GAS unsigned gu32;
typedef GAS unsigned long long gu64;
#define RLX_AGENT __ATOMIC_RELAXED, __HIP_MEMORY_SCOPE_AGENT
#define LDS_WAIT() asm volatile("s_waitcnt lgkmcnt(0)" ::: "memory")
#define VM_WAIT() asm volatile("s_waitcnt vmcnt(0)" ::: "memory")
__device__ __forceinline__ unsigned long long rt() { return __builtin_amdgcn_s_memrealtime(); }
__device__ __forceinline__ unsigned f2bf(float f) { unsigned u = __builtin_bit_cast(unsigned, f); return (u + 0x7fffu + ((u >> 16) & 1u)) >> 16; }
__device__ __forceinline__ unsigned pk2(float lo, float hi) { return f2bf(lo) | (f2bf(hi) << 16); }

#define XB_TMO      128
#define XB_XCNT(j)  (256  + 64 * (j))
#define XB_XSUB(j)  (1280 + 64 * (j))
#define XB_XGEN(j)  (2304 + 64 * (j))
#define XB_TOP      3328
#define XB_TOPGEN   3392
#define XCD_BAR_WORDS 3456
#define XB_SPIN_CAP (1u << 18)

__device__ __forceinline__ unsigned xb_ld(unsigned* p)              { return __hip_atomic_load(p, __ATOMIC_RELAXED, __HIP_MEMORY_SCOPE_AGENT); }
__device__ __forceinline__ unsigned xb_add(unsigned* p, unsigned v) { return __hip_atomic_fetch_add(p, v, __ATOMIC_RELAXED, __HIP_MEMORY_SCOPE_AGENT); }
__device__ __forceinline__ unsigned xb_xcc_id() { return (unsigned)__builtin_amdgcn_s_getreg((3 << 11) | 20) & 0xFu; }
#define XB_SPIN(cond, bar) do { unsigned _sp = 0; while (cond) { __builtin_amdgcn_s_sleep(1); \
    if ((++_sp & 255u) == 0u) { if (xb_ld(&(bar)[XB_TMO])) break; if (_sp > XB_SPIN_CAP) { atomicAdd(&(bar)[XB_TMO], 1u); break; } } } } while (0)

struct XcdBarrier {
    unsigned* bar; unsigned x;
    volatile LAS unsigned* st;
};

__device__ __forceinline__ XcdBarrier xcd_barrier_post(unsigned* bar, volatile LAS unsigned* st) {
    XcdBarrier b; b.bar = bar; b.x = xb_xcc_id(); b.st = st;
    if (threadIdx.x == 0) (void)xb_add(&bar[XB_XCNT(b.x)], 1u);
    return b;
}
__device__ __forceinline__ void xcd_barrier_complete(unsigned* bar, unsigned x, unsigned& nloc, unsigned& nx) {
    const unsigned G = gridDim.x * gridDim.y * gridDim.z;
    unsigned sum, cnt, mine, sp = 0u;
    for (;;) {
        sum = 0u; cnt = 0u; mine = 0u;
#pragma unroll
        for (unsigned j = 0; j < 16; ++j) { const unsigned c = xb_ld(&bar[XB_XCNT(j)]); sum += c; cnt += (c > 0u) ? 1u : 0u; mine = (j == x) ? c : mine; }
        if (sum == G) break;
        __builtin_amdgcn_s_sleep(1);
        if ((++sp & 255u) == 0u) { if (xb_ld(&bar[XB_TMO])) break; if (sp > XB_SPIN_CAP) { atomicAdd(&bar[XB_TMO], 1u); break; } }
    }
    nloc = mine > 0u ? mine : 1u; nx = cnt > 0u ? cnt : 1u;
}

__device__ __forceinline__ void xcd_barrier(const XcdBarrier& b) {
    asm volatile("s_waitcnt vmcnt(0)" ::: "memory");
    __syncthreads();
    if (threadIdx.x == 0) {
        unsigned* bar = b.bar;
        __builtin_amdgcn_s_waitcnt(0);
        unsigned nloc = b.st[0], nx = b.st[1];
        if (nloc == 0u) { xcd_barrier_complete(bar, b.x, nloc, nx); b.st[0] = nloc; b.st[1] = nx; }
        const unsigned old = xb_add(&bar[XB_XSUB(b.x)], 1u);
        const unsigned gen = old / nloc;
        if (old + 1u == (gen + 1u) * nloc) {
            __builtin_amdgcn_fence(__ATOMIC_RELEASE, "agent");
            asm volatile("s_waitcnt vmcnt(0)" ::: "memory");
            const unsigned og = xb_add(&bar[XB_TOP], 1u);
            const unsigned tg = og / nx;
            if (og + 1u == (tg + 1u) * nx) xb_add(&bar[XB_TOPGEN], 1u);
            else XB_SPIN(xb_ld(&bar[XB_TOPGEN]) == tg, bar);
            __builtin_amdgcn_fence(__ATOMIC_ACQUIRE, "agent");
            xb_add(&bar[XB_XGEN(b.x)], 1u);
            asm volatile("s_waitcnt vmcnt(0)" ::: "memory");
        } else {
            XB_SPIN(xb_ld(&bar[XB_XGEN(b.x)]) == gen, bar);
            __builtin_amdgcn_fence(__ATOMIC_ACQUIRE, "agent");
            asm volatile("s_waitcnt vmcnt(0)" ::: "memory");
        }
    }
    __syncthreads();
}
constexpr int NWAVES = 8;
constexpr int BATCH = 16, SEQ = 2048, D = 1024, M = BATCH * SEQ;
constexpr int NP = 2816;
constexpr int IN_COLS = 2824;
constexpr int O_AK = 512, O_AV = 640, O_MQ = 768, O_MK = 1280, O_MV = 1792, O_MO = 2304, O_G = 2816;
constexpr int MEMLEN = 256, MMEM = BATCH * MEMLEN;
constexpr int FF = 2816, NU = 2 * FF;
constexpr float EPS = 1e-6f;
constexpr size_t MiB = 1u << 20;
constexpr size_t WS_CTL = 0, CTL_ZERO_BYTES = 1 * MiB;
constexpr size_t WS_RSTD0 = 1 * MiB;
constexpr size_t WS_RSTDM = WS_RSTD0 + 128 * 1024;
constexpr size_t WS_GPRE = 2 * MiB;
constexpr size_t WS_SSQ1 = 4 * MiB, WS_SSQ2 = 6 * MiB, WS_SSQ3 = 8 * MiB;
constexpr size_t WS_WIN = 16 * MiB, WS_WKV = 22 * MiB, WS_WOUT = 26 * MiB, WS_WQ = 28 * MiB, WS_WO = 30 * MiB, WS_WUP = 32 * MiB, WS_WDN = 43 * MiB;
constexpr size_t WS_MEMB = 49 * MiB;
constexpr size_t WS_KVM = 57 * MiB;
constexpr size_t WS_XB = 80 * MiB;
constexpr size_t WS_P = 144 * MiB;
constexpr size_t WS_MIX = 320 * MiB;
constexpr size_t WS_QX = 384 * MiB;
constexpr size_t WS_XO = 448 * MiB;
constexpr size_t WS_ACT = 144 * MiB;
constexpr size_t WS_SB = 320 * MiB;
constexpr size_t WS_END = 512 * MiB;
static_assert(WS_WDN + (size_t)D * FF * 2 <= WS_MEMB && WS_KVM + (size_t)MMEM * 2048 * 2 <= WS_XB && WS_XB + (size_t)M * D * 2 == WS_P && WS_P + (size_t)M * NP * 2 == WS_MIX && WS_ACT + (size_t)M * FF * 2 <= WS_SB && WS_SB + (size_t)(M / 64) * 6 * FF * 4 <= WS_QX, "d_ws map");
constexpr int CW_TMO = 0, CW_CODE = 1;
constexpr int CW_BAR = 4096;
constexpr int N_BAR_REGIONS = 16;
static_assert((CW_BAR + N_BAR_REGIONS * XCD_BAR_WORDS) * 4 <= (int)CTL_ZERO_BYTES, "CTL words inside the memset region");
constexpr int RING_OFF = 0, RING_BYTES = 131072;
constexpr int LDS_BYTES = 163840;
constexpr int LDSCTL_OFF = LDS_BYTES - 512, MISC_OFF = LDSCTL_OFF + 320;
constexpr int PH_LDS = LDSCTL_OFF;

struct Args { const float* in[20]; float* out; unsigned char* ws; int ph_lo, ph_hi, li, pad; };

struct Frame {
    LAS unsigned char* lds; volatile LAS unsigned* MISC; gu32* ctl;
    int tid, lane, wave, vcu, G;
};
__device__ __forceinline__ float wave_sum(float v) {
#pragma unroll
    for (int o = 1; o < 64; o <<= 1) v += __shfl_xor(v, o);
    return v;
}
__device__ __forceinline__ float bf2f(unsigned short b) { return __builtin_bit_cast(float, (unsigned)b << 16); }
__device__ __forceinline__ float bflo(unsigned w) { return __builtin_bit_cast(float, w << 16); }
__device__ __forceinline__ float bfhi(unsigned w) { return __builtin_bit_cast(float, w & 0xffff0000u); }

__device__ __forceinline__ void p0_transpose_item(const float* W, int K, int ldw, int src_col0, const float* g, bf16* WT, int dst_row0, LAS float* scr, int kb, int lane) {
    const int k0 = 64 * kb;
    float wv[32];
#pragma unroll
    for (int i = 0; i < 32; ++i) wv[i] = W[(size_t)(k0 + 2 * i + (lane >> 5)) * ldw + src_col0 + (lane & 31)];
#pragma unroll
    for (int i = 0; i < 32; ++i) { const int kk = 2 * i + (lane >> 5); float w = wv[i]; if (g) w *= g[k0 + kk]; scr[kk * 33 + (lane & 31)] = w; }
    LDS_WAIT(); asm volatile("" ::: "memory");
    const int c = lane & 7;
#pragma unroll
    for (int j = 0; j < 4; ++j) { const int n = (lane >> 3) + 8 * j; const LAS float* s = scr + (8 * c) * 33 + n;
        v4u o; o.x = pk2(s[0 * 33], s[1 * 33]); o.y = pk2(s[2 * 33], s[3 * 33]); o.z = pk2(s[4 * 33], s[5 * 33]); o.w = pk2(s[6 * 33], s[7 * 33]);
        *(GAS v4u*)(WT + (size_t)(dst_row0 + n) * K + k0 + 8 * c) = o; }
    LDS_WAIT(); asm volatile("" ::: "memory");
}
__device__ __forceinline__ void row_load(const float* xrow, int lane, f32x4 (&v)[4]) {
    const GAS f32x4* xr = (const GAS f32x4*)xrow + lane;
#pragma unroll
    for (int j = 0; j < 4; ++j) v[j] = xr[64 * j];
}
__device__ __forceinline__ float row_to_bf16(bf16* orow, int lane, const f32x4 (&v)[4]) {
    float s = 0.f;
#pragma unroll
    for (int j = 0; j < 4; ++j) s += (v[j][0] * v[j][0] + v[j][1] * v[j][1]) + (v[j][2] * v[j][2] + v[j][3] * v[j][3]);
    GAS unsigned long long* o8 = (GAS unsigned long long*)orow + lane;
#pragma unroll
    for (int j = 0; j < 4; ++j) o8[64 * j] = (unsigned long long)pk2(v[j][0], v[j][1]) | ((unsigned long long)pk2(v[j][2], v[j][3]) << 32);
    return wave_sum(s);
}
typedef float f32x16 __attribute__((ext_vector_type(16)));
typedef short s16x4 __attribute__((ext_vector_type(4)));
__device__ __forceinline__ int crow(int r, int hi) { return (r & 3) + 8 * (r >> 2) + 4 * hi; }
__device__ __forceinline__ unsigned cvtpk(float lo, float hi) { typedef float f2 __attribute__((ext_vector_type(2))); typedef __bf16 b2 __attribute__((ext_vector_type(2))); f2 v = {lo, hi}; b2 b = __builtin_convertvector(v, b2); return __builtin_bit_cast(unsigned, b); }
__device__ __forceinline__ s16x4 ldtr(const LAS unsigned char* p) { typedef short v4i16 __attribute__((ext_vector_type(4))); return __builtin_bit_cast(s16x4, __builtin_amdgcn_ds_read_tr16_b64_v4i16((LAS v4i16*)p)); }
__device__ __forceinline__ bf16x8 pack8(const f32x16& p, int b) { v4u w; w.x = cvtpk(p[b], p[b + 1]); w.y = cvtpk(p[b + 2], p[b + 3]); w.z = cvtpk(p[b + 4], p[b + 5]); w.w = cvtpk(p[b + 6], p[b + 7]); return __builtin_bit_cast(bf16x8, w); }
#define GLDS16(gptr, ldsptr) __builtin_amdgcn_global_load_lds((const unsigned*)(gptr), (LAS unsigned*)(ldsptr), 16, 0, 0)

__device__ __forceinline__ void xattn_unit(Frame& F, int b, int xh, int qb, const bf16* QX, const float* ssq1, const bf16* KVM, bf16* XO) {
    const int lane = F.lane, w = F.wave, r32 = lane & 31, hi = lane >> 5;
    const size_t row = (size_t)b * SEQ + qb * 256 + w * 32 + r32;
    const bf16* Kg = KVM + (size_t)b * MEMLEN * 2048 + xh * 256;
    { const bf16* kp = Kg + (size_t)(2 * w + (lane >> 5)) * 2048 + (lane & 31) * 8;
#pragma unroll
      for (int i = 0; i < 16; ++i) GLDS16(kp + (size_t)i * 16 * 2048, F.lds + (w + 8 * i) * 1040); }
    const bf16* qp = QX + row * D + xh * 256 + hi * 8;
    bf16x8 qa[2], qc[2];
#pragma unroll
    for (int j = 0; j < 2; ++j) qa[j] = *(const bf16x8*)(qp + j * 16);
    const pg8::RsParts rs{ssq1};
    const float sc2 = rs.get((int)row) * (0.0625f * 1.4426950408889634f);
    asm volatile("s_waitcnt vmcnt(0)" ::: "memory"); __syncthreads();
    const LAS unsigned char* kbase = F.lds + (r32 >> 1) * 1040 + (r32 & 1) * 512 + hi * 16;
    f32x16 S[8];
#pragma unroll
    for (int kb = 0; kb < 8; ++kb) S[kb] = (f32x16){0.f, 0.f, 0.f, 0.f, 0.f, 0.f, 0.f, 0.f, 0.f, 0.f, 0.f, 0.f, 0.f, 0.f, 0.f, 0.f};
#define XQK(QF, G) do { _Pragma("unroll") for (int j = 0; j < 2; ++j) _Pragma("unroll") for (int kb = 0; kb < 8; ++kb) { \
            const bf16x8 a = *(const LAS bf16x8*)(kbase + kb * 16640 + (2 * (G) + j) * 32); \
            S[kb] = __builtin_amdgcn_mfma_f32_32x32x16_bf16(a, QF[j], S[kb], 0, 0, 0); } } while (0)
#define XQL(QF, G) do { _Pragma("unroll") for (int j = 0; j < 2; ++j) QF[j] = *(const bf16x8*)(qp + (2 * (G) + j) * 16); } while (0)
    XQL(qc, 1); asm volatile("" ::: "memory"); XQK(qa, 0); asm volatile("" ::: "memory");
    XQL(qa, 2); asm volatile("" ::: "memory"); XQK(qc, 1); asm volatile("" ::: "memory");
    XQL(qc, 3); asm volatile("" ::: "memory"); XQK(qa, 2); asm volatile("" ::: "memory");
    XQL(qa, 4); asm volatile("" ::: "memory"); XQK(qc, 3); asm volatile("" ::: "memory");
    XQL(qc, 5); asm volatile("" ::: "memory"); XQK(qa, 4); asm volatile("" ::: "memory");
    XQL(qa, 6); asm volatile("" ::: "memory"); XQK(qc, 5); asm volatile("" ::: "memory");
    XQL(qc, 7); asm volatile("" ::: "memory"); XQK(qa, 6); asm volatile("" ::: "memory");
    XQK(qc, 7);
#undef XQK
#undef XQL
    float mx = S[0][0];
#pragma unroll
    for (int kb = 0; kb < 8; ++kb)
#pragma unroll
        for (int r = 0; r < 16; ++r) mx = fmaxf(mx, S[kb][r]);
    mx = fmaxf(mx, __shfl_xor(mx, 32));
    const float mo = mx * sc2; float l = 0.f;
#pragma unroll
    for (int kb = 0; kb < 8; ++kb)
#pragma unroll
        for (int r = 0; r < 16; ++r) { const float e = __builtin_amdgcn_exp2f(S[kb][r] * sc2 - mo); S[kb][r] = e; l += e; }
    l += __shfl_xor(l, 32);
    const float inv = 1.0f / l;
    bf16x8 pf[8][2];
#pragma unroll
    for (int kb = 0; kb < 8; ++kb) { pf[kb][0] = pack8(S[kb], 0); pf[kb][1] = pack8(S[kb], 8); }
    __syncthreads();
    { const bf16* vp = KVM + (size_t)b * MEMLEN * 2048 + 1024 + xh * 256 + (size_t)(16 * w + (lane >> 2)) * 2048 + 8 * (lane & 3);
#pragma unroll
      for (int i = 0; i < 16; ++i) GLDS16(vp + (size_t)(i & 1) * 128 * 2048 + (i >> 1) * 32, F.lds + (w + 8 * i) * 1024); }
    asm volatile("s_waitcnt vmcnt(0)" ::: "memory"); __syncthreads();
    bf16* orow = XO + row * D + xh * 256 + 4 * hi;
    const int vbase = (4 * hi + ((lane & 15) >> 2)) * 64 + (16 * ((lane >> 4) & 1) + 4 * (lane & 3)) * 2;
#pragma unroll
    for (int db = 0; db < 8; ++db) {
        f32x16 o = (f32x16){0.f, 0.f, 0.f, 0.f, 0.f, 0.f, 0.f, 0.f, 0.f, 0.f, 0.f, 0.f, 0.f, 0.f, 0.f, 0.f};
#pragma unroll
        for (int kb = 0; kb < 8; ++kb)
#pragma unroll
            for (int s = 0; s < 2; ++s) {
                const LAS unsigned char* vp = F.lds + db * 16384 + (32 * kb + 16 * s) * 64 + vbase;
                const s16x4 lo = ldtr(vp), hh = ldtr(vp + 8 * 64);
                const bf16x8 a = (bf16x8){lo[0], lo[1], lo[2], lo[3], hh[0], hh[1], hh[2], hh[3]};
                o = __builtin_amdgcn_mfma_f32_32x32x16_bf16(a, pf[kb][s], o, 0, 0, 0);
            }
#pragma unroll
        for (int g = 0; g < 4; ++g) { typedef unsigned u2 __attribute__((ext_vector_type(2))); u2 wv; wv.x = cvtpk(o[4 * g] * inv, o[4 * g + 1] * inv); wv.y = cvtpk(o[4 * g + 2] * inv, o[4 * g + 3] * inv);
            *(u2*)(orow + 32 * db + 8 * g) = wv; }
    }
    __syncthreads();
}
__device__ __forceinline__ void p5_xattn(Frame& F, const Args& a) {
    const bf16* QX = (const bf16*)(a.ws + WS_QX); const bf16* KVM = (const bf16*)(a.ws + WS_KVM); bf16* XO = (bf16*)(a.ws + WS_XO); const float* ssq1 = (const float*)(a.ws + WS_SSQ1);
    constexpr int NUNIT = BATCH * 4 * (SEQ / 256);
    for (int u = F.vcu; u < NUNIT; u += F.G) { const int qb = u & 7, xh = (u >> 3) & 3, b = u >> 5; xattn_unit(F, b, xh, qb, QX, ssq1, KVM, XO); }
}
__device__ __forceinline__ void swa_unit(Frame& F, int b, int hk, int n, const bf16* P, const float* sinks, bf16* MIX) {
    const int lane = F.lane, w = F.wave, r32 = lane & 31, hi = lane >> 5, wq = w & 3;
    LAS unsigned char* Kl = F.lds; LAS unsigned char* Vl = F.lds + 32768;
    const int np = n > 0 ? n - 1 : 0;
    {
        const int z = (4 * w + (lane >> 4)) & 7;
        const bf16* kp = P + (size_t)(b * SEQ + 8 * w + (lane >> 3)) * NP + O_AK + hk * 64 + (((lane & 7) ^ z) * 8);
#pragma unroll
        for (int i = 0; i < 4; ++i) GLDS16(kp + (size_t)(128 * (i < 2 ? np : n) + 64 * (i & 1)) * NP, Kl + (w + 8 * i) * 1024);
        const bf16* vp = P + (size_t)(b * SEQ + 16 * w + (lane >> 2)) * NP + O_AV + hk * 64 + 8 * (lane & 3);
#pragma unroll
        for (int i = 0; i < 4; ++i) GLDS16(vp + (size_t)(128 * ((i & 1) ? n : np)) * NP + 32 * (i >> 1), Vl + (w + 8 * i) * 1024);
    }
    const size_t row = (size_t)b * SEQ + n * 128 + wq * 32 + r32;
    bf16x8 qf[2][4];
#pragma unroll
    for (int gi = 0; gi < 2; ++gi) { const bf16* qp = P + row * NP + (hk * 4 + 2 * (w >> 2) + gi) * 64 + hi * 8;
#pragma unroll
        for (int ks = 0; ks < 4; ++ks) qf[gi][ks] = *(const bf16x8*)(qp + ks * 16); }
    asm volatile("s_waitcnt vmcnt(0)" ::: "memory"); __syncthreads();
    const int zk = (r32 >> 1) & 7;
    const LAS unsigned char* krow = Kl + (32 * wq + r32) * 128;
    const int vlane = (4 * hi + ((lane & 15) >> 2)) * 64 + (16 * ((lane >> 4) & 1) + 4 * (lane & 3)) * 2;
    const int dl = r32 - 4 * hi;
#pragma unroll
    for (int gi = 0; gi < 2; ++gi) {
        const int h = hk * 4 + 2 * (w >> 2) + gi;
        const float slope2 = exp2f(-(float)(h + 1)) * 1.4426950408889634f, sink2 = sinks[h] * 1.4426950408889634f;
        constexpr float sc = 0.125f * 1.4426950408889634f;
        f32x16 S[5];
#pragma unroll
        for (int jb = 0; jb < 5; ++jb) S[jb] = (f32x16){0.f, 0.f, 0.f, 0.f, 0.f, 0.f, 0.f, 0.f, 0.f, 0.f, 0.f, 0.f, 0.f, 0.f, 0.f, 0.f};
#pragma unroll
        for (int ks = 0; ks < 4; ++ks) { const int co = ((2 * ks + hi) ^ zk) * 16;
#pragma unroll
            for (int jb = 0; jb < 5; ++jb) { const bf16x8 a = *(const LAS bf16x8*)(krow + jb * 4096 + co); S[jb] = __builtin_amdgcn_mfma_f32_32x32x16_bf16(a, qf[gi][ks], S[jb], 0, 0, 0); } }
        int dlo = dl; float bbase = -slope2 * (float)(dl + 128);
        asm volatile("" : "+v"(dlo), "+v"(bbase));
        float mx = sink2;
#pragma unroll
        for (int jb = 0; jb < 5; ++jb) { const bool dead = (n == 0) && (wq + jb < 4);
#pragma unroll
            for (int r = 0; r < 16; ++r) { const int cr = 32 * jb + (r & 3) + 8 * (r >> 2);
                float v = __builtin_fmaf(S[jb][r], sc, __builtin_fmaf(slope2, (float)cr, bbase));
                if (jb == 0) v = (dlo >= cr) ? -1e30f : v;
                if (jb == 4) v = (dlo < cr - 128) ? -1e30f : v;
                v = dead ? -1e30f : v;
                S[jb][r] = v; mx = fmaxf(mx, v); } }
        mx = fmaxf(mx, __shfl_xor(mx, 32));
        float l = 0.f;
#pragma unroll
        for (int jb = 0; jb < 5; ++jb)
#pragma unroll
            for (int r = 0; r < 16; ++r) { const float e = __builtin_amdgcn_exp2f(S[jb][r] - mx); S[jb][r] = e; l += e; }
        l += __shfl_xor(l, 32);
        const float inv = 1.0f / (l + __builtin_amdgcn_exp2f(sink2 - mx));
        bf16x8 pf[5][2];
#pragma unroll
        for (int jb = 0; jb < 5; ++jb) { pf[jb][0] = pack8(S[jb], 0); pf[jb][1] = pack8(S[jb], 8); }
        bf16* orow = MIX + row * D + h * 64 + 4 * hi;
#pragma unroll
        for (int db = 0; db < 2; ++db) {
            f32x16 o = (f32x16){0.f, 0.f, 0.f, 0.f, 0.f, 0.f, 0.f, 0.f, 0.f, 0.f, 0.f, 0.f, 0.f, 0.f, 0.f, 0.f};
#pragma unroll
            for (int jb = 0; jb < 5; ++jb)
#pragma unroll
                for (int s = 0; s < 2; ++s) { const LAS unsigned char* vp = Vl + db * 16384 + (32 * (wq + jb) + 16 * s) * 64 + vlane;
                    const s16x4 lo = ldtr(vp), hh = ldtr(vp + 8 * 64);
                    const bf16x8 a = (bf16x8){lo[0], lo[1], lo[2], lo[3], hh[0], hh[1], hh[2], hh[3]};
                    o = __builtin_amdgcn_mfma_f32_32x32x16_bf16(a, pf[jb][s], o, 0, 0, 0); }
#pragma unroll
            for (int g4 = 0; g4 < 4; ++g4) { typedef unsigned u2 __attribute__((ext_vector_type(2))); u2 wv; wv.x = cvtpk(o[4 * g4] * inv, o[4 * g4 + 1] * inv); wv.y = cvtpk(o[4 * g4 + 2] * inv, o[4 * g4 + 3] * inv);
                *(u2*)(orow + 32 * db + 8 * g4) = wv; }
        }
        __builtin_amdgcn_sched_barrier(0);
    }
    __syncthreads();
}
namespace ml {
constexpr int QS = 0, KS = 16384, KT = 32768, VS0 = 49152, PS = 65536, GS = 73728, WS = 74752, END1 = 79872;
constexpr int Q0 = 0, Q1 = 16384, CT0 = 32768, CT1 = 32768 + 33280, END2 = 32768 + 2 * 33280 + 8192;
static_assert(END1 <= PH_LDS && END2 <= PH_LDS, "mLSTM LDS maps");
constexpr float L2E = 1.4426950408889634f;
constexpr int NCH = SEQ / 64, NCID = BATCH * 4 * NCH;
constexpr size_t WS_KL = WS_XB;
constexpr size_t WS_HL = WS_QX;
constexpr size_t WS_QG = WS_QX + 32 * MiB;
constexpr size_t WS_SM = WS_XO;
constexpr size_t WS_NL = WS_XO + 2 * MiB;
}
__device__ __forceinline__ float fast_silu(float y) { return y * __builtin_amdgcn_rcpf(1.0f + __builtin_amdgcn_exp2f(-1.4426950408889634f * y)); }
__device__ __forceinline__ float fast_sigmoid(float y) { return __builtin_amdgcn_rcpf(1.0f + __builtin_amdgcn_exp2f(-1.4426950408889634f * y)); }

__device__ __forceinline__ void mlstm_local_unit(Frame& F, int cid, const bf16* P, const float* gpre, const float* bg, const float* cw, const float* cb, unsigned char* ws) {
    using namespace ml;
    const int tid = F.tid, lane = F.lane, w = F.wave, r32 = lane & 31, hi = lane >> 5, vb = w & 3, tb = w >> 2;
    const int c = cid & (NCH - 1), bh = cid >> 5, h = bh & 3, b = bh >> 2;
    LAS unsigned char* L = F.lds;
    const int chg = tid & 31, run = tid >> 5, cc = chg & 15, t0 = 4 * run; const bool isk = chg >= 16;
    const int cch = (isk ? 512 : 0) + h * 128 + 8 * cc;
    const size_t row0 = (size_t)b * SEQ + (size_t)c * 64;
    v4u raw[7];
    { const bf16* rawp = P + O_MQ + cch;
#pragma unroll
      for (int k = 0; k < 7; ++k) { const int t = c * 64 + t0 - 3 + k; raw[k] = (t >= 0) ? *(const v4u*)(rawp + (row0 + t0 - 3 + k) * NP) : (v4u){0u, 0u, 0u, 0u}; } }
    const float gi = gpre[(row0 + lane) * 8 + h] + bg[h], gf = gpre[(row0 + lane) * 8 + 4 + h] + bg[4 + h];
    float wt[4][8], bb[8];
#pragma unroll
    for (int j = 0; j < 4; ++j) { const f32x4 a = *(const f32x4*)(cw + j * 1024 + cch), bq = *(const f32x4*)(cw + j * 1024 + cch + 4);
#pragma unroll
        for (int e = 0; e < 4; ++e) { wt[j][e] = a[e]; wt[j][4 + e] = bq[e]; } }
    { const f32x4 a = *(const f32x4*)(cb + cch), bq = *(const f32x4*)(cb + cch + 4);
#pragma unroll
      for (int e = 0; e < 4; ++e) { bb[e] = a[e]; bb[4 + e] = bq[e]; } }
    { const bf16* vsrc = P + (row0 + (lane >> 2)) * NP + O_MV + h * 128 + 8 * (lane & 3);
#pragma unroll
      for (int i = 0; i < 2; ++i) { const int p = w + 8 * i; GLDS16(vsrc + (size_t)(16 * (p & 3)) * NP + 32 * (p >> 2), L + VS0 + p * 1024); } }
    const float lf = fminf(gf, 0.f) - log1pf(__expf(-fabsf(gf)));
    float bs = lf;
#pragma unroll
    for (int o = 1; o < 64; o <<= 1) { const float v = __shfl_up(bs, o); if (lane >= o) bs += v; }
    const float u = gi - bs; float pm = u;
#pragma unroll
    for (int o = 1; o < 64; o <<= 1) { const float v = __shfl_up(pm, o); if (lane >= o) pm = fmaxf(pm, v); }
    const float pm63 = __shfl(pm, 63);
    const float wsl = __expf(u - pm63);
    if (w == 0) { LAS float* g = (LAS float*)(L + GS); g[lane] = u * L2E; g[64 + lane] = pm * L2E;
        float* sm = (float*)(ws + WS_SM) + (size_t)cid * 192; sm[64 + lane] = pm; sm[128 + lane] = bs; }
    {
        float psum[8];
#pragma unroll
        for (int e = 0; e < 8; ++e) psum[e] = 0.f;
        bf16* qg = (bf16*)(ws + WS_QG) + (size_t)cid * 8192;
#pragma unroll
        for (int i = 0; i < 4; ++i) {
            const int t = t0 + i; const float wsr = __shfl(wsl, t);
            float y[8];
#pragma unroll
            for (int e = 0; e < 8; ++e) y[e] = bb[e];
#pragma unroll
            for (int j = 0; j < 4; ++j)
#pragma unroll
                for (int q = 0; q < 4; ++q) { y[2 * q] += wt[j][2 * q] * bflo(raw[i + j][q]); y[2 * q + 1] += wt[j][2 * q + 1] * bfhi(raw[i + j][q]); }
#pragma unroll
            for (int e = 0; e < 8; ++e) y[e] = fast_silu(y[e]);
            const int sw = (cc ^ (t & 15)) * 16;
            if (!isk) { v4u o;
#pragma unroll
                for (int q = 0; q < 4; ++q) o[q] = cvtpk(y[2 * q] * 0.08838834764831845f, y[2 * q + 1] * 0.08838834764831845f);
                *(LAS v4u*)(L + QS + t * 256 + sw) = o; *(v4u*)((unsigned char*)qg + t * 256 + sw) = o;
            } else { v4u o, o2;
#pragma unroll
                for (int q = 0; q < 4; ++q) { o[q] = cvtpk(y[2 * q], y[2 * q + 1]); o2[q] = cvtpk(y[2 * q] * wsr, y[2 * q + 1] * wsr); }
#pragma unroll
                for (int e = 0; e < 8; ++e) psum[e] += y[e] * wsr;
                *(LAS v4u*)(L + KS + t * 256 + sw) = o;
                *(LAS v4u*)(L + KT + (cc >> 2) * 4096 + t * 64 + (cc & 3) * 16) = o2;
            }
        }
        if (isk) { LAS float* ps = (LAS float*)(L + PS) + run * 128 + 8 * cc; *(LAS f32x4*)ps = (f32x4){psum[0], psum[1], psum[2], psum[3]}; *(LAS f32x4*)(ps + 4) = (f32x4){psum[4], psum[5], psum[6], psum[7]}; }
    }
    asm volatile("s_waitcnt vmcnt(0)" ::: "memory"); __syncthreads();
    const int zsw = (r32 & 15);
    const int vlane = (4 * hi + ((lane & 15) >> 2)) * 64 + (16 * ((lane >> 4) & 1) + 4 * (lane & 3)) * 2;
    const LAS float* g = (const LAS float*)(L + GS);
    const int tl = 32 * tb + r32;
    const float pm2 = g[64 + tl];
    bf16x8 qf[8];
#pragma unroll
    for (int ks = 0; ks < 8; ++ks) qf[ks] = *(const LAS bf16x8*)(L + QS + tl * 256 + (((2 * ks + hi) ^ zsw) * 16));
    bf16x8 vf[4];
#pragma unroll
    for (int s4 = 0; s4 < 4; ++s4) { const LAS unsigned char* vp = L + VS0 + vb * 4096 + (16 * s4) * 64 + vlane; const s16x4 lo = ldtr(vp), hh = ldtr(vp + 8 * 64);
        vf[s4] = (bf16x8){lo[0], lo[1], lo[2], lo[3], hh[0], hh[1], hh[2], hh[3]}; }
    f32x16 o = (f32x16){0.f, 0.f, 0.f, 0.f, 0.f, 0.f, 0.f, 0.f, 0.f, 0.f, 0.f, 0.f, 0.f, 0.f, 0.f, 0.f};
    float dsum = 0.f;
#pragma unroll
    for (int sb = 0; sb < 2; ++sb) if (sb <= tb) {
        f32x16 S = (f32x16){0.f, 0.f, 0.f, 0.f, 0.f, 0.f, 0.f, 0.f, 0.f, 0.f, 0.f, 0.f, 0.f, 0.f, 0.f, 0.f};
#pragma unroll
        for (int ks = 0; ks < 8; ++ks) { const bf16x8 a = *(const LAS bf16x8*)(L + KS + (32 * sb + r32) * 256 + (((2 * ks + hi) ^ zsw) * 16)); S = __builtin_amdgcn_mfma_f32_32x32x16_bf16(a, qf[ks], S, 0, 0, 0); }
#pragma unroll
        for (int g4 = 0; g4 < 4; ++g4) { const f32x4 uu = *(const LAS f32x4*)(g + 32 * sb + 8 * g4 + 4 * hi);
#pragma unroll
            for (int e = 0; e < 4; ++e) { const int r = 4 * g4 + e; const int sl = 32 * sb + 8 * g4 + 4 * hi + e;
                const float gm = (sl <= tl) ? __builtin_amdgcn_exp2f(uu[e] - pm2) : 0.f; const float v = S[r] * gm; S[r] = v; dsum += v; } }
        o = __builtin_amdgcn_mfma_f32_32x32x16_bf16(vf[2 * sb], pack8(S, 0), o, 0, 0, 0);
        o = __builtin_amdgcn_mfma_f32_32x32x16_bf16(vf[2 * sb + 1], pack8(S, 8), o, 0, 0, 0);
    }
    dsum += __shfl_xor(dsum, 32);
    if (vb == 0 && hi == 0) ((float*)(ws + WS_SM) + (size_t)cid * 192)[tl] = dsum;
    { v4u* hp = (v4u*)((bf16*)(ws + WS_HL) + ((size_t)(cid * 8 + w) * 64 + lane) * 16);
      v4u a; a.x = cvtpk(o[0], o[1]); a.y = cvtpk(o[2], o[3]); a.z = cvtpk(o[4], o[5]); a.w = cvtpk(o[6], o[7]); hp[0] = a;
      a.x = cvtpk(o[8], o[9]); a.y = cvtpk(o[10], o[11]); a.z = cvtpk(o[12], o[13]); a.w = cvtpk(o[14], o[15]); hp[1] = a; }
#pragma unroll
    for (int i = 0; i < 2; ++i) {
        f32x16 kacc = (f32x16){0.f, 0.f, 0.f, 0.f, 0.f, 0.f, 0.f, 0.f, 0.f, 0.f, 0.f, 0.f, 0.f, 0.f, 0.f, 0.f};
#pragma unroll
        for (int s4 = 0; s4 < 4; ++s4) { const LAS unsigned char* kp = L + KT + (2 * tb + i) * 4096 + (16 * s4) * 64 + vlane; const s16x4 lo = ldtr(kp), hh = ldtr(kp + 8 * 64);
            const bf16x8 a = (bf16x8){lo[0], lo[1], lo[2], lo[3], hh[0], hh[1], hh[2], hh[3]};
            kacc = __builtin_amdgcn_mfma_f32_32x32x16_bf16(a, vf[s4], kacc, 0, 0, 0); }
        v4u* kp2 = (v4u*)((bf16*)(ws + WS_KL) + (((size_t)(cid * 8 + w) * 2 + i) * 64 + lane) * 16);
        v4u a; a.x = cvtpk(kacc[0], kacc[1]); a.y = cvtpk(kacc[2], kacc[3]); a.z = cvtpk(kacc[4], kacc[5]); a.w = cvtpk(kacc[6], kacc[7]); kp2[0] = a;
        a.x = cvtpk(kacc[8], kacc[9]); a.y = cvtpk(kacc[10], kacc[11]); a.z = cvtpk(kacc[12], kacc[13]); a.w = cvtpk(kacc[14], kacc[15]); kp2[1] = a;
    }
    if (tid < 128) { float s = 0.f; const LAS float* ps = (const LAS float*)(L + PS) + tid;
#pragma unroll
        for (int q = 0; q < 16; ++q) s += ps[q * 128];
        ((float*)(ws + WS_NL))[(size_t)cid * 128 + tid] = s; }
    __syncthreads();
}

__device__ __forceinline__ void mlstm_scan(Frame& F, int b, int h, const bf16* P, bf16* MIX, unsigned char* ws) {
    using namespace ml;
    typedef unsigned u2 __attribute__((ext_vector_type(2)));
    const int tid = F.tid, lane = F.lane, w = F.wave, r32 = lane & 31, hi = lane >> 5, vb = w & 3, tb = w >> 2;
    LAS unsigned char* L = F.lds;
    const int cid0 = (b * 4 + h) * NCH;
    for (int i = tid; i < (33280 + 8192) / 16; i += NWAVES * 64) *(LAS v4u*)(L + CT0 + 16 * i) = (v4u){0u, 0u, 0u, 0u};
    f32x16 Cacc[2];
#pragma unroll
    for (int i = 0; i < 2; ++i) Cacc[i] = (f32x16){0.f, 0.f, 0.f, 0.f, 0.f, 0.f, 0.f, 0.f, 0.f, 0.f, 0.f, 0.f, 0.f, 0.f, 0.f, 0.f};
    float nreg = 0.f, mprev = 0.f;
    const size_t rowb = (size_t)b * SEQ;
    const int zsw = (r32 & 15), tl = 32 * tb + r32;
    v4u hln[2], kln[2][2]; u2 mon[4]; float dln, pmn, bsn, nln;
#define ML_PREFETCH(cc_) do { const int cid_ = cid0 + (cc_); \
        const v4u* hp_ = (const v4u*)((const bf16*)(ws + WS_HL) + ((size_t)(cid_ * 8 + w) * 64 + lane) * 16); hln[0] = hp_[0]; hln[1] = hp_[1]; \
        _Pragma("unroll") for (int i_ = 0; i_ < 2; ++i_) { const v4u* kp_ = (const v4u*)((const bf16*)(ws + WS_KL) + (((size_t)(cid_ * 8 + w) * 2 + i_) * 64 + lane) * 16); kln[i_][0] = kp_[0]; kln[i_][1] = kp_[1]; } \
        const size_t tr_ = rowb + (size_t)(cc_) * 64 + tl; \
        _Pragma("unroll") for (int g_ = 0; g_ < 4; ++g_) mon[g_] = *(const u2*)(P + tr_ * NP + O_MO + h * 128 + 32 * vb + 8 * g_ + 4 * hi); \
        const float* sm_ = (const float*)(ws + WS_SM) + (size_t)cid_ * 192; dln = sm_[lane]; pmn = sm_[64 + lane]; bsn = sm_[128 + lane]; \
        nln = (tid < 128) ? ((const float*)(ws + WS_NL))[(size_t)cid_ * 128 + tid] : 0.f; \
        { const unsigned char* qg_ = (const unsigned char*)(ws + WS_QG) + (size_t)cid_ * 16384; \
          _Pragma("unroll") for (int i_ = 0; i_ < 2; ++i_) GLDS16(qg_ + (w + 8 * i_) * 1024 + lane * 16, L + (((cc_) & 1) ? Q1 : Q0) + (w + 8 * i_) * 1024); } } while (0)
    ML_PREFETCH(0);
    for (int c = 0; c < NCH; ++c) {
        const int par = c & 1;
        const v4u hl0 = hln[0], hl1 = hln[1]; v4u kl[2][2]; kl[0][0] = kln[0][0]; kl[0][1] = kln[0][1]; kl[1][0] = kln[1][0]; kl[1][1] = kln[1][1];
        u2 mo[4]; mo[0] = mon[0]; mo[1] = mon[1]; mo[2] = mon[2]; mo[3] = mon[3];
        const float dl = dln, pm = pmn, bs = bsn, nl = nln;
        asm volatile("s_waitcnt vmcnt(0)" ::: "memory"); __syncthreads();
        if (c + 1 < NCH) ML_PREFETCH(c + 1);
        const float Mt = fmaxf(mprev, pm);
        const float M63 = __shfl(Mt, 63), b63 = __shfl(bs, 63), pm63 = __shfl(pm, 63);
        const float wi_l = __expf(mprev - Mt), ft_l = __expf(pm - Mt), ef_l = __expf(-(bs + Mt));
        const float wi = __shfl(wi_l, tl), ft = __shfl(ft_l, tl), ef = __shfl(ef_l, tl), dlt = __shfl(dl, tl);
        const float decay = __expf(mprev - M63), f2 = __expf(pm63 - M63);
        const LAS unsigned char* Ql = L + (par ? Q1 : Q0);
        const LAS unsigned char* Cr = L + (par ? CT1 : CT0); LAS unsigned char* Cw = L + (par ? CT0 : CT1);
        bf16x8 qf[8];
#pragma unroll
        for (int ks = 0; ks < 8; ++ks) qf[ks] = *(const LAS bf16x8*)(Ql + tl * 256 + (((2 * ks + hi) ^ zsw) * 16));
        f32x16 o = (f32x16){0.f, 0.f, 0.f, 0.f, 0.f, 0.f, 0.f, 0.f, 0.f, 0.f, 0.f, 0.f, 0.f, 0.f, 0.f, 0.f};
        f32x16 on = (f32x16){0.f, 0.f, 0.f, 0.f, 0.f, 0.f, 0.f, 0.f, 0.f, 0.f, 0.f, 0.f, 0.f, 0.f, 0.f, 0.f};
#pragma unroll
        for (int ks = 0; ks < 8; ++ks) { const bf16x8 a = *(const LAS bf16x8*)(Cr + (32 * vb + r32) * 256 + (((2 * ks + hi) ^ zsw) * 16)); o = __builtin_amdgcn_mfma_f32_32x32x16_bf16(a, qf[ks], o, 0, 0, 0); }
#pragma unroll
        for (int ks = 0; ks < 8; ++ks) { const bf16x8 a = *(const LAS bf16x8*)(Cr + (128 + r32) * 256 + (2 * ks + hi) * 16); on = __builtin_amdgcn_mfma_f32_32x32x16_bf16(a, qf[ks], on, 0, 0, 0); }
        const float qn = __shfl(on[0], r32);
        const float den = wi * qn + ft * dlt;
        const float rden = 1.0f / fmaxf(fabsf(den), ef);
        { bf16* op = MIX + (rowb + (size_t)c * 64 + tl) * D + 512 + h * 128 + 32 * vb + 4 * hi;
#pragma unroll
          for (int g4 = 0; g4 < 4; ++g4) { const unsigned hw0 = g4 < 2 ? hl0[2 * g4] : hl1[2 * g4 - 4], hw1 = g4 < 2 ? hl0[2 * g4 + 1] : hl1[2 * g4 - 3];
              float x[4]; const float hv[4] = {bflo(hw0), bfhi(hw0), bflo(hw1), bfhi(hw1)};
#pragma unroll
              for (int e = 0; e < 4; ++e) { const float og = (e & 1) ? bfhi(mo[g4][e >> 1]) : bflo(mo[g4][e >> 1]); x[e] = (wi * o[4 * g4 + e] + ft * hv[e]) * rden * fast_sigmoid(og); }
              u2 wv; wv.x = cvtpk(x[0], x[1]); wv.y = cvtpk(x[2], x[3]); *(u2*)(op + 8 * g4) = wv; } }
        const int dv = 32 * vb + r32;
#pragma unroll
        for (int i = 0; i < 2; ++i) {
#pragma unroll
            for (int r = 0; r < 16; ++r) { const unsigned kw = kl[i][r >> 3][(r >> 1) & 3]; const float kv = (r & 1) ? bfhi(kw) : bflo(kw); Cacc[i][r] = decay * Cacc[i][r] + f2 * kv; }
#pragma unroll
            for (int g4 = 0; g4 < 4; ++g4) { const int ch = 4 * (2 * tb + i) + g4; u2 wv; wv.x = cvtpk(Cacc[i][4 * g4], Cacc[i][4 * g4 + 1]); wv.y = cvtpk(Cacc[i][4 * g4 + 2], Cacc[i][4 * g4 + 3]);
                *(LAS u2*)(Cw + dv * 256 + ((ch ^ (dv & 15)) * 16) + 8 * hi) = wv; }
        }
        if (tid < 128) { nreg = decay * nreg + f2 * nl; *(LAS unsigned short*)(Cw + 128 * 256 + tid * 2) = (unsigned short)f2bf(nreg); }
        mprev = b63 + M63;
    }
    __syncthreads();
#undef ML_PREFETCH
}
__device__ __forceinline__ void p2a_mix(Frame& F, const Args& a) {
    const bf16* P = (const bf16*)(a.ws + WS_P);
    for (int u = F.vcu; u < ml::NCID; u += F.G) mlstm_local_unit(F, u, P, (const float*)(a.ws + WS_GPRE), a.in[4], a.in[5], a.in[6], a.ws);
}
__device__ __forceinline__ void p2b_mix(Frame& F, const Args& a) {
    const bf16* P = (const bf16*)(a.ws + WS_P); bf16* MIX = (bf16*)(a.ws + WS_MIX);
    const int NSEQ = BATCH * 4;
    if ((int)blockIdx.x < NSEQ && F.G > NSEQ) {
        if (a.pad != 2) mlstm_scan(F, (int)blockIdx.x >> 2, (int)blockIdx.x & 3, P, MIX, a.ws);
    } else {
        const int nb = F.G > NSEQ ? F.G - NSEQ : F.G, b0 = F.G > NSEQ ? (int)blockIdx.x - NSEQ : (int)blockIdx.x;
        if (a.pad != 1) for (int u = b0; u < BATCH * 2 * 16; u += nb) swa_unit(F, u >> 5, (u >> 4) & 1, u & 15, P, a.in[7], MIX);
    }
}
__device__ __forceinline__ void p0_prologue(Frame& F, const Args& a) {
    unsigned char* ws = a.ws;
    LAS float* scr = (LAS float*)(F.lds + F.wave * 8448);
    LAS float* wgT = (LAS float*)(F.lds + 73728);
    const int gw = F.vcu * NWAVES + F.wave, NGW = F.G * NWAVES;
    {
        const float* w_in = a.in[3]; const float* gm = a.in[2];
        for (int i = F.tid; i < 8192; i += NWAVES * 64) { const int k = i >> 3, c = i & 7; wgT[c * 1024 + k] = gm[k] * w_in[(size_t)k * IN_COLS + O_G + c]; }
    }
    constexpr int I_IN = 16 * (NP / 32), I_KV = 16 * 64, I_SQ = 16 * 32, I_UP = 16 * (NU / 32), I_DN = (FF / 64) * 32;
    constexpr int NITEMS = I_IN + I_KV + 3 * I_SQ + I_UP + I_DN;
    for (int it = gw; it < NITEMS; it += NGW) {
        int r = it;
        if (r < I_IN) { const int nb = r % (NP / 32), kb = r / (NP / 32); p0_transpose_item(a.in[3], D, IN_COLS, 32 * nb, a.in[2], (bf16*)(ws + WS_WIN), 32 * nb, scr, kb, F.lane); continue; } r -= I_IN;
        if (r < I_KV) { const int nb = r % 64, kb = r / 64; p0_transpose_item(a.in[12], D, 2048, 32 * nb, a.in[10], (bf16*)(ws + WS_WKV), 32 * nb, scr, kb, F.lane); continue; } r -= I_KV;
        if (r < I_SQ) { const int nb = r % 32, kb = r / 32; p0_transpose_item(a.in[8], D, D, 32 * nb, nullptr, (bf16*)(ws + WS_WOUT), 32 * nb, scr, kb, F.lane); continue; } r -= I_SQ;
        if (r < I_SQ) { const int nb = r % 32, kb = r / 32; p0_transpose_item(a.in[11], D, D, 32 * nb, a.in[9], (bf16*)(ws + WS_WQ), 32 * nb, scr, kb, F.lane); continue; } r -= I_SQ;
        if (r < I_SQ) { const int nb = r % 32, kb = r / 32; p0_transpose_item(a.in[13], D, D, 32 * nb, nullptr, (bf16*)(ws + WS_WO), 32 * nb, scr, kb, F.lane); continue; } r -= I_SQ;
        if (r < I_UP) { const int nb = r % (NU / 32), kb = r / (NU / 32); const int c0 = 32 * nb < FF ? 32 * nb : 32 * nb - FF, dr = (c0 >> 7) * 256 + (32 * nb < FF ? 0 : 128) + (c0 & 127);
            p0_transpose_item(a.in[15], D, NU, 32 * nb, a.in[14], (bf16*)(ws + WS_WUP), dr, scr, kb, F.lane); continue; } r -= I_UP;
        { const int nb = r % 32, kb = r / 32; p0_transpose_item(a.in[18], FF, D, 32 * nb, nullptr, (bf16*)(ws + WS_WDN), 32 * nb, scr, kb, F.lane); }
    }
    __syncthreads();
    float* rstd0 = (float*)(ws + WS_RSTD0); float* gpre = (float*)(ws + WS_GPRE); bf16* XB = (bf16*)(ws + WS_XB);
    for (int m = gw; m < M; m += 2 * NGW) {
        f32x4 va[4], vc[4];
        row_load(a.in[0] + (size_t)m * D, F.lane, va); row_load(a.in[0] + (size_t)(m + NGW) * D, F.lane, vc);
#pragma unroll
        for (int hlf = 0; hlf < 2; ++hlf) {
            const int mm = m + hlf * NGW; const f32x4 (&v)[4] = hlf ? vc : va;
            const float ssq = row_to_bf16(XB + (size_t)mm * D, F.lane, v);
            const float rstd = 1.0f / sqrtf(ssq * (1.0f / D) + EPS);
            float ga[8];
#pragma unroll
            for (int c = 0; c < 8; ++c) { float s = 0.f;
#pragma unroll
                for (int j = 0; j < 4; ++j) { const f32x4 w = *(const LAS f32x4*)(wgT + c * 1024 + 256 * j + 4 * F.lane); s += (v[j][0] * w[0] + v[j][1] * w[1]) + (v[j][2] * w[2] + v[j][3] * w[3]); }
                ga[c] = wave_sum(s) * rstd; }
            if (F.lane == 0) { rstd0[mm] = rstd; *(f32x4*)(gpre + (size_t)mm * 8) = (f32x4){ga[0], ga[1], ga[2], ga[3]}; *(f32x4*)(gpre + (size_t)mm * 8 + 4) = (f32x4){ga[4], ga[5], ga[6], ga[7]}; }
        }
    }
    float* rstdm = (float*)(ws + WS_RSTDM); bf16* MEMB = (bf16*)(ws + WS_MEMB);
    for (int m = gw; m < MMEM; m += NGW) {
        f32x4 v[4];
        row_load(a.in[1] + (size_t)m * D, F.lane, v);
        const float ssq = row_to_bf16(MEMB + (size_t)m * D, F.lane, v);
        if (F.lane == 0) rstdm[m] = 1.0f / sqrtf(ssq * (1.0f / D) + EPS);
    }
}
__device__ __forceinline__ void act_fixup_panel(Frame& F, const Args& a, int pm) {
    bf16* ACT = (bf16*)(a.ws + WS_ACT); const float* SB = (const float*)(a.ws + WS_SB); const float* cw = a.in[16]; const float* cb = a.in[17];
    for (int it = F.tid; it < 4 * (FF / 4); it += NWAVES * 64) {
        const int gl = it / (FF / 4), ch = 4 * (it % (FF / 4)), gid = 4 * pm + gl;
        const float* s = SB + (size_t)gid * 6 * FF + ch;
        const f32x4 w0 = *(const f32x4*)(cw + ch), w1 = *(const f32x4*)(cw + FF + ch), w2 = *(const f32x4*)(cw + 2 * FF + ch), bb = *(const f32x4*)(cb + ch);
        f32x4 gm2 = (f32x4){0.f, 0.f, 0.f, 0.f}, gm1 = gm2;
        if ((gid & 31) != 0) { gm2 = *(const f32x4*)(s - 6 * FF); gm1 = *(const f32x4*)(s - 5 * FF); }
        const f32x4 g0 = *(const f32x4*)(s + 2 * FF), g1 = *(const f32x4*)(s + 3 * FF), v0 = *(const f32x4*)(s + 4 * FF), v1 = *(const f32x4*)(s + 5 * FF);
        float r0[4], r1[4];
#pragma unroll
        for (int e = 0; e < 4; ++e) { const float y0 = w2[e] * g0[e] + w1[e] * gm1[e] + w0[e] * gm2[e] + bb[e], y1 = w2[e] * g1[e] + w1[e] * g0[e] + w0[e] * gm1[e] + bb[e];
            r0[e] = y0 * __builtin_amdgcn_rcpf(1.0f + __builtin_amdgcn_exp2f(-1.4426950408889634f * y0)) * v0[e]; r1[e] = y1 * __builtin_amdgcn_rcpf(1.0f + __builtin_amdgcn_exp2f(-1.4426950408889634f * y1)) * v1[e]; }
        typedef unsigned u2 __attribute__((ext_vector_type(2)));
        u2 o0, o1; o0.x = pk2(r0[0], r0[1]); o0.y = pk2(r0[2], r0[3]); o1.x = pk2(r1[0], r1[1]); o1.y = pk2(r1[2], r1[3]);
        *(u2*)(ACT + (size_t)(64 * gid) * FF + ch) = o0; *(u2*)(ACT + (size_t)(64 * gid + 1) * FF + ch) = o1;
    }
}
__device__ __forceinline__ void p10_final(Frame& F, const Args& a) {
    const int gw = F.vcu * NWAVES + F.wave, NGW = F.G * NWAVES;
    const float* gf = a.in[19]; const pg8::RsParts rs{(const float*)(a.ws + WS_SSQ3)};
    f32x4 gv[4];
#pragma unroll
    for (int j = 0; j < 4; ++j) gv[j] = ((const f32x4*)gf)[64 * j + F.lane];
    for (int m = gw; m < M; m += NGW) {
        const float r = rs.get(m);
        GAS f32x4* xr = (GAS f32x4*)(a.out + (size_t)m * D) + F.lane;
#pragma unroll
        for (int j = 0; j < 4; ++j) { const f32x4 v = xr[64 * j]; xr[64 * j] = v * r * gv[j]; }
    }
}

#ifndef PROBE_REP
#define PROBE_REP (-1)
#endif
#ifndef PROBE_SUB
#define PROBE_SUB 0
#endif
#ifndef PG8_SP2
#define PG8_SP2 true
#endif
#ifndef PG8_ALIGN
#define PG8_ALIGN true
#endif
enum { PH_PRO = 0, PH_G1 = 1, PH_MIXA = 2, PH_MIXB = 3, PH_G2 = 4, PH_G3 = 5, PH_XAT = 6, PH_G4 = 7, PH_G5 = 8, PH_G6 = 9, PH_FIN = 10, PH_N = 11 };

__device__ __forceinline__ bool phase_in(Frame& F, int lo, int hi, int k) {
    if (!(lo <= k && k < hi)) return false;
    int t_ = threadIdx.x; asm volatile("" : "+v"(t_)); F.tid = t_; F.lane = t_ & 63; return true;
}
__global__ void __launch_bounds__(NWAVES * 64, 2) mk_fwd(Args args) {
    extern __shared__ __attribute__((aligned(16))) unsigned char lds[];
    Frame F;
    F.lds = (LAS unsigned char*)lds;
    F.MISC = (volatile LAS unsigned*)(F.lds + MISC_OFF);
    F.tid = threadIdx.x; F.lane = F.tid & 63; F.wave = __builtin_amdgcn_readfirstlane(F.tid >> 6);
    F.G = gridDim.x; { const int bx = blockIdx.x; F.vcu = (F.G % 8 == 0) ? (bx % 8) * (F.G / 8) + bx / 8 : bx; }
    unsigned char* ws = args.ws;
    F.ctl = (gu32*)(ws + WS_CTL);
    for (int u = F.tid; u < (LDS_BYTES - LDSCTL_OFF) / 4; u += NWAVES * 64) ((LAS unsigned*)(F.lds + LDSCTL_OFF))[u] = 0u;
    __syncthreads();
    const int lo = args.ph_lo, hi = args.ph_hi;
    XcdBarrier bar = xcd_barrier_post((unsigned*)(F.ctl + CW_BAR) + args.li * XCD_BAR_WORDS, F.MISC + 8);
#define IN(k) (phase_in(F, lo, hi, (k)))
#define SEAM(k) do { if (lo <= (k) && (k) + 1 < hi) xcd_barrier(bar); } while (0)
    bf16* XB = (bf16*)(ws + WS_XB); bf16* P = (bf16*)(ws + WS_P); bf16* MIX = (bf16*)(ws + WS_MIX); bf16* QX = (bf16*)(ws + WS_QX); bf16* XO = (bf16*)(ws + WS_XO);
    const int G = F.G, bx = (int)blockIdx.x;

    if (IN(PH_PRO)) { p0_prologue(F, args); SEAM(PH_PRO); }
    if (IN(PH_G1)) {
        { pg8::Gemm g{XB, D, (const bf16*)(ws + WS_WIN), M, NP, D}; pg8::StaticOrder S; S.init(M, NP, G, bx);
          pg8::EpiScaleBf16<pg8::RsArr> E{P, NP, {(const float*)(ws + WS_RSTD0)}};
          pg8::gemm_phase<pg8::EpiScaleBf16<pg8::RsArr>, pg8::StaticOrder, PG8_ALIGN, PG8_SP2>(F.lds + RING_OFF, g, S, E); }
        { pg8::Gemm g{(const bf16*)(ws + WS_MEMB), D, (const bf16*)(ws + WS_WKV), MMEM, 2048, D}; pg8::StaticOrder S; S.init(MMEM, 2048, G, (bx + G / 2) % G);
          pg8::EpiScaleBf16<pg8::RsArr> E{(bf16*)(ws + WS_KVM), 2048, {(const float*)(ws + WS_RSTDM)}};
          pg8::gemm_phase<pg8::EpiScaleBf16<pg8::RsArr>, pg8::StaticOrder, PG8_ALIGN, PG8_SP2>(F.lds + RING_OFF, g, S, E); }
        SEAM(PH_G1);
    }
    if (IN(PH_MIXA)) { p2a_mix(F, args); SEAM(PH_MIXA); }
    if (IN(PH_MIXB)) { p2b_mix(F, args); SEAM(PH_MIXB); }
    if (IN(PH_G2)) {
        pg8::Gemm g{MIX, D, (const bf16*)(ws + WS_WOUT), M, D, D}; pg8::StaticOrder S; S.init(M, D, G, bx);
        pg8::EpiResid<true> E{args.in[0], args.out, XB, (float*)(ws + WS_SSQ1), D};
        pg8::gemm_phase<pg8::EpiResid<true>, pg8::StaticOrder, PG8_ALIGN, PG8_SP2>(F.lds + RING_OFF, g, S, E);
        SEAM(PH_G2);
    }
    if (IN(PH_G3)) {
        pg8::Gemm g{XB, D, (const bf16*)(ws + WS_WQ), M, D, D}; pg8::StaticOrder S; S.init(M, D, G, bx);
        pg8::EpiScaleBf16<pg8::RsOne> E{QX, D, {}};
        pg8::gemm_phase<pg8::EpiScaleBf16<pg8::RsOne>, pg8::StaticOrder, PG8_ALIGN, PG8_SP2>(F.lds + RING_OFF, g, S, E);
        SEAM(PH_G3);
    }
    if (IN(PH_XAT)) { p5_xattn(F, args); SEAM(PH_XAT); }
    if (IN(PH_G4)) {
        pg8::Gemm g{XO, D, (const bf16*)(ws + WS_WO), M, D, D}; pg8::StaticOrder S; S.init(M, D, G, bx);
        pg8::EpiResid<true> E{args.out, args.out, XB, (float*)(ws + WS_SSQ2), D};
        pg8::gemm_phase<pg8::EpiResid<true>, pg8::StaticOrder, PG8_ALIGN, PG8_SP2>(F.lds + RING_OFF, g, S, E);
        SEAM(PH_G4);
    }
    if (IN(PH_G5)) {
        pg8::Gemm g{XB, D, (const bf16*)(ws + WS_WUP), M, NU, D}; pg8::StaticOrder S; S.init(M, NU, G, bx);
        pg8::EpiGateConv E{(bf16*)(ws + WS_ACT), {(const float*)(ws + WS_SSQ2)}, args.in[16], args.in[17], (float*)(ws + WS_SB)};
        pg8::gemm_phase<pg8::EpiGateConv, pg8::StaticOrder, PG8_ALIGN, PG8_SP2>(F.lds + RING_OFF, g, S, E);
        SEAM(PH_G5);
    }
    if (IN(PH_G6)) {
        pg8::Gemm g{(const bf16*)(ws + WS_ACT), FF, (const bf16*)(ws + WS_WDN), M, D, FF}; pg8::StaticOrder S; S.init(M, D, G, bx);
        { pg8::Unit uu; int last = -1; for (int i = 0; S.next(i, uu); ++i) if (uu.pm != last) { act_fixup_panel(F, args, uu.pm); last = uu.pm; }
          asm volatile("s_waitcnt vmcnt(0)" ::: "memory"); __syncthreads(); if (F.tid == 0) { __builtin_amdgcn_fence(__ATOMIC_ACQUIRE, "agent"); asm volatile("s_waitcnt vmcnt(0)" ::: "memory"); } __syncthreads(); }
        pg8::EpiResid<false> E{args.out, args.out, nullptr, (float*)(ws + WS_SSQ3), D};
        pg8::gemm_phase<pg8::EpiResid<false>, pg8::StaticOrder, PG8_ALIGN, PG8_SP2>(F.lds + RING_OFF, g, S, E);
        SEAM(PH_G6);
    }
    if (IN(PH_FIN)) { p10_final(F, args); }
#undef IN
#undef SEAM
}
extern "C" void kernel_launch(void* const* d_in, const int* in_sizes, int n_in, void* d_out, int out_size, void* d_ws, size_t ws_size, hipStream_t stream) {
    static int grid = 0;
    if (grid == 0) {
        if (n_in != 20 || in_sizes[0] != M * D || out_size != M * D || ws_size < WS_END) { fprintf(stderr, "kernel_launch: shape/workspace mismatch: n_in %d in0 %d out %d ws %zu (need %zu)\n", n_in, n_in > 0 ? in_sizes[0] : -1, out_size, ws_size, (size_t)WS_END); grid = -1; return; }
        int dev = 0, cus = 0, per_cu = 0;
        if (hipGetDevice(&dev) != hipSuccess || hipDeviceGetAttribute(&cus, hipDeviceAttributeMultiprocessorCount, dev) != hipSuccess) { fprintf(stderr, "kernel_launch: device query failed\n"); grid = -1; return; }
        if (hipFuncSetAttribute((const void*)mk_fwd, hipFuncAttributeMaxDynamicSharedMemorySize, LDS_BYTES) != hipSuccess) { fprintf(stderr, "kernel_launch: hipFuncSetAttribute failed\n"); grid = -1; return; }
        if (hipOccupancyMaxActiveBlocksPerMultiprocessor(&per_cu, (const void*)mk_fwd, NWAVES * 64, LDS_BYTES) != hipSuccess || per_cu < 1) { fprintf(stderr, "kernel_launch: occupancy query reports %d workgroups per CU\n", per_cu); (void)hipGetLastError(); grid = -1; return; }
        grid = cus;
    }
    if (grid < 0) return;
    (void)hipMemsetAsync((char*)d_ws + WS_CTL, 0, CTL_ZERO_BYTES, stream);
    Args a{};
    for (int i = 0; i < 20; ++i) a.in[i] = (const float*)d_in[i];
    a.out = (float*)d_out; a.ws = (unsigned char*)d_ws;
    unsigned char* ws = (unsigned char*)d_ws;
    auto launch = [&](int lo, int hi, int li) { a.ph_lo = lo; a.ph_hi = hi; a.li = li; hipLaunchKernelGGL(mk_fwd, dim3(grid), dim3(NWAVES * 64), LDS_BYTES, stream, a); };
#if PROBE_REP >= 0
    a.pad = PROBE_SUB; launch(PH_PRO, PROBE_REP + 1, 0); a.pad = 0; launch(PROBE_REP, PH_N, 1);
#else
    launch(PH_PRO, PH_N, 0);
#endif
}
```

```cpp
#include <hip/hip_runtime.h>
#include <cstdio>
#include <cstdint>
namespace pg8 {
#define PG8_LAS __attribute__((address_space(3)))
typedef unsigned short bf16_t;
typedef short bf16x8 __attribute__((ext_vector_type(8)));
typedef float f32x4 __attribute__((ext_vector_type(4)));
typedef unsigned u32x4 __attribute__((ext_vector_type(4)));
constexpr int BM = 256, BK = 64, HALF = 128, HTB = HALF * BK * 2  , STAGE_BYTES = 8 * HTB, NXCD = 8, WGM = 8;

__host__ __device__ __forceinline__ int lds_byte(int r, int c) { const int st = (r >> 4) * 2 + (c >> 5), rr = r & 15, cc = c & 31, ob = rr * 64 + cc * 2; return st * 1024 + (ob ^ (((ob >> 9) & 1) << 5)); }
__host__ __device__ __forceinline__ void stage_rc(int b, int& R, int& C) { const int st = b / 1024, sb = b % 1024, swz = sb ^ (((sb >> 9) & 1) << 5); R = (st >> 1) * 16 + swz / 64; C = (st & 1) * 32 + (swz % 64) / 2; }
__host__ __device__ __forceinline__ int perm32(int rho) { const int n = rho >> 4, i = rho & 15; return 8 * (i >> 2) + 4 * n + (i & 3); }

struct Unit { int pm, pn; };
struct Gemm { const bf16_t* A; int lda; const bf16_t* Bt; int M, N, K; };

struct StaticOrder {
    int nM, nN, nwg, G, c;
    __host__ __device__ void init(int M, int N, int G_, int c_) { nM = M / BM; nN = N / BM; nwg = nM * nN; G = G_; c = c_; }
    __host__ __device__ bool next(int i, Unit& u) const {
        const long L = (long)i * G + c; if (L >= nwg) return false;
        int wgid = (int)L; { const int q = nwg / NXCD, r = nwg % NXCD, xcd = wgid % NXCD, off = wgid / NXCD; wgid = (xcd < r ? xcd * (q + 1) : r * (q + 1) + (xcd - r) * q) + off; }
        const int nig = WGM * nN, gid = wgid / nig, fm = gid * WGM, gsz = (nM - fm) < WGM ? (nM - fm) : WGM;
        u.pm = fm + ((wgid % nig) % gsz); u.pn = (wgid % nig) / gsz; return true;
    }
    __device__ __forceinline__ void a_ready(const Unit&) const {}
    __device__ __forceinline__ void done(const Unit&) const {}
};

__device__ __forceinline__ unsigned cvt_pk_bf16(float lo, float hi) { unsigned r; asm volatile("v_cvt_pk_bf16_f32 %0, %1, %2" : "=v"(r) : "v"(lo), "v"(hi)); return r; }
typedef float f32x2 __attribute__((ext_vector_type(2)));
constexpr float RMS_EPS = 1e-6f;
struct RsOne   { __device__ __forceinline__ float get(int) const { return 1.0f; } };
struct RsArr   { const float* r; __device__ __forceinline__ float get(int row) const { return r[row]; } };
struct RsParts { const float* p;
    __device__ __forceinline__ float get(int row) const { const f32x4* q = (const f32x4*)(p + (size_t)row * 16); const f32x4 a = q[0], b = q[1], c = q[2], d = q[3];
        const float s = ((a[0] + a[1]) + (a[2] + a[3])) + ((b[0] + b[1]) + (b[2] + b[3])) + ((c[0] + c[1]) + (c[2] + c[3])) + ((d[0] + d[1]) + (d[2] + d[3]));
        return 1.0f / sqrtf(s * (1.0f / 1024.0f) + RMS_EPS); } };
template <class RS> struct EpiScaleBf16 {
    static constexpr bool PERM = true, AFTER_DRAIN = false;
    bf16_t* O; int ldc; RS rs;
    __device__ __forceinline__ void operator()(const f32x4 (&acc)[2][2][4][2], const Unit& u, int wr, int wc, int fr, int fq) const {
        const int row0 = u.pm * BM + wr * 64 + fr, col0 = u.pn * BM + wc * 32 + 8 * fq;
#pragma unroll
        for (int ai = 0; ai < 2; ++ai)
#pragma unroll
            for (int m = 0; m < 4; ++m) { const int row = row0 + ai * HALF + m * 16; const float sc = rs.get(row); bf16_t* rowp = O + (size_t)row * ldc + col0;
#pragma unroll
                for (int bj = 0; bj < 2; ++bj) { const f32x4 v0 = acc[ai][bj][m][0] * sc, v1 = acc[ai][bj][m][1] * sc;
                    u32x4 w; w.x = cvt_pk_bf16(v0[0], v0[1]); w.y = cvt_pk_bf16(v0[2], v0[3]); w.z = cvt_pk_bf16(v1[0], v1[1]); w.w = cvt_pk_bf16(v1[2], v1[3]);
                    *(u32x4*)(rowp + bj * HALF) = w; } }
    }
};
template <int MODE> struct EpiResid {
    static constexpr bool PERM = true, AFTER_DRAIN = false;
    bf16_t* xb; const float* resf; float* out; float* ssq; int ldc;
    __device__ __forceinline__ void operator()(const f32x4 (&acc)[2][2][4][2], const Unit& u, int wr, int wc, int fr, int fq) const {
        const int row0 = u.pm * BM + wr * 64 + fr, col0 = u.pn * BM + wc * 32 + 8 * fq;
#pragma unroll
        for (int ai = 0; ai < 2; ++ai)
#pragma unroll
          for (int mh = 0; mh < (MODE == 1 ? 2 : 1); ++mh) {
            constexpr int MR = (MODE == 1 ? 2 : 4);
            f32x4 pre[MR][2][2];
#pragma unroll
            for (int mm = 0; mm < MR; ++mm) { const size_t off = (size_t)(row0 + ai * HALF + (mh * MR + mm) * 16) * ldc + col0;
#pragma unroll
                for (int bj = 0; bj < 2; ++bj) {
                    if (MODE == 1) { pre[mm][bj][0] = *(const f32x4*)(resf + off + bj * HALF); pre[mm][bj][1] = *(const f32x4*)(resf + off + bj * HALF + 4); }
                    else { const u32x4 p = *(const u32x4*)(xb + off + bj * HALF);
#pragma unroll
                        for (int e = 0; e < 2; ++e) { pre[mm][bj][0][2 * e] = __builtin_bit_cast(float, p[e] << 16); pre[mm][bj][0][2 * e + 1] = __builtin_bit_cast(float, p[e] & 0xffff0000u);
                            pre[mm][bj][1][2 * e] = __builtin_bit_cast(float, p[2 + e] << 16); pre[mm][bj][1][2 * e + 1] = __builtin_bit_cast(float, p[2 + e] & 0xffff0000u); } } } }
#pragma unroll
            for (int mm = 0; mm < MR; ++mm) { const int m = mh * MR + mm, row = row0 + ai * HALF + m * 16; const size_t off = (size_t)row * ldc + col0; float ss = 0.f;
#pragma unroll
                for (int bj = 0; bj < 2; ++bj) { const f32x4 o0 = pre[mm][bj][0] + acc[ai][bj][m][0], o1 = pre[mm][bj][1] + acc[ai][bj][m][1];
                    ss += ((o0[0] * o0[0] + o0[1] * o0[1]) + (o0[2] * o0[2] + o0[3] * o0[3])) + ((o1[0] * o1[0] + o1[1] * o1[1]) + (o1[2] * o1[2] + o1[3] * o1[3]));
                    if (MODE == 2) { *(f32x4*)(out + off + bj * HALF) = o0; *(f32x4*)(out + off + bj * HALF + 4) = o1; }
                    else { u32x4 w; w.x = cvt_pk_bf16(o0[0], o0[1]); w.y = cvt_pk_bf16(o0[2], o0[3]); w.z = cvt_pk_bf16(o1[0], o1[1]); w.w = cvt_pk_bf16(o1[2], o1[3]); *(u32x4*)(xb + off + bj * HALF) = w; } }
                ss += __shfl_xor(ss, 16); ss += __shfl_xor(ss, 32);
                if (fq == 0) ssq[(size_t)row * 16 + u.pn * 4 + wc] = ss; }
            asm volatile("" ::: "memory");
          }
    }
};
__device__ __forceinline__ float dpp_shr1(float cur, float prv) {
    const int t = __builtin_amdgcn_update_dpp(0, __builtin_bit_cast(int, prv), 0x121, 0xf, 0xf, false);
    return __builtin_bit_cast(float, __builtin_amdgcn_update_dpp(t, __builtin_bit_cast(int, cur), 0x111, 0xf, 0xf, false)); }
__device__ __forceinline__ float dpp_shr2(float cur, float prv) {
    const int t = __builtin_amdgcn_update_dpp(0, __builtin_bit_cast(int, prv), 0x122, 0xf, 0xf, false);
    return __builtin_bit_cast(float, __builtin_amdgcn_update_dpp(t, __builtin_bit_cast(int, cur), 0x112, 0xf, 0xf, false)); }
struct EpiGateConv {
    static constexpr bool PERM = true, AFTER_DRAIN = false;
    static constexpr int FFD = 2816;
    bf16_t* ACT; RsParts rs; const float* cw; const float* cb; float* SB;
    __device__ __forceinline__ void operator()(const f32x4 (&acc)[2][2][4][2], const Unit& u, int wr, int wc, int fr, int fq) const {
        const int ch0 = 128 * u.pn + 32 * wc + 8 * fq;
        f32x4 w0[2], w1[2], w2[2], bb[2];
#pragma unroll
        for (int n = 0; n < 2; ++n) { w0[n] = *(const f32x4*)(cw + ch0 + 4 * n); w1[n] = *(const f32x4*)(cw + FFD + ch0 + 4 * n); w2[n] = *(const f32x4*)(cw + 2 * FFD + ch0 + 4 * n); bb[n] = *(const f32x4*)(cb + ch0 + 4 * n); }
#pragma unroll
        for (int ai = 0; ai < 2; ++ai) {
            f32x4 Gp[2] = {(f32x4){0.f, 0.f, 0.f, 0.f}, (f32x4){0.f, 0.f, 0.f, 0.f}};
            const int grow = u.pm * BM + ai * HALF + wr * 64, grp = grow >> 6;
#pragma unroll
            for (int m = 0; m < 4; ++m) {
                const int row = grow + m * 16 + fr; const float sc = rs.get(row);
                f32x4 G[2], V[2]; u32x4 w;
#pragma unroll
                for (int n = 0; n < 2; ++n) { G[n] = acc[ai][0][m][n] * sc; V[n] = acc[ai][1][m][n] * sc; }
#pragma unroll
                for (int n = 0; n < 2; ++n) { float a[4];
#pragma unroll
                    for (int e = 0; e < 4; ++e) { const float g1 = dpp_shr1(G[n][e], Gp[n][e]), g2 = dpp_shr2(G[n][e], Gp[n][e]);
                        const float y = __builtin_fmaf(w2[n][e], G[n][e], __builtin_fmaf(w1[n][e], g1, __builtin_fmaf(w0[n][e], g2, bb[n][e])));
                        a[e] = y * __builtin_amdgcn_rcpf(1.0f + __builtin_amdgcn_exp2f(-1.4426950408889634f * y)) * V[n][e]; }
                    w[2 * n] = cvt_pk_bf16(a[0], a[1]); w[2 * n + 1] = cvt_pk_bf16(a[2], a[3]); }
                if (!(m == 0 && fr < 2)) *(u32x4*)(ACT + (size_t)row * FFD + ch0) = w;
                if (m == 0 && fr < 2) { float* sb = SB + ((size_t)grp * 6 + 2 + fr) * FFD + ch0; *(f32x4*)sb = G[0]; *(f32x4*)(sb + 4) = G[1]; sb += 2 * FFD; *(f32x4*)sb = V[0]; *(f32x4*)(sb + 4) = V[1]; }
                if (m == 3 && fr >= 14) { float* sb = SB + ((size_t)grp * 6 + (fr - 14)) * FFD + ch0; *(f32x4*)sb = G[0]; *(f32x4*)(sb + 4) = G[1]; }
                Gp[0] = G[0]; Gp[1] = G[1];
            }
        }
    }
};
template <class Epi, class Sched, bool ALIGN_EPI = false, bool SP2 = false>
__device__ __forceinline__ void gemm_phase(PG8_LAS unsigned char* lds, const Gemm g, const Sched& S, const Epi& E) {
    const int tid = threadIdx.x, wid = __builtin_amdgcn_readfirstlane(tid >> 6), lane = tid & 63, wr = wid >> 2, wc = wid & 3, fr = lane & 15, fq = lane >> 4;
    const int K = g.K, nt = K / BK;
    unsigned voffA[2], voffB[2];
#pragma unroll
    for (int i = 0; i < 2; ++i) { int R, C; stage_rc(tid * 16 + i * 8192, R, C); const int Rb = Epi::PERM ? ((R & ~31) + perm32(R & 31)) : R;
        voffA[i] = (unsigned)(R * g.lda + C) * 2u; voffB[i] = (unsigned)(Rb * K + C) * 2u; }
    const size_t kstep = (size_t)(BK * 2);
    const size_t hstepA = (size_t)HALF * g.lda * 2, hstepB = (size_t)HALF * K * 2;
    const size_t tstepA = 2 * hstepA, tstepB = 2 * hstepB;
    const unsigned ldsw = (unsigned)wid * 1024u;
    const int aoff = lds_byte(wr * 64 + fr, fq * 8), boff = lds_byte(wc * 32 + fr, fq * 8);
#define PG8_SA(b, h) (((b) * 2 + (h)) * HTB)
#define PG8_SB(b, h) ((4 + (b) * 2 + (h)) * HTB)
#define PG8_STAGE(bufoff, gbase, voff) do { _Pragma("unroll") for (int _i = 0; _i < 2; ++_i) \
        __builtin_amdgcn_global_load_lds((const unsigned*)((const char*)(gbase) + (voff)[_i]), (PG8_LAS unsigned*)(lds + (bufoff) + ldsw + _i * 8192), 16, 0, 0); } while (0)
#define PG8_LDA(dst, b, h) do { _Pragma("unroll") for (int m = 0; m < 4; ++m) _Pragma("unroll") for (int k = 0; k < 2; ++k) dst[m][k] = *(const PG8_LAS bf16x8*)(lds + PG8_SA(b, h) + aoff + m * 2048 + k * 1024); } while (0)
#define PG8_LDB(dst, b, h) do { _Pragma("unroll") for (int n = 0; n < 2; ++n) _Pragma("unroll") for (int k = 0; k < 2; ++k) dst[n][k] = *(const PG8_LAS bf16x8*)(lds + PG8_SB(b, h) + boff + n * 2048 + k * 1024); } while (0)
#define PG8_MMA(ai, bj, At, Bt) do { __builtin_amdgcn_s_setprio(1); _Pragma("unroll") for (int m = 0; m < 4; ++m) _Pragma("unroll") for (int n = 0; n < 2; ++n) _Pragma("unroll") for (int k = 0; k < 2; ++k) \
        acc[ai][bj][m][n] = __builtin_amdgcn_mfma_f32_16x16x32_bf16(Bt[n][k], At[m][k], acc[ai][bj][m][n], 0, 0, 0); __builtin_amdgcn_s_setprio(0); } while (0)
#define PG8_WAIT_V(n) asm volatile("s_waitcnt vmcnt(" #n ")" ::: "memory")
#define PG8_WAIT_L(n) asm volatile("s_waitcnt lgkmcnt(" #n ")" ::: "memory")
#define PG8_BAR __builtin_amdgcn_s_barrier()
#define PG8_SCHED __builtin_amdgcn_sched_barrier(0)
    Unit cur, nxt; int ui = 0;
    if (!S.next(0, cur)) return;
    f32x4 acc[2][2][4][2];
#pragma unroll
    for (int a = 0; a < 2; ++a)
#pragma unroll
        for (int b = 0; b < 2; ++b)
#pragma unroll
            for (int m = 0; m < 4; ++m)
#pragma unroll
                for (int n = 0; n < 2; ++n) acc[a][b][m][n] = (f32x4){0.f, 0.f, 0.f, 0.f};
    bf16x8 At[4][2], B0[2][2], B1[2][2];
    const char* cA = (const char*)g.A + (size_t)cur.pm * tstepA; const char* cB = (const char*)g.Bt + (size_t)cur.pn * tstepB;
    S.a_ready(cur);
    if constexpr (SP2) {
        PG8_STAGE(PG8_SB(0, 0), cB, voffB); PG8_STAGE(PG8_SB(0, 1), cB + hstepB, voffB); PG8_STAGE(PG8_SA(0, 0), cA, voffA); PG8_STAGE(PG8_SA(0, 1), cA + hstepA, voffA);
        if (wr == 1) PG8_BAR;
        PG8_WAIT_V(2); PG8_BAR;
        PG8_STAGE(PG8_SB(1, 0), cB + kstep, voffB); PG8_STAGE(PG8_SA(1, 0), cA + kstep, voffA); PG8_STAGE(PG8_SB(1, 1), cB + hstepB + kstep, voffB);
        PG8_WAIT_V(6); PG8_BAR;
    } else {
        PG8_STAGE(PG8_SB(0, 0), cB, voffB); PG8_STAGE(PG8_SA(0, 0), cA, voffA); PG8_STAGE(PG8_SB(0, 1), cB + hstepB, voffB); PG8_STAGE(PG8_SA(0, 1), cA + hstepA, voffA);
        if (wr == 1) PG8_BAR;
        PG8_WAIT_V(4); PG8_BAR;
        PG8_STAGE(PG8_SB(1, 0), cB + kstep, voffB); PG8_STAGE(PG8_SA(1, 0), cA + kstep, voffA); PG8_STAGE(PG8_SB(1, 1), cB + hstepB + kstep, voffB);
        PG8_WAIT_V(6); PG8_BAR;
    }
    for (;;) {
        const bool has_next = S.next(ui + 1, nxt);
        const char* nA = has_next ? (const char*)g.A + (size_t)nxt.pm * tstepA : cA; const char* nB = has_next ? (const char*)g.Bt + (size_t)nxt.pn * tstepB : cB;
        for (int t = 0; t < nt; t += 2) {
            const bool last = (t == nt - 2);
            const char* a1 = cA + (size_t)(t + 1) * kstep;
            const char* a2 = last ? nA : cA + (size_t)(t + 2) * kstep; const char* b2 = last ? nB : cB + (size_t)(t + 2) * kstep;
            const char* a3 = a2 + kstep; const char* b3 = b2 + kstep;
            if (last && has_next) S.a_ready(nxt);
            if constexpr (SP2) {
            PG8_LDB(B0, 0, 0); PG8_LDB(B1, 0, 1); PG8_SCHED; PG8_LDA(At, 0, 0); PG8_STAGE(PG8_SA(1, 1), a1 + hstepA, voffA);
            PG8_WAIT_V(8); PG8_WAIT_L(0); PG8_BAR; PG8_MMA(0, 0, At, B0); PG8_MMA(0, 1, At, B1); PG8_BAR; PG8_SCHED;
            PG8_LDA(At, 0, 1); PG8_STAGE(PG8_SB(0, 0), b2, voffB); PG8_STAGE(PG8_SB(0, 1), b2 + hstepB, voffB); PG8_STAGE(PG8_SA(0, 0), a2, voffA);
            PG8_WAIT_V(8); PG8_WAIT_L(0); PG8_BAR; PG8_MMA(1, 0, At, B0); PG8_MMA(1, 1, At, B1); PG8_BAR; PG8_SCHED;
            PG8_LDB(B0, 1, 0); PG8_LDB(B1, 1, 1); PG8_SCHED; PG8_LDA(At, 1, 0); PG8_STAGE(PG8_SA(0, 1), a2 + hstepA, voffA);
            PG8_WAIT_V(8); PG8_WAIT_L(0); PG8_BAR; PG8_MMA(0, 0, At, B0); PG8_MMA(0, 1, At, B1); PG8_BAR; PG8_SCHED;
            PG8_LDA(At, 1, 1); PG8_STAGE(PG8_SB(1, 0), b3, voffB); PG8_STAGE(PG8_SB(1, 1), b3 + hstepB, voffB); PG8_STAGE(PG8_SA(1, 0), a3, voffA);
            PG8_WAIT_V(8); PG8_WAIT_L(0); PG8_BAR; PG8_MMA(1, 0, At, B0); PG8_MMA(1, 1, At, B1); PG8_BAR; PG8_SCHED;
            } else {
            PG8_LDB(B0, 0, 0); PG8_SCHED; PG8_LDA(At, 0, 0); PG8_STAGE(PG8_SA(1, 1), a1 + hstepA, voffA);
            PG8_WAIT_L(8); PG8_BAR; PG8_WAIT_L(0); PG8_MMA(0, 0, At, B0); PG8_BAR; PG8_SCHED;
            PG8_LDB(B1, 0, 1); PG8_STAGE(PG8_SB(0, 0), b2, voffB);
            PG8_BAR; PG8_WAIT_L(0); PG8_MMA(0, 1, At, B1); PG8_BAR;
            PG8_LDA(At, 0, 1); PG8_STAGE(PG8_SA(0, 0), a2, voffA);
            PG8_BAR; PG8_WAIT_L(0); PG8_MMA(1, 0, At, B0); PG8_BAR; PG8_SCHED;
            PG8_STAGE(PG8_SB(0, 1), b2 + hstepB, voffB);
            PG8_WAIT_V(6); PG8_BAR; PG8_MMA(1, 1, At, B1); PG8_BAR;
            PG8_LDB(B0, 1, 0); PG8_SCHED; PG8_LDA(At, 1, 0); PG8_STAGE(PG8_SA(0, 1), a2 + hstepA, voffA);
            PG8_WAIT_L(8); PG8_BAR; PG8_WAIT_L(0); PG8_MMA(0, 0, At, B0); PG8_BAR; PG8_SCHED;
            PG8_LDB(B1, 1, 1); PG8_STAGE(PG8_SB(1, 0), b3, voffB);
            PG8_BAR; PG8_WAIT_L(0); PG8_MMA(0, 1, At, B1); PG8_BAR;
            PG8_LDA(At, 1, 1); PG8_STAGE(PG8_SA(1, 0), a3, voffA);
            PG8_BAR; PG8_WAIT_L(0); PG8_MMA(1, 0, At, B0); PG8_BAR; PG8_SCHED;
            PG8_STAGE(PG8_SB(1, 1), b3 + hstepB, voffB);
            PG8_WAIT_V(6); PG8_BAR; PG8_MMA(1, 1, At, B1); PG8_BAR;
            }
        }
        if constexpr (ALIGN_EPI) { if (wr == 0) PG8_BAR; }
        if constexpr (!Epi::AFTER_DRAIN) { E(acc, cur, wr, wc, fr, fq); S.done(cur); }
        if (!has_next) break;
#pragma unroll
        for (int a = 0; a < 2; ++a)
#pragma unroll
            for (int b = 0; b < 2; ++b)
#pragma unroll
                for (int m = 0; m < 4; ++m)
#pragma unroll
                    for (int n = 0; n < 2; ++n) acc[a][b][m][n] = (f32x4){0.f, 0.f, 0.f, 0.f};
        cur = nxt; cA = nA; cB = nB; ++ui;
        if constexpr (ALIGN_EPI) { if (wr == 1) PG8_BAR; }
    }
    PG8_WAIT_V(0);
    if constexpr (!ALIGN_EPI) { if (wr == 0) PG8_BAR; }
    PG8_BAR;
    if constexpr (Epi::AFTER_DRAIN) { E.fused(acc, cur, wr, wc, fr, fq, lds, wid, lane); S.done(cur); }
#undef PG8_SA
#undef PG8_SB
#undef PG8_STAGE
#undef PG8_LDA
#undef PG8_LDB
#undef PG8_MMA
#undef PG8_WAIT_V
#undef PG8_WAIT_L
#undef PG8_BAR
#undef PG8_SCHED
}
}
#define GAS __attribute__((address_space(1)))
#define LAS __attribute__((address_space(3)))
typedef unsigned short bf16;
typedef unsigned v4u __attribute__((ext_vector_type(4)));
typedef float f32x4 __attribute__((ext_vector_type(4)));
typedef short bf16x8 __attribute__((ext_vector_type(8)));
typedef GAS unsigned gu32;
typedef GAS unsigned long long gu64;
#define RLX_AGENT __ATOMIC_RELAXED, __HIP_MEMORY_SCOPE_AGENT
#define LDS_WAIT() asm volatile("s_waitcnt lgkmcnt(0)" ::: "memory")
#define VM_WAIT() asm volatile("s_waitcnt vmcnt(0)" ::: "memory")
__device__ __forceinline__ unsigned long long rt() { return __builtin_amdgcn_s_memrealtime(); }
__device__ __forceinline__ unsigned f2bf(float f) { unsigned u = __builtin_bit_cast(unsigned, f); return (u + 0x7fffu + ((u >> 16) & 1u)) >> 16; }
__device__ __forceinline__ unsigned pk2(float lo, float hi) { return f2bf(lo) | (f2bf(hi) << 16); }

#define XB_TMO      128
#define XB_XCNT(j)  (256  + 64 * (j))
#define XB_XSUB(j)  (1280 + 64 * (j))
#define XB_XGEN(j)  (2304 + 64 * (j))
#define XB_TOP      3328
#define XB_TOPGEN   3392
#define XCD_BAR_WORDS 3456
#define XB_SPIN_CAP (1u << 18)

__device__ __forceinline__ unsigned xb_ld(unsigned* p)              { return __hip_atomic_load(p, __ATOMIC_RELAXED, __HIP_MEMORY_SCOPE_AGENT); }
__device__ __forceinline__ unsigned xb_add(unsigned* p, unsigned v) { return __hip_atomic_fetch_add(p, v, __ATOMIC_RELAXED, __HIP_MEMORY_SCOPE_AGENT); }
__device__ __forceinline__ unsigned xb_xcc_id() { return (unsigned)__builtin_amdgcn_s_getreg((3 << 11) | 20) & 0xFu; }
#define XB_SPIN(cond, bar) do { unsigned _sp = 0; while (cond) { __builtin_amdgcn_s_sleep(1); \
    if ((++_sp & 255u) == 0u) { if (xb_ld(&(bar)[XB_TMO])) break; if (_sp > XB_SPIN_CAP) { atomicAdd(&(bar)[XB_TMO], 1u); break; } } } } while (0)

struct XcdBarrier {
    unsigned* bar; unsigned x;
    volatile LAS unsigned* st;
};

__device__ __forceinline__ XcdBarrier xcd_barrier_post(unsigned* bar, volatile LAS unsigned* st) {
    XcdBarrier b; b.bar = bar; b.x = xb_xcc_id(); b.st = st;
    if (threadIdx.x == 0) (void)xb_add(&bar[XB_XCNT(b.x)], 1u);
    return b;
}
__device__ __forceinline__ void xcd_barrier_complete(unsigned* bar, unsigned x, unsigned& nloc, unsigned& nx) {
    const unsigned G = gridDim.x * gridDim.y * gridDim.z;
    unsigned sum, cnt, mine, sp = 0u;
    for (;;) {
        sum = 0u; cnt = 0u; mine = 0u;
#pragma unroll
        for (unsigned j = 0; j < 16; ++j) { const unsigned c = xb_ld(&bar[XB_XCNT(j)]); sum += c; cnt += (c > 0u) ? 1u : 0u; mine = (j == x) ? c : mine; }
        if (sum == G) break;
        __builtin_amdgcn_s_sleep(1);
        if ((++sp & 255u) == 0u) { if (xb_ld(&bar[XB_TMO])) break; if (sp > XB_SPIN_CAP) { atomicAdd(&bar[XB_TMO], 1u); break; } }
    }
    nloc = mine > 0u ? mine : 1u; nx = cnt > 0u ? cnt : 1u;
}

__device__ __forceinline__ void xcd_barrier(const XcdBarrier& b) {
    asm volatile("s_waitcnt vmcnt(0)" ::: "memory");
    __syncthreads();
    if (threadIdx.x == 0) {
        unsigned* bar = b.bar;
        __builtin_amdgcn_s_waitcnt(0);
        unsigned nloc = b.st[0], nx = b.st[1];
        if (nloc == 0u) { xcd_barrier_complete(bar, b.x, nloc, nx); b.st[0] = nloc; b.st[1] = nx; }
        const unsigned old = xb_add(&bar[XB_XSUB(b.x)], 1u);
        const unsigned gen = old / nloc;
        if (old + 1u == (gen + 1u) * nloc) {
            __builtin_amdgcn_fence(__ATOMIC_RELEASE, "agent");
            asm volatile("s_waitcnt vmcnt(0)" ::: "memory");
            const unsigned og = xb_add(&bar[XB_TOP], 1u);
            const unsigned tg = og / nx;
            if (og + 1u == (tg + 1u) * nx) xb_add(&bar[XB_TOPGEN], 1u);
            else XB_SPIN(xb_ld(&bar[XB_TOPGEN]) == tg, bar);
            __builtin_amdgcn_fence(__ATOMIC_ACQUIRE, "agent");
            xb_add(&bar[XB_XGEN(b.x)], 1u);
            asm volatile("s_waitcnt vmcnt(0)" ::: "memory");
        } else {
            XB_SPIN(xb_ld(&bar[XB_XGEN(b.x)]) == gen, bar);
            __builtin_amdgcn_fence(__ATOMIC_ACQUIRE, "agent");
            asm volatile("s_waitcnt vmcnt(0)" ::: "memory");
        }
    }
    __syncthreads();
}
constexpr int NWAVES = 8;
constexpr int BATCH = 16, SEQ = 2048, D = 1024, M = BATCH * SEQ;
constexpr int NP = 2816;
constexpr int IN_COLS = 2824;
constexpr int O_AK = 512, O_AV = 640, O_MQ = 768, O_MK = 1280, O_MV = 1792, O_MO = 2304, O_G = 2816;
constexpr int MEMLEN = 256, MMEM = BATCH * MEMLEN;
constexpr int FF = 2816, NU = 2 * FF;
constexpr float EPS = 1e-6f;
constexpr size_t MiB = 1u << 20;
constexpr size_t WS_CTL = 0, CTL_ZERO_BYTES = 1 * MiB;
constexpr size_t WS_RSTD0 = 1 * MiB;
constexpr size_t WS_RSTDM = WS_RSTD0 + 128 * 1024;
constexpr size_t WS_GPRE = 2 * MiB;
constexpr size_t WS_SSQ1 = 4 * MiB, WS_SSQ2 = 6 * MiB, WS_SSQ3 = 8 * MiB;
constexpr size_t WS_WIN = 16 * MiB, WS_WKV = 22 * MiB, WS_WOUT = 26 * MiB, WS_WQ = 28 * MiB, WS_WO = 30 * MiB, WS_WUP = 32 * MiB, WS_WDN = 43 * MiB;
constexpr size_t WS_MEMB = 49 * MiB;
constexpr size_t WS_KVM = 57 * MiB;
constexpr size_t WS_XB = 80 * MiB;
constexpr size_t WS_P = 144 * MiB;
constexpr size_t WS_MIX = 320 * MiB;
constexpr size_t WS_QX = 384 * MiB;
constexpr size_t WS_XO = 448 * MiB;
constexpr size_t WS_ACT = 144 * MiB;
constexpr size_t WS_SB = 320 * MiB;
constexpr size_t WS_END = 512 * MiB;
static_assert(WS_WDN + (size_t)D * FF * 2 <= WS_MEMB && WS_KVM + (size_t)MMEM * 2048 * 2 <= WS_XB && WS_XB + (size_t)M * D * 2 == WS_P && WS_P + (size_t)M * NP * 2 == WS_MIX && WS_ACT + (size_t)M * FF * 2 <= WS_SB && WS_SB + (size_t)(M / 64) * 6 * FF * 4 <= WS_QX, "d_ws map");
constexpr int CW_TMO = 0, CW_CODE = 1;
constexpr int CW_BAR = 4096;
constexpr int N_BAR_REGIONS = 16;
static_assert((CW_BAR + N_BAR_REGIONS * XCD_BAR_WORDS) * 4 <= (int)CTL_ZERO_BYTES, "CTL words inside the memset region");
constexpr int RING_OFF = 0, RING_BYTES = 131072;
constexpr int LDS_BYTES = 163840;
constexpr int LDSCTL_OFF = LDS_BYTES - 512, MISC_OFF = LDSCTL_OFF + 320;
constexpr int PH_LDS = LDSCTL_OFF;

struct Args { const float* in[20]; float* out; unsigned char* ws; int ph_lo, ph_hi, li, pad; };

struct Frame {
    LAS unsigned char* lds; volatile LAS unsigned* MISC; gu32* ctl;
    int tid, lane, wave, vcu, G;
};
__device__ __forceinline__ float wave_sum(float v) {
#pragma unroll
    for (int o = 1; o < 64; o <<= 1) v += __shfl_xor(v, o);
    return v;
}
__device__ __forceinline__ float bf2f(unsigned short b) { return __builtin_bit_cast(float, (unsigned)b << 16); }
__device__ __forceinline__ float bflo(unsigned w) { return __builtin_bit_cast(float, w << 16); }
__device__ __forceinline__ float bfhi(unsigned w) { return __builtin_bit_cast(float, w & 0xffff0000u); }

__device__ __forceinline__ void p0_transpose_item(const float* W, int K, int ldw, int src_col0, const float* g, bf16* WT, int dst_row0, LAS float* scr, int kb, int lane) {
    const int k0 = 64 * kb;
    float wv[32];
#pragma unroll
    for (int i = 0; i < 32; ++i) wv[i] = W[(size_t)(k0 + 2 * i + (lane >> 5)) * ldw + src_col0 + (lane & 31)];
#pragma unroll
    for (int i = 0; i < 32; ++i) { const int kk = 2 * i + (lane >> 5); float w = wv[i]; if (g) w *= g[k0 + kk]; scr[kk * 33 + (lane & 31)] = w; }
    LDS_WAIT(); asm volatile("" ::: "memory");
    const int c = lane & 7;
#pragma unroll
    for (int j = 0; j < 4; ++j) { const int n = (lane >> 3) + 8 * j; const LAS float* s = scr + (8 * c) * 33 + n;
        v4u o; o.x = pk2(s[0 * 33], s[1 * 33]); o.y = pk2(s[2 * 33], s[3 * 33]); o.z = pk2(s[4 * 33], s[5 * 33]); o.w = pk2(s[6 * 33], s[7 * 33]);
        *(GAS v4u*)(WT + (size_t)(dst_row0 + n) * K + k0 + 8 * c) = o; }
    LDS_WAIT(); asm volatile("" ::: "memory");
}
__device__ __forceinline__ void row_load(const float* xrow, int lane, f32x4 (&v)[4]) {
    const GAS f32x4* xr = (const GAS f32x4*)xrow + lane;
#pragma unroll
    for (int j = 0; j < 4; ++j) v[j] = xr[64 * j];
}
__device__ __forceinline__ float row_to_bf16(bf16* orow, int lane, const f32x4 (&v)[4]) {
    float s = 0.f;
#pragma unroll
    for (int j = 0; j < 4; ++j) s += (v[j][0] * v[j][0] + v[j][1] * v[j][1]) + (v[j][2] * v[j][2] + v[j][3] * v[j][3]);
    GAS unsigned long long* o8 = (GAS unsigned long long*)orow + lane;
#pragma unroll
    for (int j = 0; j < 4; ++j) o8[64 * j] = (unsigned long long)pk2(v[j][0], v[j][1]) | ((unsigned long long)pk2(v[j][2], v[j][3]) << 32);
    return wave_sum(s);
}
typedef float f32x16 __attribute__((ext_vector_type(16)));
typedef short s16x4 __attribute__((ext_vector_type(4)));
__device__ __forceinline__ int crow(int r, int hi) { return (r & 3) + 8 * (r >> 2) + 4 * hi; }
__device__ __forceinline__ unsigned cvtpk(float lo, float hi) { typedef float f2 __attribute__((ext_vector_type(2))); typedef __bf16 b2 __attribute__((ext_vector_type(2))); f2 v = {lo, hi}; b2 b = __builtin_convertvector(v, b2); return __builtin_bit_cast(unsigned, b); }
__device__ __forceinline__ s16x4 ldtr(const LAS unsigned char* p) { typedef short v4i16 __attribute__((ext_vector_type(4))); return __builtin_bit_cast(s16x4, __builtin_amdgcn_ds_read_tr16_b64_v4i16((LAS v4i16*)p)); }
__device__ __forceinline__ bf16x8 pack8(const f32x16& p, int b) { v4u w; w.x = cvtpk(p[b], p[b + 1]); w.y = cvtpk(p[b + 2], p[b + 3]); w.z = cvtpk(p[b + 4], p[b + 5]); w.w = cvtpk(p[b + 6], p[b + 7]); return __builtin_bit_cast(bf16x8, w); }
#define GLDS16(gptr, ldsptr) __builtin_amdgcn_global_load_lds((const unsigned*)(gptr), (LAS unsigned*)(ldsptr), 16, 0, 0)

__device__ __forceinline__ void xattn_unit(Frame& F, int b, int xh, int qb, const bf16* QX, const float* ssq1, const bf16* KVM, bf16* XO) {
    const int lane = F.lane, w = F.wave, r32 = lane & 31, hi = lane >> 5;
    const size_t row = (size_t)b * SEQ + qb * 256 + w * 32 + r32;
    const bf16* Kg = KVM + (size_t)b * MEMLEN * 2048 + xh * 256;
    { const bf16* kp = Kg + (size_t)(2 * w + (lane >> 5)) * 2048 + (lane & 31) * 8;
#pragma unroll
      for (int i = 0; i < 16; ++i) GLDS16(kp + (size_t)i * 16 * 2048, F.lds + (w + 8 * i) * 1040); }
    const bf16* qp = QX + row * D + xh * 256 + hi * 8;
    bf16x8 qa[2], qc[2];
#pragma unroll
    for (int j = 0; j < 2; ++j) qa[j] = *(const bf16x8*)(qp + j * 16);
    const pg8::RsParts rs{ssq1};
    const float sc2 = rs.get((int)row) * (0.0625f * 1.4426950408889634f);
    asm volatile("s_waitcnt vmcnt(0)" ::: "memory"); __syncthreads();
    const LAS unsigned char* kbase = F.lds + (r32 >> 1) * 1040 + (r32 & 1) * 512 + hi * 16;
    f32x16 S[8];
#pragma unroll
    for (int kb = 0; kb < 8; ++kb) S[kb] = (f32x16){0.f, 0.f, 0.f, 0.f, 0.f, 0.f, 0.f, 0.f, 0.f, 0.f, 0.f, 0.f, 0.f, 0.f, 0.f, 0.f};
#define XQK(QF, G) do { _Pragma("unroll") for (int j = 0; j < 2; ++j) _Pragma("unroll") for (int kb = 0; kb < 8; ++kb) { \
            const bf16x8 a = *(const LAS bf16x8*)(kbase + kb * 16640 + (2 * (G) + j) * 32); \
            S[kb] = __builtin_amdgcn_mfma_f32_32x32x16_bf16(a, QF[j], S[kb], 0, 0, 0); } } while (0)
#define XQL(QF, G) do { _Pragma("unroll") for (int j = 0; j < 2; ++j) QF[j] = *(const bf16x8*)(qp + (2 * (G) + j) * 16); } while (0)
    XQL(qc, 1); asm volatile("" ::: "memory"); XQK(qa, 0); asm volatile("" ::: "memory");
    XQL(qa, 2); asm volatile("" ::: "memory"); XQK(qc, 1); asm volatile("" ::: "memory");
    XQL(qc, 3); asm volatile("" ::: "memory"); XQK(qa, 2); asm volatile("" ::: "memory");
    XQL(qa, 4); asm volatile("" ::: "memory"); XQK(qc, 3); asm volatile("" ::: "memory");
    XQL(qc, 5); asm volatile("" ::: "memory"); XQK(qa, 4); asm volatile("" ::: "memory");
    XQL(qa, 6); asm volatile("" ::: "memory"); XQK(qc, 5); asm volatile("" ::: "memory");
    XQL(qc, 7); asm volatile("" ::: "memory"); XQK(qa, 6); asm volatile("" ::: "memory");
    XQK(qc, 7);
#undef XQK
#undef XQL
    float mx = S[0][0];
#pragma unroll
    for (int kb = 0; kb < 8; ++kb)
#pragma unroll
        for (int r = 0; r < 16; ++r) mx = fmaxf(mx, S[kb][r]);
    mx = fmaxf(mx, __shfl_xor(mx, 32));
    const float mo = mx * sc2; float l = 0.f;
#pragma unroll
    for (int kb = 0; kb < 8; ++kb)
#pragma unroll
        for (int r = 0; r < 16; ++r) { const float e = __builtin_amdgcn_exp2f(S[kb][r] * sc2 - mo); S[kb][r] = e; l += e; }
    l += __shfl_xor(l, 32);
    const float inv = 1.0f / l;
    bf16x8 pf[8][2];
#pragma unroll
    for (int kb = 0; kb < 8; ++kb) { pf[kb][0] = pack8(S[kb], 0); pf[kb][1] = pack8(S[kb], 8); }
    __syncthreads();
    { const bf16* vp = KVM + (size_t)b * MEMLEN * 2048 + 1024 + xh * 256 + (size_t)(16 * w + (lane >> 2)) * 2048 + 8 * (lane & 3);
#pragma unroll
      for (int i = 0; i < 16; ++i) GLDS16(vp + (size_t)(i & 1) * 128 * 2048 + (i >> 1) * 32, F.lds + (w + 8 * i) * 1024); }
    asm volatile("s_waitcnt vmcnt(0)" ::: "memory"); __syncthreads();
    bf16* orow = XO + row * D + xh * 256 + 4 * hi;
    const int vbase = (4 * hi + ((lane & 15) >> 2)) * 64 + (16 * ((lane >> 4) & 1) + 4 * (lane & 3)) * 2;
#pragma unroll
    for (int db = 0; db < 8; ++db) {
        f32x16 o = (f32x16){0.f, 0.f, 0.f, 0.f, 0.f, 0.f, 0.f, 0.f, 0.f, 0.f, 0.f, 0.f, 0.f, 0.f, 0.f, 0.f};
#pragma unroll
        for (int kb = 0; kb < 8; ++kb)
#pragma unroll
            for (int s = 0; s < 2; ++s) {
                const LAS unsigned char* vp = F.lds + db * 16384 + (32 * kb + 16 * s) * 64 + vbase;
                const s16x4 lo = ldtr(vp), hh = ldtr(vp + 8 * 64);
                const bf16x8 a = (bf16x8){lo[0], lo[1], lo[2], lo[3], hh[0], hh[1], hh[2], hh[3]};
                o = __builtin_amdgcn_mfma_f32_32x32x16_bf16(a, pf[kb][s], o, 0, 0, 0);
            }
#pragma unroll
        for (int g = 0; g < 4; ++g) { typedef unsigned u2 __attribute__((ext_vector_type(2))); u2 wv; wv.x = cvtpk(o[4 * g] * inv, o[4 * g + 1] * inv); wv.y = cvtpk(o[4 * g + 2] * inv, o[4 * g + 3] * inv);
            *(u2*)(orow + 32 * db + 8 * g) = wv; }
    }
    __syncthreads();
}
__device__ __forceinline__ void p5_xattn(Frame& F, const Args& a) {
    const bf16* QX = (const bf16*)(a.ws + WS_QX); const bf16* KVM = (const bf16*)(a.ws + WS_KVM); bf16* XO = (bf16*)(a.ws + WS_XO); const float* ssq1 = (const float*)(a.ws + WS_SSQ1);
    constexpr int NUNIT = BATCH * 4 * (SEQ / 256);
    for (int u = F.vcu; u < NUNIT; u += F.G) { const int qb = u & 7, xh = (u >> 3) & 3, b = u >> 5; xattn_unit(F, b, xh, qb, QX, ssq1, KVM, XO); }
}
__device__ __forceinline__ void swa_unit(Frame& F, int b, int hk, int n, const bf16* P, const float* sinks, bf16* MIX) {
    const int lane = F.lane, w = F.wave, r32 = lane & 31, hi = lane >> 5, wq = w & 3;
    LAS unsigned char* Kl = F.lds; LAS unsigned char* Vl = F.lds + 32768;
    const int np = n > 0 ? n - 1 : 0;
    {
        const int z = (4 * w + (lane >> 4)) & 7;
        const bf16* kp = P + (size_t)(b * SEQ + 8 * w + (lane >> 3)) * NP + O_AK + hk * 64 + (((lane & 7) ^ z) * 8);
#pragma unroll
        for (int i = 0; i < 4; ++i) GLDS16(kp + (size_t)(128 * (i < 2 ? np : n) + 64 * (i & 1)) * NP, Kl + (w + 8 * i) * 1024);
        const bf16* vp = P + (size_t)(b * SEQ + 16 * w + (lane >> 2)) * NP + O_AV + hk * 64 + 8 * (lane & 3);
#pragma unroll
        for (int i = 0; i < 4; ++i) GLDS16(vp + (size_t)(128 * ((i & 1) ? n : np)) * NP + 32 * (i >> 1), Vl + (w + 8 * i) * 1024);
    }
    const size_t row = (size_t)b * SEQ + n * 128 + wq * 32 + r32;
    bf16x8 qf[2][4];
#pragma unroll
    for (int gi = 0; gi < 2; ++gi) { const bf16* qp = P + row * NP + (hk * 4 + 2 * (w >> 2) + gi) * 64 + hi * 8;
#pragma unroll
        for (int ks = 0; ks < 4; ++ks) qf[gi][ks] = *(const bf16x8*)(qp + ks * 16); }
    asm volatile("s_waitcnt vmcnt(0)" ::: "memory"); __syncthreads();
    const int zk = (r32 >> 1) & 7;
    const LAS unsigned char* krow = Kl + (32 * wq + r32) * 128;
    const int vlane = (4 * hi + ((lane & 15) >> 2)) * 64 + (16 * ((lane >> 4) & 1) + 4 * (lane & 3)) * 2;
    const int dl = r32 - 4 * hi;
#pragma unroll
    for (int gi = 0; gi < 2; ++gi) {
        const int h = hk * 4 + 2 * (w >> 2) + gi;
        const float slope2 = exp2f(-(float)(h + 1)) * 1.4426950408889634f, sink2 = sinks[h] * 1.4426950408889634f;
        constexpr float sc = 0.125f * 1.4426950408889634f;
        f32x16 S[5];
#pragma unroll
        for (int jb = 0; jb < 5; ++jb) S[jb] = (f32x16){0.f, 0.f, 0.f, 0.f, 0.f, 0.f, 0.f, 0.f, 0.f, 0.f, 0.f, 0.f, 0.f, 0.f, 0.f, 0.f};
#pragma unroll
        for (int ks = 0; ks < 4; ++ks) { const int co = ((2 * ks + hi) ^ zk) * 16;
#pragma unroll
            for (int jb = 0; jb < 5; ++jb) { const bf16x8 a = *(const LAS bf16x8*)(krow + jb * 4096 + co); S[jb] = __builtin_amdgcn_mfma_f32_32x32x16_bf16(a, qf[gi][ks], S[jb], 0, 0, 0); } }
        int dlo = dl; float bbase = -slope2 * (float)(dl + 128);
        asm volatile("" : "+v"(dlo), "+v"(bbase));
        float mx = sink2;
#pragma unroll
        for (int jb = 0; jb < 5; ++jb) { const bool dead = (n == 0) && (wq + jb < 4);
#pragma unroll
            for (int r = 0; r < 16; ++r) { const int cr = 32 * jb + (r & 3) + 8 * (r >> 2);
                float v = __builtin_fmaf(S[jb][r], sc, __builtin_fmaf(slope2, (float)cr, bbase));
                if (jb == 0) v = (dlo >= cr) ? -1e30f : v;
                if (jb == 4) v = (dlo < cr - 128) ? -1e30f : v;
                v = dead ? -1e30f : v;
                S[jb][r] = v; mx = fmaxf(mx, v); } }
        mx = fmaxf(mx, __shfl_xor(mx, 32));
        float l = 0.f;
#pragma unroll
        for (int jb = 0; jb < 5; ++jb)
#pragma unroll
            for (int r = 0; r < 16; ++r) { const float e = __builtin_amdgcn_exp2f(S[jb][r] - mx); S[jb][r] = e; l += e; }
        l += __shfl_xor(l, 32);
        const float inv = 1.0f / (l + __builtin_amdgcn_exp2f(sink2 - mx));
        bf16x8 pf[5][2];
#pragma unroll
        for (int jb = 0; jb < 5; ++jb) { pf[jb][0] = pack8(S[jb], 0); pf[jb][1] = pack8(S[jb], 8); }
        bf16* orow = MIX + row * D + h * 64 + 4 * hi;
#pragma unroll
        for (int db = 0; db < 2; ++db) {
            f32x16 o = (f32x16){0.f, 0.f, 0.f, 0.f, 0.f, 0.f, 0.f, 0.f, 0.f, 0.f, 0.f, 0.f, 0.f, 0.f, 0.f, 0.f};
#pragma unroll
            for (int jb = 0; jb < 5; ++jb)
#pragma unroll
                for (int s = 0; s < 2; ++s) { const LAS unsigned char* vp = Vl + db * 16384 + (32 * (wq + jb) + 16 * s) * 64 + vlane;
                    const s16x4 lo = ldtr(vp), hh = ldtr(vp + 8 * 64);
                    const bf16x8 a = (bf16x8){lo[0], lo[1], lo[2], lo[3], hh[0], hh[1], hh[2], hh[3]};
                    o = __builtin_amdgcn_mfma_f32_32x32x16_bf16(a, pf[jb][s], o, 0, 0, 0); }
#pragma unroll
            for (int g4 = 0; g4 < 4; ++g4) { typedef unsigned u2 __attribute__((ext_vector_type(2))); u2 wv; wv.x = cvtpk(o[4 * g4] * inv, o[4 * g4 + 1] * inv); wv.y = cvtpk(o[4 * g4 + 2] * inv, o[4 * g4 + 3] * inv);
                *(u2*)(orow + 32 * db + 8 * g4) = wv; }
        }
        __builtin_amdgcn_sched_barrier(0);
    }
    __syncthreads();
}
namespace ml {
constexpr int QS = 0, KS = 16384, KT = 32768, VS0 = 49152, PS = 65536, GS = 73728, WS = 74752, END1 = 79872;
constexpr int Q0 = 0, Q1 = 16384, CT0 = 32768, CT1 = 32768 + 33280, END2 = 32768 + 2 * 33280 + 8192;
static_assert(END1 <= PH_LDS && END2 <= PH_LDS, "mLSTM LDS maps");
constexpr float L2E = 1.4426950408889634f;
constexpr int NCH = SEQ / 64, NCID = BATCH * 4 * NCH;
constexpr size_t WS_KL = WS_XB;
constexpr size_t WS_HL = WS_QX;
constexpr size_t WS_QG = WS_QX + 32 * MiB;
constexpr size_t WS_SM = WS_XO;
constexpr size_t WS_NL = WS_XO + 2 * MiB;
}
__device__ __forceinline__ float fast_silu(float y) { return y * __builtin_amdgcn_rcpf(1.0f + __builtin_amdgcn_exp2f(-1.4426950408889634f * y)); }
__device__ __forceinline__ float fast_sigmoid(float y) { return __builtin_amdgcn_rcpf(1.0f + __builtin_amdgcn_exp2f(-1.4426950408889634f * y)); }

__device__ __forceinline__ void mlstm_local_unit(Frame& F, int cid, const bf16* P, const float* gpre, const float* bg, const float* cw, const float* cb, unsigned char* ws) {
    using namespace ml;
    const int tid = F.tid, lane = F.lane, w = F.wave, r32 = lane & 31, hi = lane >> 5, vb = w & 3, tb = w >> 2;
    const int c = cid & (NCH - 1), bh = cid >> 5, h = bh & 3, b = bh >> 2;
    LAS unsigned char* L = F.lds;
    const int chg = tid & 31, run = tid >> 5, cc = chg & 15, t0 = 4 * run; const bool isk = chg >= 16;
    const int cch = (isk ? 512 : 0) + h * 128 + 8 * cc;
    const size_t row0 = (size_t)b * SEQ + (size_t)c * 64;
    v4u raw[7];
    { const bf16* rawp = P + O_MQ + cch;
#pragma unroll
      for (int k = 0; k < 7; ++k) { const int t = c * 64 + t0 - 3 + k; raw[k] = (t >= 0) ? *(const v4u*)(rawp + (row0 + t0 - 3 + k) * NP) : (v4u){0u, 0u, 0u, 0u}; } }
    const float gi = gpre[(row0 + lane) * 8 + h] + bg[h], gf = gpre[(row0 + lane) * 8 + 4 + h] + bg[4 + h];
    float wt[4][8], bb[8];
#pragma unroll
    for (int j = 0; j < 4; ++j) { const f32x4 a = *(const f32x4*)(cw + j * 1024 + cch), bq = *(const f32x4*)(cw + j * 1024 + cch + 4);
#pragma unroll
        for (int e = 0; e < 4; ++e) { wt[j][e] = a[e]; wt[j][4 + e] = bq[e]; } }
    { const f32x4 a = *(const f32x4*)(cb + cch), bq = *(const f32x4*)(cb + cch + 4);
#pragma unroll
      for (int e = 0; e < 4; ++e) { bb[e] = a[e]; bb[4 + e] = bq[e]; } }
    { const bf16* vsrc = P + (row0 + (lane >> 2)) * NP + O_MV + h * 128 + 8 * (lane & 3);
#pragma unroll
      for (int i = 0; i < 2; ++i) { const int p = w + 8 * i; GLDS16(vsrc + (size_t)(16 * (p & 3)) * NP + 32 * (p >> 2), L + VS0 + p * 1024); } }
    const float lf = fminf(gf, 0.f) - log1pf(__expf(-fabsf(gf)));
    float bs = lf;
#pragma unroll
    for (int o = 1; o < 64; o <<= 1) { const float v = __shfl_up(bs, o); if (lane >= o) bs += v; }
    const float u = gi - bs; float pm = u;
#pragma unroll
    for (int o = 1; o < 64; o <<= 1) { const float v = __shfl_up(pm, o); if (lane >= o) pm = fmaxf(pm, v); }
    const float pm63 = __shfl(pm, 63);
    const float wsl = __expf(u - pm63);
    if (w == 0) { LAS float* g = (LAS float*)(L + GS); g[lane] = u * L2E; g[64 + lane] = pm * L2E;
        float* sm = (float*)(ws + WS_SM) + (size_t)cid * 192; sm[64 + lane] = pm; sm[128 + lane] = bs; }
    {
        float psum[8];
#pragma unroll
        for (int e = 0; e < 8; ++e) psum[e] = 0.f;
        bf16* qg = (bf16*)(ws + WS_QG) + (size_t)cid * 8192;
#pragma unroll
        for (int i = 0; i < 4; ++i) {
            const int t = t0 + i; const float wsr = __shfl(wsl, t);
            float y[8];
#pragma unroll
            for (int e = 0; e < 8; ++e) y[e] = bb[e];
#pragma unroll
            for (int j = 0; j < 4; ++j)
#pragma unroll
                for (int q = 0; q < 4; ++q) { y[2 * q] += wt[j][2 * q] * bflo(raw[i + j][q]); y[2 * q + 1] += wt[j][2 * q + 1] * bfhi(raw[i + j][q]); }
#pragma unroll
            for (int e = 0; e < 8; ++e) y[e] = fast_silu(y[e]);
            const int sw = (cc ^ (t & 15)) * 16;
            if (!isk) { v4u o;
#pragma unroll
                for (int q = 0; q < 4; ++q) o[q] = cvtpk(y[2 * q] * 0.08838834764831845f, y[2 * q + 1] * 0.08838834764831845f);
                *(LAS v4u*)(L + QS + t * 256 + sw) = o; *(v4u*)((unsigned char*)qg + t * 256 + sw) = o;
            } else { v4u o, o2;
#pragma unroll
                for (int q = 0; q < 4; ++q) { o[q] = cvtpk(y[2 * q], y[2 * q + 1]); o2[q] = cvtpk(y[2 * q] * wsr, y[2 * q + 1] * wsr); }
#pragma unroll
                for (int e = 0; e < 8; ++e) psum[e] += y[e] * wsr;
                *(LAS v4u*)(L + KS + t * 256 + sw) = o;
                *(LAS v4u*)(L + KT + (cc >> 2) * 4096 + t * 64 + (cc & 3) * 16) = o2;
            }
        }
        if (isk) { LAS float* ps = (LAS float*)(L + PS) + run * 128 + 8 * cc; *(LAS f32x4*)ps = (f32x4){psum[0], psum[1], psum[2], psum[3]}; *(LAS f32x4*)(ps + 4) = (f32x4){psum[4], psum[5], psum[6], psum[7]}; }
    }
    asm volatile("s_waitcnt vmcnt(0)" ::: "memory"); __syncthreads();
    const int zsw = (r32 & 15);
    const int vlane = (4 * hi + ((lane & 15) >> 2)) * 64 + (16 * ((lane >> 4) & 1) + 4 * (lane & 3)) * 2;
    const LAS float* g = (const LAS float*)(L + GS);
    const int tl = 32 * tb + r32;
    const float pm2 = g[64 + tl];
    bf16x8 qf[8];
#pragma unroll
    for (int ks = 0; ks < 8; ++ks) qf[ks] = *(const LAS bf16x8*)(L + QS + tl * 256 + (((2 * ks + hi) ^ zsw) * 16));
    bf16x8 vf[4];
#pragma unroll
    for (int s4 = 0; s4 < 4; ++s4) { const LAS unsigned char* vp = L + VS0 + vb * 4096 + (16 * s4) * 64 + vlane; const s16x4 lo = ldtr(vp), hh = ldtr(vp + 8 * 64);
        vf[s4] = (bf16x8){lo[0], lo[1], lo[2], lo[3], hh[0], hh[1], hh[2], hh[3]}; }
    f32x16 o = (f32x16){0.f, 0.f, 0.f, 0.f, 0.f, 0.f, 0.f, 0.f, 0.f, 0.f, 0.f, 0.f, 0.f, 0.f, 0.f, 0.f};
    float dsum = 0.f;
#pragma unroll
    for (int sb = 0; sb < 2; ++sb) if (sb <= tb) {
        f32x16 S = (f32x16){0.f, 0.f, 0.f, 0.f, 0.f, 0.f, 0.f, 0.f, 0.f, 0.f, 0.f, 0.f, 0.f, 0.f, 0.f, 0.f};
#pragma unroll
        for (int ks = 0; ks < 8; ++ks) { const bf16x8 a = *(const LAS bf16x8*)(L + KS + (32 * sb + r32) * 256 + (((2 * ks + hi) ^ zsw) * 16)); S = __builtin_amdgcn_mfma_f32_32x32x16_bf16(a, qf[ks], S, 0, 0, 0); }
#pragma unroll
        for (int g4 = 0; g4 < 4; ++g4) { const f32x4 uu = *(const LAS f32x4*)(g + 32 * sb + 8 * g4 + 4 * hi);
#pragma unroll
            for (int e = 0; e < 4; ++e) { const int r = 4 * g4 + e; const int sl = 32 * sb + 8 * g4 + 4 * hi + e;
                const float gm = (sl <= tl) ? __builtin_amdgcn_exp2f(uu[e] - pm2) : 0.f; const float v = S[r] * gm; S[r] = v; dsum += v; } }
        o = __builtin_amdgcn_mfma_f32_32x32x16_bf16(vf[2 * sb], pack8(S, 0), o, 0, 0, 0);
        o = __builtin_amdgcn_mfma_f32_32x32x16_bf16(vf[2 * sb + 1], pack8(S, 8), o, 0, 0, 0);
    }
    dsum += __shfl_xor(dsum, 32);
    if (vb == 0 && hi == 0) ((float*)(ws + WS_SM) + (size_t)cid * 192)[tl] = dsum;
    { v4u* hp = (v4u*)((bf16*)(ws + WS_HL) + ((size_t)(cid * 8 + w) * 64 + lane) * 16);
      v4u a; a.x = cvtpk(o[0], o[1]); a.y = cvtpk(o[2], o[3]); a.z = cvtpk(o[4], o[5]); a.w = cvtpk(o[6], o[7]); hp[0] = a;
      a.x = cvtpk(o[8], o[9]); a.y = cvtpk(o[10], o[11]); a.z = cvtpk(o[12], o[13]); a.w = cvtpk(o[14], o[15]); hp[1] = a; }
#pragma unroll
    for (int i = 0; i < 2; ++i) {
        f32x16 kacc = (f32x16){0.f, 0.f, 0.f, 0.f, 0.f, 0.f, 0.f, 0.f, 0.f, 0.f, 0.f, 0.f, 0.f, 0.f, 0.f, 0.f};
#pragma unroll
        for (int s4 = 0; s4 < 4; ++s4) { const LAS unsigned char* kp = L + KT + (2 * tb + i) * 4096 + (16 * s4) * 64 + vlane; const s16x4 lo = ldtr(kp), hh = ldtr(kp + 8 * 64);
            const bf16x8 a = (bf16x8){lo[0], lo[1], lo[2], lo[3], hh[0], hh[1], hh[2], hh[3]};
            kacc = __builtin_amdgcn_mfma_f32_32x32x16_bf16(a, vf[s4], kacc, 0, 0, 0); }
        v4u* kp2 = (v4u*)((bf16*)(ws + WS_KL) + (((size_t)(cid * 8 + w) * 2 + i) * 64 + lane) * 16);
        v4u a; a.x = cvtpk(kacc[0], kacc[1]); a.y = cvtpk(kacc[2], kacc[3]); a.z = cvtpk(kacc[4], kacc[5]); a.w = cvtpk(kacc[6], kacc[7]); kp2[0] = a;
        a.x = cvtpk(kacc[8], kacc[9]); a.y = cvtpk(kacc[10], kacc[11]); a.z = cvtpk(kacc[12], kacc[13]); a.w = cvtpk(kacc[14], kacc[15]); kp2[1] = a;
    }
    if (tid < 128) { float s = 0.f; const LAS float* ps = (const LAS float*)(L + PS) + tid;
#pragma unroll
        for (int q = 0; q < 16; ++q) s += ps[q * 128];
        ((float*)(ws + WS_NL))[(size_t)cid * 128 + tid] = s; }
    __syncthreads();
}

__device__ __forceinline__ void mlstm_scan(Frame& F, int b, int h, const bf16* P, bf16* MIX, unsigned char* ws) {
    using namespace ml;
    typedef unsigned u2 __attribute__((ext_vector_type(2)));
    const int tid = F.tid, lane = F.lane, w = F.wave, r32 = lane & 31, hi = lane >> 5, vb = w & 3, tb = w >> 2;
    LAS unsigned char* L = F.lds;
    const int cid0 = (b * 4 + h) * NCH;
    for (int i = tid; i < (33280 + 8192) / 16; i += NWAVES * 64) *(LAS v4u*)(L + CT0 + 16 * i) = (v4u){0u, 0u, 0u, 0u};
    f32x16 Cacc[2];
#pragma unroll
    for (int i = 0; i < 2; ++i) Cacc[i] = (f32x16){0.f, 0.f, 0.f, 0.f, 0.f, 0.f, 0.f, 0.f, 0.f, 0.f, 0.f, 0.f, 0.f, 0.f, 0.f, 0.f};
    float nreg = 0.f, mprev = 0.f;
    const size_t rowb = (size_t)b * SEQ;
    const int zsw = (r32 & 15), tl = 32 * tb + r32;
    v4u hln[2], kln[2][2]; u2 mon[4]; float dln, pmn, bsn, nln;
#define ML_PREFETCH(cc_) do { const int cid_ = cid0 + (cc_); \
        const v4u* hp_ = (const v4u*)((const bf16*)(ws + WS_HL) + ((size_t)(cid_ * 8 + w) * 64 + lane) * 16); hln[0] = hp_[0]; hln[1] = hp_[1]; \
        _Pragma("unroll") for (int i_ = 0; i_ < 2; ++i_) { const v4u* kp_ = (const v4u*)((const bf16*)(ws + WS_KL) + (((size_t)(cid_ * 8 + w) * 2 + i_) * 64 + lane) * 16); kln[i_][0] = kp_[0]; kln[i_][1] = kp_[1]; } \
        const size_t tr_ = rowb + (size_t)(cc_) * 64 + tl; \
        _Pragma("unroll") for (int g_ = 0; g_ < 4; ++g_) mon[g_] = *(const u2*)(P + tr_ * NP + O_MO + h * 128 + 32 * vb + 8 * g_ + 4 * hi); \
        const float* sm_ = (const float*)(ws + WS_SM) + (size_t)cid_ * 192; dln = sm_[lane]; pmn = sm_[64 + lane]; bsn = sm_[128 + lane]; \
        nln = (tid < 128) ? ((const float*)(ws + WS_NL))[(size_t)cid_ * 128 + tid] : 0.f; \
        { const unsigned char* qg_ = (const unsigned char*)(ws + WS_QG) + (size_t)cid_ * 16384; \
          _Pragma("unroll") for (int i_ = 0; i_ < 2; ++i_) GLDS16(qg_ + (w + 8 * i_) * 1024 + lane * 16, L + (((cc_) & 1) ? Q1 : Q0) + (w + 8 * i_) * 1024); } } while (0)
    ML_PREFETCH(0);
    for (int c = 0; c < NCH; ++c) {
        const int par = c & 1;
        const v4u hl0 = hln[0], hl1 = hln[1]; v4u kl[2][2]; kl[0][0] = kln[0][0]; kl[0][1] = kln[0][1]; kl[1][0] = kln[1][0]; kl[1][1] = kln[1][1];
        u2 mo[4]; mo[0] = mon[0]; mo[1] = mon[1]; mo[2] = mon[2]; mo[3] = mon[3];
        const float dl = dln, pm = pmn, bs = bsn, nl = nln;
        asm volatile("s_waitcnt vmcnt(0)" ::: "memory"); __syncthreads();
        if (c + 1 < NCH) ML_PREFETCH(c + 1);
        const float Mt = fmaxf(mprev, pm);
        const float M63 = __shfl(Mt, 63), b63 = __shfl(bs, 63), pm63 = __shfl(pm, 63);
        const float wi_l = __expf(mprev - Mt), ft_l = __expf(pm - Mt), ef_l = __expf(-(bs + Mt));
        const float wi = __shfl(wi_l, tl), ft = __shfl(ft_l, tl), ef = __shfl(ef_l, tl), dlt = __shfl(dl, tl);
        const float decay = __expf(mprev - M63), f2 = __expf(pm63 - M63);
        const LAS unsigned char* Ql = L + (par ? Q1 : Q0);
        const LAS unsigned char* Cr = L + (par ? CT1 : CT0); LAS unsigned char* Cw = L + (par ? CT0 : CT1);
        bf16x8 qf[8];
#pragma unroll
        for (int ks = 0; ks < 8; ++ks) qf[ks] = *(const LAS bf16x8*)(Ql + tl * 256 + (((2 * ks + hi) ^ zsw) * 16));
        f32x16 o = (f32x16){0.f, 0.f, 0.f, 0.f, 0.f, 0.f, 0.f, 0.f, 0.f, 0.f, 0.f, 0.f, 0.f, 0.f, 0.f, 0.f};
        f32x16 on = (f32x16){0.f, 0.f, 0.f, 0.f, 0.f, 0.f, 0.f, 0.f, 0.f, 0.f, 0.f, 0.f, 0.f, 0.f, 0.f, 0.f};
#pragma unroll
        for (int ks = 0; ks < 8; ++ks) { const bf16x8 a = *(const LAS bf16x8*)(Cr + (32 * vb + r32) * 256 + (((2 * ks + hi) ^ zsw) * 16)); o = __builtin_amdgcn_mfma_f32_32x32x16_bf16(a, qf[ks], o, 0, 0, 0); }
#pragma unroll
        for (int ks = 0; ks < 8; ++ks) { const bf16x8 a = *(const LAS bf16x8*)(Cr + (128 + r32) * 256 + (2 * ks + hi) * 16); on = __builtin_amdgcn_mfma_f32_32x32x16_bf16(a, qf[ks], on, 0, 0, 0); }
        const float qn = __shfl(on[0], r32);
        const float den = wi * qn + ft * dlt;
        const float rden = 1.0f / fmaxf(fabsf(den), ef);
        { bf16* op = MIX + (rowb + (size_t)c * 64 + tl) * D + 512 + h * 128 + 32 * vb + 4 * hi;
#pragma unroll
          for (int g4 = 0; g4 < 4; ++g4) { const unsigned hw0 = g4 < 2 ? hl0[2 * g4] : hl1[2 * g4 - 4], hw1 = g4 < 2 ? hl0[2 * g4 + 1] : hl1[2 * g4 - 3];
              float x[4]; const float hv[4] = {bflo(hw0), bfhi(hw0), bflo(hw1), bfhi(hw1)};
#pragma unroll
              for (int e = 0; e < 4; ++e) { const float og = (e & 1) ? bfhi(mo[g4][e >> 1]) : bflo(mo[g4][e >> 1]); x[e] = (wi * o[4 * g4 + e] + ft * hv[e]) * rden * fast_sigmoid(og); }
              u2 wv; wv.x = cvtpk(x[0], x[1]); wv.y = cvtpk(x[2], x[3]); *(u2*)(op + 8 * g4) = wv; } }
        const int dv = 32 * vb + r32;
#pragma unroll
        for (int i = 0; i < 2; ++i) {
#pragma unroll
            for (int r = 0; r < 16; ++r) { const unsigned kw = kl[i][r >> 3][(r >> 1) & 3]; const float kv = (r & 1) ? bfhi(kw) : bflo(kw); Cacc[i][r] = decay * Cacc[i][r] + f2 * kv; }
#pragma unroll
            for (int g4 = 0; g4 < 4; ++g4) { const int ch = 4 * (2 * tb + i) + g4; u2 wv; wv.x = cvtpk(Cacc[i][4 * g4], Cacc[i][4 * g4 + 1]); wv.y = cvtpk(Cacc[i][4 * g4 + 2], Cacc[i][4 * g4 + 3]);
                *(LAS u2*)(Cw + dv * 256 + ((ch ^ (dv & 15)) * 16) + 8 * hi) = wv; }
        }
        if (tid < 128) { nreg = decay * nreg + f2 * nl; *(LAS unsigned short*)(Cw + 128 * 256 + tid * 2) = (unsigned short)f2bf(nreg); }
        mprev = b63 + M63;
    }
    __syncthreads();
#undef ML_PREFETCH
}
__device__ __forceinline__ void p2a_mix(Frame& F, const Args& a) {
    const bf16* P = (const bf16*)(a.ws + WS_P);
    for (int u = F.vcu; u < ml::NCID; u += F.G) mlstm_local_unit(F, u, P, (const float*)(a.ws + WS_GPRE), a.in[4], a.in[5], a.in[6], a.ws);
}
__device__ __forceinline__ void p2b_mix(Frame& F, const Args& a) {
    const bf16* P = (const bf16*)(a.ws + WS_P); bf16* MIX = (bf16*)(a.ws + WS_MIX);
    const int NSEQ = BATCH * 4;
    if ((int)blockIdx.x < NSEQ && F.G > NSEQ) {
        if (a.pad != 2) mlstm_scan(F, (int)blockIdx.x >> 2, (int)blockIdx.x & 3, P, MIX, a.ws);
    } else {
        const int nb = F.G > NSEQ ? F.G - NSEQ : F.G, b0 = F.G > NSEQ ? (int)blockIdx.x - NSEQ : (int)blockIdx.x;
        if (a.pad != 1) for (int u = b0; u < BATCH * 2 * 16; u += nb) swa_unit(F, u >> 5, (u >> 4) & 1, u & 15, P, a.in[7], MIX);
    }
}
__device__ __forceinline__ void p0_prologue(Frame& F, const Args& a) {
    unsigned char* ws = a.ws;
    LAS float* scr = (LAS float*)(F.lds + F.wave * 8448);
    LAS float* wgT = (LAS float*)(F.lds + 73728);
    const int gw = F.vcu * NWAVES + F.wave, NGW = F.G * NWAVES;
    {
        const float* w_in = a.in[3]; const float* gm = a.in[2];
        for (int i = F.tid; i < 8192; i += NWAVES * 64) { const int k = i >> 3, c = i & 7; wgT[c * 1024 + k] = gm[k] * w_in[(size_t)k * IN_COLS + O_G + c]; }
    }
    constexpr int I_IN = 16 * (NP / 32), I_KV = 16 * 64, I_SQ = 16 * 32, I_UP = 16 * (NU / 32), I_DN = (FF / 64) * 32;
    constexpr int NITEMS = I_IN + I_KV + 3 * I_SQ + I_UP + I_DN;
    for (int it = gw; it < NITEMS; it += NGW) {
        int r = it;
        if (r < I_IN) { const int nb = r % (NP / 32), kb = r / (NP / 32); p0_transpose_item(a.in[3], D, IN_COLS, 32 * nb, a.in[2], (bf16*)(ws + WS_WIN), 32 * nb, scr, kb, F.lane); continue; } r -= I_IN;
        if (r < I_KV) { const int nb = r % 64, kb = r / 64; p0_transpose_item(a.in[12], D, 2048, 32 * nb, a.in[10], (bf16*)(ws + WS_WKV), 32 * nb, scr, kb, F.lane); continue; } r -= I_KV;
        if (r < I_SQ) { const int nb = r % 32, kb = r / 32; p0_transpose_item(a.in[8], D, D, 32 * nb, nullptr, (bf16*)(ws + WS_WOUT), 32 * nb, scr, kb, F.lane); continue; } r -= I_SQ;
        if (r < I_SQ) { const int nb = r % 32, kb = r / 32; p0_transpose_item(a.in[11], D, D, 32 * nb, a.in[9], (bf16*)(ws + WS_WQ), 32 * nb, scr, kb, F.lane); continue; } r -= I_SQ;
        if (r < I_SQ) { const int nb = r % 32, kb = r / 32; p0_transpose_item(a.in[13], D, D, 32 * nb, nullptr, (bf16*)(ws + WS_WO), 32 * nb, scr, kb, F.lane); continue; } r -= I_SQ;
        if (r < I_UP) { const int nb = r % (NU / 32), kb = r / (NU / 32); const int c0 = 32 * nb < FF ? 32 * nb : 32 * nb - FF, dr = (c0 >> 7) * 256 + (32 * nb < FF ? 0 : 128) + (c0 & 127);
            p0_transpose_item(a.in[15], D, NU, 32 * nb, a.in[14], (bf16*)(ws + WS_WUP), dr, scr, kb, F.lane); continue; } r -= I_UP;
        { const int nb = r % 32, kb = r / 32; p0_transpose_item(a.in[18], FF, D, 32 * nb, nullptr, (bf16*)(ws + WS_WDN), 32 * nb, scr, kb, F.lane); }
    }
    __syncthreads();
    float* rstd0 = (float*)(ws + WS_RSTD0); float* gpre = (float*)(ws + WS_GPRE); bf16* XB = (bf16*)(ws + WS_XB);
    for (int m = gw; m < M; m += 2 * NGW) {
        f32x4 va[4], vc[4];
        row_load(a.in[0] + (size_t)m * D, F.lane, va); row_load(a.in[0] + (size_t)(m + NGW) * D, F.lane, vc);
#pragma unroll
        for (int hlf = 0; hlf < 2; ++hlf) {
            const int mm = m + hlf * NGW; const f32x4 (&v)[4] = hlf ? vc : va;
            const float ssq = row_to_bf16(XB + (size_t)mm * D, F.lane, v);
            const float rstd = 1.0f / sqrtf(ssq * (1.0f / D) + EPS);
            float ga[8];
#pragma unroll
            for (int c = 0; c < 8; ++c) { float s = 0.f;
#pragma unroll
                for (int j = 0; j < 4; ++j) { const f32x4 w = *(const LAS f32x4*)(wgT + c * 1024 + 256 * j + 4 * F.lane); s += (v[j][0] * w[0] + v[j][1] * w[1]) + (v[j][2] * w[2] + v[j][3] * w[3]); }
                ga[c] = wave_sum(s) * rstd; }
            if (F.lane == 0) { rstd0[mm] = rstd; *(f32x4*)(gpre + (size_t)mm * 8) = (f32x4){ga[0], ga[1], ga[2], ga[3]}; *(f32x4*)(gpre + (size_t)mm * 8 + 4) = (f32x4){ga[4], ga[5], ga[6], ga[7]}; }
        }
    }
    float* rstdm = (float*)(ws + WS_RSTDM); bf16* MEMB = (bf16*)(ws + WS_MEMB);
    for (int m = gw; m < MMEM; m += NGW) {
        f32x4 v[4];
        row_load(a.in[1] + (size_t)m * D, F.lane, v);
        const float ssq = row_to_bf16(MEMB + (size_t)m * D, F.lane, v);
        if (F.lane == 0) rstdm[m] = 1.0f / sqrtf(ssq * (1.0f / D) + EPS);
    }
}
__device__ __forceinline__ void act_fixup_panel(Frame& F, const Args& a, int pm) {
    bf16* ACT = (bf16*)(a.ws + WS_ACT); const float* SB = (const float*)(a.ws + WS_SB); const float* cw = a.in[16]; const float* cb = a.in[17];
    for (int it = F.tid; it < 4 * (FF / 4); it += NWAVES * 64) {
        const int gl = it / (FF / 4), ch = 4 * (it % (FF / 4)), gid = 4 * pm + gl;
        const float* s = SB + (size_t)gid * 6 * FF + ch;
        const f32x4 w0 = *(const f32x4*)(cw + ch), w1 = *(const f32x4*)(cw + FF + ch), w2 = *(const f32x4*)(cw + 2 * FF + ch), bb = *(const f32x4*)(cb + ch);
        f32x4 gm2 = (f32x4){0.f, 0.f, 0.f, 0.f}, gm1 = gm2;
        if ((gid & 31) != 0) { gm2 = *(const f32x4*)(s - 6 * FF); gm1 = *(const f32x4*)(s - 5 * FF); }
        const f32x4 g0 = *(const f32x4*)(s + 2 * FF), g1 = *(const f32x4*)(s + 3 * FF), v0 = *(const f32x4*)(s + 4 * FF), v1 = *(const f32x4*)(s + 5 * FF);
        float r0[4], r1[4];
#pragma unroll
        for (int e = 0; e < 4; ++e) { const float y0 = w2[e] * g0[e] + w1[e] * gm1[e] + w0[e] * gm2[e] + bb[e], y1 = w2[e] * g1[e] + w1[e] * g0[e] + w0[e] * gm1[e] + bb[e];
            r0[e] = y0 * __builtin_amdgcn_rcpf(1.0f + __builtin_amdgcn_exp2f(-1.4426950408889634f * y0)) * v0[e]; r1[e] = y1 * __builtin_amdgcn_rcpf(1.0f + __builtin_amdgcn_exp2f(-1.4426950408889634f * y1)) * v1[e]; }
        typedef unsigned u2 __attribute__((ext_vector_type(2)));
        u2 o0, o1; o0.x = pk2(r0[0], r0[1]); o0.y = pk2(r0[2], r0[3]); o1.x = pk2(r1[0], r1[1]); o1.y = pk2(r1[2], r1[3]);
        *(u2*)(ACT + (size_t)(64 * gid) * FF + ch) = o0; *(u2*)(ACT + (size_t)(64 * gid + 1) * FF + ch) = o1;
    }
}
__device__ __forceinline__ void p10_final(Frame& F, const Args& a) {
    const int gw = F.vcu * NWAVES + F.wave, NGW = F.G * NWAVES;
    const float* gf = a.in[19]; const pg8::RsParts rs{(const float*)(a.ws + WS_SSQ3)};
    f32x4 gv[4];
#pragma unroll
    for (int j = 0; j < 4; ++j) gv[j] = ((const f32x4*)gf)[64 * j + F.lane];
    for (int m = gw; m < M; m += NGW) {
        const float r = rs.get(m);
        GAS f32x4* xr = (GAS f32x4*)(a.out + (size_t)m * D) + F.lane;
#pragma unroll
        for (int j = 0; j < 4; ++j) { const f32x4 v = xr[64 * j]; xr[64 * j] = v * r * gv[j]; }
    }
}

#ifndef PROBE_REP
#define PROBE_REP (-1)
#endif
#ifndef PROBE_SUB
#define PROBE_SUB 0
#endif
#ifndef PG8_SP2
#define PG8_SP2 true
#endif
#ifndef PG8_ALIGN
#define PG8_ALIGN true
#endif
enum { PH_PRO = 0, PH_G1 = 1, PH_MIXA = 2, PH_MIXB = 3, PH_G2 = 4, PH_G3 = 5, PH_XAT = 6, PH_G4 = 7, PH_G5 = 8, PH_G6 = 9, PH_FIN = 10, PH_N = 11 };

__device__ __forceinline__ bool phase_in(Frame& F, int lo, int hi, int k) {
    if (!(lo <= k && k < hi)) return false;
    int t_ = threadIdx.x; asm volatile("" : "+v"(t_)); F.tid = t_; F.lane = t_ & 63; return true;
}
__global__ void __launch_bounds__(NWAVES * 64, 2) mk_fwd(Args args) {
    extern __shared__ __attribute__((aligned(16))) unsigned char lds[];
    Frame F;
    F.lds = (LAS unsigned char*)lds;
    F.MISC = (volatile LAS unsigned*)(F.lds + MISC_OFF);
    F.tid = threadIdx.x; F.lane = F.tid & 63; F.wave = __builtin_amdgcn_readfirstlane(F.tid >> 6);
    F.G = gridDim.x; { const int bx = blockIdx.x; F.vcu = (F.G % 8 == 0) ? (bx % 8) * (F.G / 8) + bx / 8 : bx; }
    unsigned char* ws = args.ws;
    F.ctl = (gu32*)(ws + WS_CTL);
    for (int u = F.tid; u < (LDS_BYTES - LDSCTL_OFF) / 4; u += NWAVES * 64) ((LAS unsigned*)(F.lds + LDSCTL_OFF))[u] = 0u;
    __syncthreads();
    const int lo = args.ph_lo, hi = args.ph_hi;
    XcdBarrier bar = xcd_barrier_post((unsigned*)(F.ctl + CW_BAR) + args.li * XCD_BAR_WORDS, F.MISC + 8);
#define IN(k) (phase_in(F, lo, hi, (k)))
#define SEAM(k) do { if (lo <= (k) && (k) + 1 < hi) xcd_barrier(bar); } while (0)
    bf16* XB = (bf16*)(ws + WS_XB); bf16* P = (bf16*)(ws + WS_P); bf16* MIX = (bf16*)(ws + WS_MIX); bf16* QX = (bf16*)(ws + WS_QX); bf16* XO = (bf16*)(ws + WS_XO);
    const int G = F.G, bx = (int)blockIdx.x;

    if (IN(PH_PRO)) { p0_prologue(F, args); SEAM(PH_PRO); }
    if (IN(PH_G1)) {
        { pg8::Gemm g{XB, D, (const bf16*)(ws + WS_WIN), M, NP, D}; pg8::StaticOrder S; S.init(M, NP, G, bx);
          pg8::EpiScaleBf16<pg8::RsArr> E{P, NP, {(const float*)(ws + WS_RSTD0)}};
          pg8::gemm_phase<pg8::EpiScaleBf16<pg8::RsArr>, pg8::StaticOrder, PG8_ALIGN, PG8_SP2>(F.lds + RING_OFF, g, S, E); }
        { pg8::Gemm g{(const bf16*)(ws + WS_MEMB), D, (const bf16*)(ws + WS_WKV), MMEM, 2048, D}; pg8::StaticOrder S; S.init(MMEM, 2048, G, (bx + G / 2) % G);
          pg8::EpiScaleBf16<pg8::RsArr> E{(bf16*)(ws + WS_KVM), 2048, {(const float*)(ws + WS_RSTDM)}};
          pg8::gemm_phase<pg8::EpiScaleBf16<pg8::RsArr>, pg8::StaticOrder, PG8_ALIGN, PG8_SP2>(F.lds + RING_OFF, g, S, E); }
        SEAM(PH_G1);
    }
    if (IN(PH_MIXA)) { p2a_mix(F, args); SEAM(PH_MIXA); }
    if (IN(PH_MIXB)) { p2b_mix(F, args); SEAM(PH_MIXB); }
    if (IN(PH_G2)) {
        pg8::Gemm g{MIX, D, (const bf16*)(ws + WS_WOUT), M, D, D}; pg8::StaticOrder S; S.init(M, D, G, bx);
        pg8::EpiResid<1> E{XB, args.in[0], nullptr, (float*)(ws + WS_SSQ1), D};
        pg8::gemm_phase<pg8::EpiResid<1>, pg8::StaticOrder, PG8_ALIGN, PG8_SP2>(F.lds + RING_OFF, g, S, E);
        SEAM(PH_G2);
    }
    if (IN(PH_G3)) {
        pg8::Gemm g{XB, D, (const bf16*)(ws + WS_WQ), M, D, D}; pg8::StaticOrder S; S.init(M, D, G, bx);
        pg8::EpiScaleBf16<pg8::RsOne> E{QX, D, {}};
        pg8::gemm_phase<pg8::EpiScaleBf16<pg8::RsOne>, pg8::StaticOrder, PG8_ALIGN, PG8_SP2>(F.lds + RING_OFF, g, S, E);
        SEAM(PH_G3);
    }
    if (IN(PH_XAT)) { p5_xattn(F, args); SEAM(PH_XAT); }
    if (IN(PH_G4)) {
        pg8::Gemm g{XO, D, (const bf16*)(ws + WS_WO), M, D, D}; pg8::StaticOrder S; S.init(M, D, G, bx);
        pg8::EpiResid<0> E{XB, nullptr, nullptr, (float*)(ws + WS_SSQ2), D};
        pg8::gemm_phase<pg8::EpiResid<0>, pg8::StaticOrder, PG8_ALIGN, PG8_SP2>(F.lds + RING_OFF, g, S, E);
        SEAM(PH_G4);
    }
    if (IN(PH_G5)) {
        pg8::Gemm g{XB, D, (const bf16*)(ws + WS_WUP), M, NU, D}; pg8::StaticOrder S; S.init(M, NU, G, bx);
        pg8::EpiGateConv E{(bf16*)(ws + WS_ACT), {(const float*)(ws + WS_SSQ2)}, args.in[16], args.in[17], (float*)(ws + WS_SB)};
        pg8::gemm_phase<pg8::EpiGateConv, pg8::StaticOrder, PG8_ALIGN, PG8_SP2>(F.lds + RING_OFF, g, S, E);
        SEAM(PH_G5);
    }
    if (IN(PH_G6)) {
        pg8::Gemm g{(const bf16*)(ws + WS_ACT), FF, (const bf16*)(ws + WS_WDN), M, D, FF}; pg8::StaticOrder S; S.init(M, D, G, bx);
        { pg8::Unit uu; int last = -1; for (int i = 0; S.next(i, uu); ++i) if (uu.pm != last) { act_fixup_panel(F, args, uu.pm); last = uu.pm; }
          asm volatile("s_waitcnt vmcnt(0)" ::: "memory"); __syncthreads(); if (F.tid == 0) { __builtin_amdgcn_fence(__ATOMIC_ACQUIRE, "agent"); asm volatile("s_waitcnt vmcnt(0)" ::: "memory"); } __syncthreads(); }
        pg8::EpiResid<2> E{XB, nullptr, args.out, (float*)(ws + WS_SSQ3), D};
        pg8::gemm_phase<pg8::EpiResid<2>, pg8::StaticOrder, PG8_ALIGN, PG8_SP2>(F.lds + RING_OFF, g, S, E);
        SEAM(PH_G6);
    }
    if (IN(PH_FIN)) { p10_final(F, args); }
#undef IN
#undef SEAM
}
extern "C" void kernel_launch(void* const* d_in, const int* in_sizes, int n_in, void* d_out, int out_size, void* d_ws, size_t ws_size, hipStream_t stream) {
    static int grid = 0;
    if (grid == 0) {
        if (n_in != 20 || in_sizes[0] != M * D || out_size != M * D || ws_size < WS_END) { fprintf(stderr, "kernel_launch: shape/workspace mismatch: n_in %d in0 %d out %d ws %zu (need %zu)\n", n_in, n_in > 0 ? in_sizes[0] : -1, out_size, ws_size, (size_t)WS_END); grid = -1; return; }
        int dev = 0, cus = 0, per_cu = 0;
        if (hipGetDevice(&dev) != hipSuccess || hipDeviceGetAttribute(&cus, hipDeviceAttributeMultiprocessorCount, dev) != hipSuccess) { fprintf(stderr, "kernel_launch: device query failed\n"); grid = -1; return; }
        if (hipFuncSetAttribute((const void*)mk_fwd, hipFuncAttributeMaxDynamicSharedMemorySize, LDS_BYTES) != hipSuccess) { fprintf(stderr, "kernel_launch: hipFuncSetAttribute failed\n"); grid = -1; return; }
        if (hipOccupancyMaxActiveBlocksPerMultiprocessor(&per_cu, (const void*)mk_fwd, NWAVES * 64, LDS_BYTES) != hipSuccess || per_cu < 1) { fprintf(stderr, "kernel_launch: occupancy query reports %d workgroups per CU\n", per_cu); (void)hipGetLastError(); grid = -1; return; }
        grid = cus;
    }
    if (grid < 0) return;
    (void)hipMemsetAsync((char*)d_ws + WS_CTL, 0, CTL_ZERO_BYTES, stream);
    Args a{};
    for (int i = 0; i < 20; ++i) a.in[i] = (const float*)d_in[i];
    a.out = (float*)d_out; a.ws = (unsigned char*)d_ws;
    unsigned char* ws = (unsigned char*)d_ws;
    auto launch = [&](int lo, int hi, int li) { a.ph_lo = lo; a.ph_hi = hi; a.li = li; hipLaunchKernelGGL(mk_fwd, dim3(grid), dim3(NWAVES * 64), LDS_BYTES, stream, a); };
#if PROBE_REP >= 0
    a.pad = PROBE_SUB; launch(PH_PRO, PROBE_REP + 1, 0); a.pad = 0; launch(PROBE_REP, PH_N, 1);
#else
    launch(PH_PRO, PH_N, 0);
#endif
}
```

```cpp
#include <hip/hip_runtime.h>
#include <cstdio>
#include <cstdint>
namespace pg8 {
#define PG8_LAS __attribute__((address_space(3)))
typedef unsigned short bf16_t;
typedef short bf16x8 __attribute__((ext_vector_type(8)));
typedef float f32x4 __attribute__((ext_vector_type(4)));
typedef unsigned u32x4 __attribute__((ext_vector_type(4)));
constexpr int BM = 256, BK = 64, HALF = 128, HTB = HALF * BK * 2  , STAGE_BYTES = 8 * HTB, NXCD = 8, WGM = 8;

__host__ __device__ __forceinline__ int lds_byte(int r, int c) { const int st = (r >> 4) * 2 + (c >> 5), rr = r & 15, cc = c & 31, ob = rr * 64 + cc * 2; return st * 1024 + (ob ^ (((ob >> 9) & 1) << 5)); }
__host__ __device__ __forceinline__ void stage_rc(int b, int& R, int& C) { const int st = b / 1024, sb = b % 1024, swz = sb ^ (((sb >> 9) & 1) << 5); R = (st >> 1) * 16 + swz / 64; C = (st & 1) * 32 + (swz % 64) / 2; }
__host__ __device__ __forceinline__ int perm32(int rho) { const int n = rho >> 4, i = rho & 15; return 8 * (i >> 2) + 4 * n + (i & 3); }

struct Unit { int pm, pn; };
struct Gemm { const bf16_t* A; int lda; const bf16_t* Bt; int M, N, K; };

struct StaticOrder {
    int nM, nN, nwg, G, c;
    __host__ __device__ void init(int M, int N, int G_, int c_) { nM = M / BM; nN = N / BM; nwg = nM * nN; G = G_; c = c_; }
    __host__ __device__ bool next(int i, Unit& u) const {
        const long L = (long)i * G + c; if (L >= nwg) return false;
        int wgid = (int)L; { const int q = nwg / NXCD, r = nwg % NXCD, xcd = wgid % NXCD, off = wgid / NXCD; wgid = (xcd < r ? xcd * (q + 1) : r * (q + 1) + (xcd - r) * q) + off; }
        const int nig = WGM * nN, gid = wgid / nig, fm = gid * WGM, gsz = (nM - fm) < WGM ? (nM - fm) : WGM;
        u.pm = fm + ((wgid % nig) % gsz); u.pn = (wgid % nig) / gsz; return true;
    }
    __device__ __forceinline__ void a_ready(const Unit&) const {}
    __device__ __forceinline__ void done(const Unit&) const {}
};

__device__ __forceinline__ unsigned cvt_pk_bf16(float lo, float hi) { unsigned r; asm volatile("v_cvt_pk_bf16_f32 %0, %1, %2" : "=v"(r) : "v"(lo), "v"(hi)); return r; }
typedef float f32x2 __attribute__((ext_vector_type(2)));
constexpr float RMS_EPS = 1e-6f;
struct RsOne   { __device__ __forceinline__ float get(int) const { return 1.0f; } };
struct RsArr   { const float* r; __device__ __forceinline__ float get(int row) const { return r[row]; } };
struct RsParts { const float* p;
    __device__ __forceinline__ float get(int row) const { const f32x4* q = (const f32x4*)(p + (size_t)row * 16); const f32x4 a = q[0], b = q[1], c = q[2], d = q[3];
        const float s = ((a[0] + a[1]) + (a[2] + a[3])) + ((b[0] + b[1]) + (b[2] + b[3])) + ((c[0] + c[1]) + (c[2] + c[3])) + ((d[0] + d[1]) + (d[2] + d[3]));
        return 1.0f / sqrtf(s * (1.0f / 1024.0f) + RMS_EPS); } };
template <class RS> struct EpiScaleBf16 {
    static constexpr bool PERM = true, AFTER_DRAIN = false;
    bf16_t* O; int ldc; RS rs;
    __device__ __forceinline__ void operator()(const f32x4 (&acc)[2][2][4][2], const Unit& u, int wr, int wc, int fr, int fq) const {
        const int row0 = u.pm * BM + wr * 64 + fr, col0 = u.pn * BM + wc * 32 + 8 * fq;
#pragma unroll
        for (int ai = 0; ai < 2; ++ai)
#pragma unroll
            for (int m = 0; m < 4; ++m) { const int row = row0 + ai * HALF + m * 16; const float sc = rs.get(row); bf16_t* rowp = O + (size_t)row * ldc + col0;
#pragma unroll
                for (int bj = 0; bj < 2; ++bj) { const f32x4 v0 = acc[ai][bj][m][0] * sc, v1 = acc[ai][bj][m][1] * sc;
                    u32x4 w; w.x = cvt_pk_bf16(v0[0], v0[1]); w.y = cvt_pk_bf16(v0[2], v0[3]); w.z = cvt_pk_bf16(v1[0], v1[1]); w.w = cvt_pk_bf16(v1[2], v1[3]);
                    *(u32x4*)(rowp + bj * HALF) = w; } }
    }
};
template <int MODE> struct EpiResid {
    static constexpr bool PERM = true, AFTER_DRAIN = false;
    bf16_t* xb; const float* resf; float* out; float* ssq; int ldc;
    __device__ __forceinline__ void operator()(const f32x4 (&acc)[2][2][4][2], const Unit& u, int wr, int wc, int fr, int fq) const {
        const int row0 = u.pm * BM + wr * 64 + fr, col0 = u.pn * BM + wc * 32 + 8 * fq;
#pragma unroll
        for (int ai = 0; ai < 2; ++ai)
#pragma unroll
          for (int mh = 0; mh < (MODE == 1 ? 2 : 1); ++mh) {
            constexpr int MR = (MODE == 1 ? 2 : 4);
            f32x4 pre[MR][2][2];
#pragma unroll
            for (int mm = 0; mm < MR; ++mm) { const size_t off = (size_t)(row0 + ai * HALF + (mh * MR + mm) * 16) * ldc + col0;
#pragma unroll
                for (int bj = 0; bj < 2; ++bj) {
                    if (MODE == 1) { pre[mm][bj][0] = *(const f32x4*)(resf + off + bj * HALF); pre[mm][bj][1] = *(const f32x4*)(resf + off + bj * HALF + 4); }
                    else { const u32x4 p = *(const u32x4*)(xb + off + bj * HALF);
#pragma unroll
                        for (int e = 0; e < 2; ++e) { pre[mm][bj][0][2 * e] = __builtin_bit_cast(float, p[e] << 16); pre[mm][bj][0][2 * e + 1] = __builtin_bit_cast(float, p[e] & 0xffff0000u);
                            pre[mm][bj][1][2 * e] = __builtin_bit_cast(float, p[2 + e] << 16); pre[mm][bj][1][2 * e + 1] = __builtin_bit_cast(float, p[2 + e] & 0xffff0000u); } } } }
#pragma unroll
            for (int mm = 0; mm < MR; ++mm) { const int m = mh * MR + mm, row = row0 + ai * HALF + m * 16; const size_t off = (size_t)row * ldc + col0; float ss = 0.f;
#pragma unroll
                for (int bj = 0; bj < 2; ++bj) { const f32x4 o0 = pre[mm][bj][0] + acc[ai][bj][m][0], o1 = pre[mm][bj][1] + acc[ai][bj][m][1];
                    ss += ((o0[0] * o0[0] + o0[1] * o0[1]) + (o0[2] * o0[2] + o0[3] * o0[3])) + ((o1[0] * o1[0] + o1[1] * o1[1]) + (o1[2] * o1[2] + o1[3] * o1[3]));
                    if (MODE == 2) { *(f32x4*)(out + off + bj * HALF) = o0; *(f32x4*)(out + off + bj * HALF + 4) = o1; }
                    else { u32x4 w; w.x = cvt_pk_bf16(o0[0], o0[1]); w.y = cvt_pk_bf16(o0[2], o0[3]); w.z = cvt_pk_bf16(o1[0], o1[1]); w.w = cvt_pk_bf16(o1[2], o1[3]); *(u32x4*)(xb + off + bj * HALF) = w; } }
                ss += __shfl_xor(ss, 16); ss += __shfl_xor(ss, 32);
                if (fq == 0) ssq[(size_t)row * 16 + u.pn * 4 + wc] = ss; }
            asm volatile("" ::: "memory");
          }
    }
};
__device__ __forceinline__ float dpp_shr1(float cur, float prv) {
    const int t = __builtin_amdgcn_update_dpp(0, __builtin_bit_cast(int, prv), 0x121, 0xf, 0xf, false);
    return __builtin_bit_cast(float, __builtin_amdgcn_update_dpp(t, __builtin_bit_cast(int, cur), 0x111, 0xf, 0xf, false)); }
__device__ __forceinline__ float dpp_shr2(float cur, float prv) {
    const int t = __builtin_amdgcn_update_dpp(0, __builtin_bit_cast(int, prv), 0x122, 0xf, 0xf, false);
    return __builtin_bit_cast(float, __builtin_amdgcn_update_dpp(t, __builtin_bit_cast(int, cur), 0x112, 0xf, 0xf, false)); }
struct EpiGateConv {
    static constexpr bool PERM = true, AFTER_DRAIN = false;
    static constexpr int FFD = 2816;
    bf16_t* ACT; RsParts rs; const float* cw; const float* cb; float* SB;
    __device__ __forceinline__ void operator()(const f32x4 (&acc)[2][2][4][2], const Unit& u, int wr, int wc, int fr, int fq) const {
        const int ch0 = 128 * u.pn + 32 * wc + 8 * fq;
        f32x4 w0[2], w1[2], w2[2], bb[2];
#pragma unroll
        for (int n = 0; n < 2; ++n) { w0[n] = *(const f32x4*)(cw + ch0 + 4 * n); w1[n] = *(const f32x4*)(cw + FFD + ch0 + 4 * n); w2[n] = *(const f32x4*)(cw + 2 * FFD + ch0 + 4 * n); bb[n] = *(const f32x4*)(cb + ch0 + 4 * n); }
#pragma unroll
        for (int ai = 0; ai < 2; ++ai) {
            f32x4 Gp[2] = {(f32x4){0.f, 0.f, 0.f, 0.f}, (f32x4){0.f, 0.f, 0.f, 0.f}};
            const int grow = u.pm * BM + ai * HALF + wr * 64, grp = grow >> 6;
#pragma unroll
            for (int m = 0; m < 4; ++m) {
                const int row = grow + m * 16 + fr; const float sc = rs.get(row);
                f32x4 G[2], V[2]; u32x4 w;
#pragma unroll
                for (int n = 0; n < 2; ++n) { G[n] = acc[ai][0][m][n] * sc; V[n] = acc[ai][1][m][n] * sc; }
#pragma unroll
                for (int n = 0; n < 2; ++n) { float a[4];
#pragma unroll
                    for (int e = 0; e < 4; ++e) { const float g1 = dpp_shr1(G[n][e], Gp[n][e]), g2 = dpp_shr2(G[n][e], Gp[n][e]);
                        const float y = __builtin_fmaf(w2[n][e], G[n][e], __builtin_fmaf(w1[n][e], g1, __builtin_fmaf(w0[n][e], g2, bb[n][e])));
                        a[e] = y * __builtin_amdgcn_rcpf(1.0f + __builtin_amdgcn_exp2f(-1.4426950408889634f * y)) * V[n][e]; }
                    w[2 * n] = cvt_pk_bf16(a[0], a[1]); w[2 * n + 1] = cvt_pk_bf16(a[2], a[3]); }
                if (!(m == 0 && fr < 2)) *(u32x4*)(ACT + (size_t)row * FFD + ch0) = w;
                if (m == 0 && fr < 2) { float* sb = SB + ((size_t)grp * 6 + 2 + fr) * FFD + ch0; *(f32x4*)sb = G[0]; *(f32x4*)(sb + 4) = G[1]; sb += 2 * FFD; *(f32x4*)sb = V[0]; *(f32x4*)(sb + 4) = V[1]; }
                if (m == 3 && fr >= 14) { float* sb = SB + ((size_t)grp * 6 + (fr - 14)) * FFD + ch0; *(f32x4*)sb = G[0]; *(f32x4*)(sb + 4) = G[1]; }
                Gp[0] = G[0]; Gp[1] = G[1];
            }
        }
    }
};
template <class Epi, class Sched, bool ALIGN_EPI = false, bool SP2 = false>
__device__ __forceinline__ void gemm_phase(PG8_LAS unsigned char* lds, const Gemm g, const Sched& S, const Epi& E) {
    const int tid = threadIdx.x, wid = __builtin_amdgcn_readfirstlane(tid >> 6), lane = tid & 63, wr = wid >> 2, wc = wid & 3, fr = lane & 15, fq = lane >> 4;
    const int K = g.K, nt = K / BK;
    unsigned voffA[2], voffB[2];
#pragma unroll
    for (int i = 0; i < 2; ++i) { int R, C; stage_rc(tid * 16 + i * 8192, R, C); const int Rb = Epi::PERM ? ((R & ~31) + perm32(R & 31)) : R;
        voffA[i] = (unsigned)(R * g.lda + C) * 2u; voffB[i] = (unsigned)(Rb * K + C) * 2u; }
    const size_t kstep = (size_t)(BK * 2);
    const size_t hstepA = (size_t)HALF * g.lda * 2, hstepB = (size_t)HALF * K * 2;
    const size_t tstepA = 2 * hstepA, tstepB = 2 * hstepB;
    const unsigned ldsw = (unsigned)wid * 1024u;
    const int aoff = lds_byte(wr * 64 + fr, fq * 8), boff = lds_byte(wc * 32 + fr, fq * 8);
#define PG8_SA(b, h) (((b) * 2 + (h)) * HTB)
#define PG8_SB(b, h) ((4 + (b) * 2 + (h)) * HTB)
#define PG8_STAGE(bufoff, gbase, voff) do { _Pragma("unroll") for (int _i = 0; _i < 2; ++_i) \
        __builtin_amdgcn_global_load_lds((const unsigned*)((const char*)(gbase) + (voff)[_i]), (PG8_LAS unsigned*)(lds + (bufoff) + ldsw + _i * 8192), 16, 0, 0); } while (0)
#define PG8_LDA(dst, b, h) do { _Pragma("unroll") for (int m = 0; m < 4; ++m) _Pragma("unroll") for (int k = 0; k < 2; ++k) dst[m][k] = *(const PG8_LAS bf16x8*)(lds + PG8_SA(b, h) + aoff + m * 2048 + k * 1024); } while (0)
#define PG8_LDB(dst, b, h) do { _Pragma("unroll") for (int n = 0; n < 2; ++n) _Pragma("unroll") for (int k = 0; k < 2; ++k) dst[n][k] = *(const PG8_LAS bf16x8*)(lds + PG8_SB(b, h) + boff + n * 2048 + k * 1024); } while (0)
#define PG8_MMA(ai, bj, At, Bt) do { __builtin_amdgcn_s_setprio(1); _Pragma("unroll") for (int m = 0; m < 4; ++m) _Pragma("unroll") for (int n = 0; n < 2; ++n) _Pragma("unroll") for (int k = 0; k < 2; ++k) \
        acc[ai][bj][m][n] = __builtin_amdgcn_mfma_f32_16x16x32_bf16(Bt[n][k], At[m][k], acc[ai][bj][m][n], 0, 0, 0); __builtin_amdgcn_s_setprio(0); } while (0)
#define PG8_WAIT_V(n) asm volatile("s_waitcnt vmcnt(" #n ")" ::: "memory")
#define PG8_WAIT_L(n) asm volatile("s_waitcnt lgkmcnt(" #n ")" ::: "memory")
#define PG8_BAR __builtin_amdgcn_s_barrier()
#define PG8_SCHED __builtin_amdgcn_sched_barrier(0)
    Unit cur, nxt; int ui = 0;
    if (!S.next(0, cur)) return;
    f32x4 acc[2][2][4][2];
#pragma unroll
    for (int a = 0; a < 2; ++a)
#pragma unroll
        for (int b = 0; b < 2; ++b)
#pragma unroll
            for (int m = 0; m < 4; ++m)
#pragma unroll
                for (int n = 0; n < 2; ++n) acc[a][b][m][n] = (f32x4){0.f, 0.f, 0.f, 0.f};
    bf16x8 At[4][2], B0[2][2], B1[2][2];
    const char* cA = (const char*)g.A + (size_t)cur.pm * tstepA; const char* cB = (const char*)g.Bt + (size_t)cur.pn * tstepB;
    S.a_ready(cur);
    if constexpr (SP2) {
        PG8_STAGE(PG8_SB(0, 0), cB, voffB); PG8_STAGE(PG8_SB(0, 1), cB + hstepB, voffB); PG8_STAGE(PG8_SA(0, 0), cA, voffA); PG8_STAGE(PG8_SA(0, 1), cA + hstepA, voffA);
        if (wr == 1) PG8_BAR;
        PG8_WAIT_V(2); PG8_BAR;
        PG8_STAGE(PG8_SB(1, 0), cB + kstep, voffB); PG8_STAGE(PG8_SA(1, 0), cA + kstep, voffA); PG8_STAGE(PG8_SB(1, 1), cB + hstepB + kstep, voffB);
        PG8_WAIT_V(6); PG8_BAR;
    } else {
        PG8_STAGE(PG8_SB(0, 0), cB, voffB); PG8_STAGE(PG8_SA(0, 0), cA, voffA); PG8_STAGE(PG8_SB(0, 1), cB + hstepB, voffB); PG8_STAGE(PG8_SA(0, 1), cA + hstepA, voffA);
        if (wr == 1) PG8_BAR;
        PG8_WAIT_V(4); PG8_BAR;
        PG8_STAGE(PG8_SB(1, 0), cB + kstep, voffB); PG8_STAGE(PG8_SA(1, 0), cA + kstep, voffA); PG8_STAGE(PG8_SB(1, 1), cB + hstepB + kstep, voffB);
        PG8_WAIT_V(6); PG8_BAR;
    }
    for (;;) {
        const bool has_next = S.next(ui + 1, nxt);
        const char* nA = has_next ? (const char*)g.A + (size_t)nxt.pm * tstepA : cA; const char* nB = has_next ? (const char*)g.Bt + (size_t)nxt.pn * tstepB : cB;
        for (int t = 0; t < nt; t += 2) {
            const bool last = (t == nt - 2);
            const char* a1 = cA + (size_t)(t + 1) * kstep;
            const char* a2 = last ? nA : cA + (size_t)(t + 2) * kstep; const char* b2 = last ? nB : cB + (size_t)(t + 2) * kstep;
            const char* a3 = a2 + kstep; const char* b3 = b2 + kstep;
            if (last && has_next) S.a_ready(nxt);
            if constexpr (SP2) {
            PG8_LDB(B0, 0, 0); PG8_LDB(B1, 0, 1); PG8_SCHED; PG8_LDA(At, 0, 0); PG8_STAGE(PG8_SA(1, 1), a1 + hstepA, voffA);
            PG8_WAIT_V(8); PG8_WAIT_L(0); PG8_BAR; PG8_MMA(0, 0, At, B0); PG8_MMA(0, 1, At, B1); PG8_BAR; PG8_SCHED;
            PG8_LDA(At, 0, 1); PG8_STAGE(PG8_SB(0, 0), b2, voffB); PG8_STAGE(PG8_SB(0, 1), b2 + hstepB, voffB); PG8_STAGE(PG8_SA(0, 0), a2, voffA);
            PG8_WAIT_V(8); PG8_WAIT_L(0); PG8_BAR; PG8_MMA(1, 0, At, B0); PG8_MMA(1, 1, At, B1); PG8_BAR; PG8_SCHED;
            PG8_LDB(B0, 1, 0); PG8_LDB(B1, 1, 1); PG8_SCHED; PG8_LDA(At, 1, 0); PG8_STAGE(PG8_SA(0, 1), a2 + hstepA, voffA);
            PG8_WAIT_V(8); PG8_WAIT_L(0); PG8_BAR; PG8_MMA(0, 0, At, B0); PG8_MMA(0, 1, At, B1); PG8_BAR; PG8_SCHED;
            PG8_LDA(At, 1, 1); PG8_STAGE(PG8_SB(1, 0), b3, voffB); PG8_STAGE(PG8_SB(1, 1), b3 + hstepB, voffB); PG8_STAGE(PG8_SA(1, 0), a3, voffA);
            PG8_WAIT_V(8); PG8_WAIT_L(0); PG8_BAR; PG8_MMA(1, 0, At, B0); PG8_MMA(1, 1, At, B1); PG8_BAR; PG8_SCHED;
            } else {
            PG8_LDB(B0, 0, 0); PG8_SCHED; PG8_LDA(At, 0, 0); PG8_STAGE(PG8_SA(1, 1), a1 + hstepA, voffA);
            PG8_WAIT_L(8); PG8_BAR; PG8_WAIT_L(0); PG8_MMA(0, 0, At, B0); PG8_BAR; PG8_SCHED;
            PG8_LDB(B1, 0, 1); PG8_STAGE(PG8_SB(0, 0), b2, voffB);
            PG8_BAR; PG8_WAIT_L(0); PG8_MMA(0, 1, At, B1); PG8_BAR;
            PG8_LDA(At, 0, 1); PG8_STAGE(PG8_SA(0, 0), a2, voffA);
            PG8_BAR; PG8_WAIT_L(0); PG8_MMA(1, 0, At, B0); PG8_BAR; PG8_SCHED;
            PG8_STAGE(PG8_SB(0, 1), b2 + hstepB, voffB);
            PG8_WAIT_V(6); PG8_BAR; PG8_MMA(1, 1, At, B1); PG8_BAR;
            PG8_LDB(B0, 1, 0); PG8_SCHED; PG8_LDA(At, 1, 0); PG8_STAGE(PG8_SA(0, 1), a2 + hstepA, voffA);
            PG8_WAIT_L(8); PG8_BAR; PG8_WAIT_L(0); PG8_MMA(0, 0, At, B0); PG8_BAR; PG8_SCHED;
            PG8_LDB(B1, 1, 1); PG8_STAGE(PG8_SB(1, 0), b3, voffB);
            PG8_BAR; PG8_WAIT_L(0); PG8_MMA(0, 1, At, B1); PG8_BAR;
            PG8_LDA(At, 1, 1); PG8_STAGE(PG8_SA(1, 0), a3, voffA);
            PG8_BAR; PG8_WAIT_L(0); PG8_MMA(1, 0, At, B0); PG8_BAR; PG8_SCHED;
            PG8_STAGE(PG8_SB(1, 1), b3 + hstepB, voffB);
            PG8_WAIT_V(6); PG8_BAR; PG8_MMA(1, 1, At, B1); PG8_BAR;
            }
        }
        if constexpr (ALIGN_EPI) { if (wr == 0) PG8_BAR; }
        if constexpr (!Epi::AFTER_DRAIN) { E(acc, cur, wr, wc, fr, fq); S.done(cur); }
        if (!has_next) break;
#pragma unroll
        for (int a = 0; a < 2; ++a)
#pragma unroll
            for (int b = 0; b < 2; ++b)
#pragma unroll
                for (int m = 0; m < 4; ++m)
#pragma unroll
                    for (int n = 0; n < 2; ++n) acc[a][b][m][n] = (f32x4){0.f, 0.f, 0.f, 0.f};
        cur = nxt; cA = nA; cB = nB; ++ui;
        if constexpr (ALIGN_EPI) { if (wr == 1) PG8_BAR; }
    }
    PG8_WAIT_V(0);
    if constexpr (!ALIGN_EPI) { if (wr == 0) PG8_BAR; }
    PG8_BAR;
    if constexpr (Epi::AFTER_DRAIN) { E.fused(acc, cur, wr, wc, fr, fq, lds, wid, lane); S.done(cur); }
#undef PG8_SA
#undef PG8_SB
#undef PG8_STAGE
#undef PG8_LDA
#undef PG8_LDB
#undef PG8_MMA
#undef PG8_WAIT_V
#undef PG8_WAIT_L
#undef PG8_BAR
#undef PG8_SCHED
}
}
#define GAS __attribute__((address_space(1)))
#define LAS __attribute__((address_space(3)))
typedef unsigned short bf16;
typedef unsigned v4u __attribute__((ext_vector_type(4)));
typedef float f32x4 __attribute__((ext_vector_type(4)));
typedef short bf16x8 __attribute__((ext_vector_type(8)));
typedef GAS unsigned gu32;
typedef GAS unsigned long long gu64;
#define RLX_AGENT __ATOMIC_RELAXED, __HIP_MEMORY_SCOPE_AGENT
#define LDS_WAIT() asm volatile("s_waitcnt lgkmcnt(0)" ::: "memory")
#define VM_WAIT() asm volatile("s_waitcnt vmcnt(0)" ::: "memory")
__device__ __forceinline__ unsigned long long rt() { return __builtin_amdgcn_s_memrealtime(); }
__device__ __forceinline__ unsigned f2bf(float f) { unsigned u = __builtin_bit_cast(unsigned, f); return (u + 0x7fffu + ((u >> 16) & 1u)) >> 16; }
__device__ __forceinline__ unsigned pk2(float lo, float hi) { return f2bf(lo) | (f2bf(hi) << 16); }

#define XB_TMO      128
#define XB_XCNT(j)  (256  + 64 * (j))
#define XB_XSUB(j)  (1280 + 64 * (j))
#define XB_XGEN(j)  (2304 + 64 * (j))
#define XB_TOP      3328
#define XB_TOPGEN   3392
#define XCD_BAR_WORDS 3456
#define XB_SPIN_CAP (1u << 18)

__device__ __forceinline__ unsigned xb_ld(unsigned* p)              { return __hip_atomic_load(p, __ATOMIC_RELAXED, __HIP_MEMORY_SCOPE_AGENT); }
__device__ __forceinline__ unsigned xb_add(unsigned* p, unsigned v) { return __hip_atomic_fetch_add(p, v, __ATOMIC_RELAXED, __HIP_MEMORY_SCOPE_AGENT); }
__device__ __forceinline__ unsigned xb_xcc_id() { return (unsigned)__builtin_amdgcn_s_getreg((3 << 11) | 20) & 0xFu; }
#define XB_SPIN(cond, bar) do { unsigned _sp = 0; while (cond) { __builtin_amdgcn_s_sleep(1); \
    if ((++_sp & 255u) == 0u) { if (xb_ld(&(bar)[XB_TMO])) break; if (_sp > XB_SPIN_CAP) { atomicAdd(&(bar)[XB_TMO], 1u); break; } } } } while (0)

struct XcdBarrier {
    unsigned* bar; unsigned x;
    volatile LAS unsigned* st;
};

__device__ __forceinline__ XcdBarrier xcd_barrier_post(unsigned* bar, volatile LAS unsigned* st) {
    XcdBarrier b; b.bar = bar; b.x = xb_xcc_id(); b.st = st;
    if (threadIdx.x == 0) (void)xb_add(&bar[XB_XCNT(b.x)], 1u);
    return b;
}
__device__ __forceinline__ void xcd_barrier_complete(unsigned* bar, unsigned x, unsigned& nloc, unsigned& nx) {
    const unsigned G = gridDim.x * gridDim.y * gridDim.z;
    unsigned sum, cnt, mine, sp = 0u;
    for (;;) {
        sum = 0u; cnt = 0u; mine = 0u;
#pragma unroll
        for (unsigned j = 0; j < 16; ++j) { const unsigned c = xb_ld(&bar[XB_XCNT(j)]); sum += c; cnt += (c > 0u) ? 1u : 0u; mine = (j == x) ? c : mine; }
        if (sum == G) break;
        __builtin_amdgcn_s_sleep(1);
        if ((++sp & 255u) == 0u) { if (xb_ld(&bar[XB_TMO])) break; if (sp > XB_SPIN_CAP) { atomicAdd(&bar[XB_TMO], 1u); break; } }
    }
    nloc = mine > 0u ? mine : 1u; nx = cnt > 0u ? cnt : 1u;
}

__device__ __forceinline__ void xcd_barrier(const XcdBarrier& b) {
    asm volatile("s_waitcnt vmcnt(0)" ::: "memory");
    __syncthreads();
    if (threadIdx.x == 0) {
        unsigned* bar = b.bar;
        __builtin_amdgcn_s_waitcnt(0);
        unsigned nloc = b.st[0], nx = b.st[1];
        if (nloc == 0u) { xcd_barrier_complete(bar, b.x, nloc, nx); b.st[0] = nloc; b.st[1] = nx; }
        const unsigned old = xb_add(&bar[XB_XSUB(b.x)], 1u);
        const unsigned gen = old / nloc;
        if (old + 1u == (gen + 1u) * nloc) {
            __builtin_amdgcn_fence(__ATOMIC_RELEASE, "agent");
            asm volatile("s_waitcnt vmcnt(0)" ::: "memory");
            const unsigned og = xb_add(&bar[XB_TOP], 1u);
            const unsigned tg = og / nx;
            if (og + 1u == (tg + 1u) * nx) xb_add(&bar[XB_TOPGEN], 1u);
            else XB_SPIN(xb_ld(&bar[XB_TOPGEN]) == tg, bar);
            __builtin_amdgcn_fence(__ATOMIC_ACQUIRE, "agent");
            xb_add(&bar[XB_XGEN(b.x)], 1u);
            asm volatile("s_waitcnt vmcnt(0)" ::: "memory");
        } else {
            XB_SPIN(xb_ld(&bar[XB_XGEN(b.x)]) == gen, bar);
            __builtin_amdgcn_fence(__ATOMIC_ACQUIRE, "agent");
            asm volatile("s_waitcnt vmcnt(0)" ::: "memory");
        }
    }
    __syncthreads();
}
constexpr int NWAVES = 8;
constexpr int BATCH = 16, SEQ = 2048, D = 1024, M = BATCH * SEQ;
constexpr int NP = 2816;
constexpr int IN_COLS = 2824;
constexpr int O_AK = 512, O_AV = 640, O_MQ = 768, O_MK = 1280, O_MV = 1792, O_MO = 2304, O_G = 2816;
constexpr int MEMLEN = 256, MMEM = BATCH * MEMLEN;
constexpr int FF = 2816, NU = 2 * FF;
constexpr float EPS = 1e-6f;
constexpr size_t MiB = 1u << 20;
constexpr size_t WS_CTL = 0, CTL_ZERO_BYTES = 1 * MiB;
constexpr size_t WS_RSTD0 = 1 * MiB;
constexpr size_t WS_RSTDM = WS_RSTD0 + 128 * 1024;
constexpr size_t WS_GPRE = 2 * MiB;
constexpr size_t WS_SSQ1 = 4 * MiB, WS_SSQ2 = 6 * MiB, WS_SSQ3 = 8 * MiB;
constexpr size_t WS_WIN = 16 * MiB, WS_WKV = 22 * MiB, WS_WOUT = 26 * MiB, WS_WQ = 28 * MiB, WS_WO = 30 * MiB, WS_WUP = 32 * MiB, WS_WDN = 43 * MiB;
constexpr size_t WS_MEMB = 49 * MiB;
constexpr size_t WS_KVM = 57 * MiB;
constexpr size_t WS_XB = 80 * MiB;
constexpr size_t WS_P = 144 * MiB;
constexpr size_t WS_MIX = 320 * MiB;
constexpr size_t WS_QX = 384 * MiB;
constexpr size_t WS_XO = 448 * MiB;
constexpr size_t WS_ACT = 144 * MiB;
constexpr size_t WS_SB = 320 * MiB;
constexpr size_t WS_END = 512 * MiB;
static_assert(WS_WDN + (size_t)D * FF * 2 <= WS_MEMB && WS_KVM + (size_t)MMEM * 2048 * 2 <= WS_XB && WS_XB + (size_t)M * D * 2 == WS_P && WS_P + (size_t)M * NP * 2 == WS_MIX && WS_ACT + (size_t)M * FF * 2 <= WS_SB && WS_SB + (size_t)(M / 64) * 6 * FF * 4 <= WS_QX, "d_ws map");
constexpr int CW_TMO = 0, CW_CODE = 1;
constexpr int CW_BAR = 4096;
constexpr int N_BAR_REGIONS = 16;
static_assert((CW_BAR + N_BAR_REGIONS * XCD_BAR_WORDS) * 4 <= (int)CTL_ZERO_BYTES, "CTL words inside the memset region");
constexpr int RING_OFF = 0, RING_BYTES = 131072;
constexpr int LDS_BYTES = 163840;
constexpr int LDSCTL_OFF = LDS_BYTES - 512, MISC_OFF = LDSCTL_OFF + 320;
constexpr int PH_LDS = LDSCTL_OFF;

struct Args { const float* in[20]; float* out; unsigned char* ws; int ph_lo, ph_hi, li, pad; };

struct Frame {
    LAS unsigned char* lds; volatile LAS unsigned* MISC; gu32* ctl;
    int tid, lane, wave, vcu, G;
};
__device__ __forceinline__ float wave_sum(float v) {
#pragma unroll
    for (int o = 1; o < 64; o <<= 1) v += __shfl_xor(v, o);
    return v;
}
__device__ __forceinline__ float bf2f(unsigned short b) { return __builtin_bit_cast(float, (unsigned)b << 16); }
__device__ __forceinline__ float bflo(unsigned w) { return __builtin_bit_cast(float, w << 16); }
__device__ __forceinline__ float bfhi(unsigned w) { return __builtin_bit_cast(float, w & 0xffff0000u); }

__device__ __forceinline__ void p0_transpose_item(const float* W, int K, int ldw, int src_col0, const float* g, bf16* WT, int dst_row0, LAS float* scr, int kb, int lane) {
    const int k0 = 64 * kb;
    float wv[32];
#pragma unroll
    for (int i = 0; i < 32; ++i) wv[i] = W[(size_t)(k0 + 2 * i + (lane >> 5)) * ldw + src_col0 + (lane & 31)];
#pragma unroll
    for (int i = 0; i < 32; ++i) { const int kk = 2 * i + (lane >> 5); float w = wv[i]; if (g) w *= g[k0 + kk]; scr[kk * 33 + (lane & 31)] = w; }
    LDS_WAIT(); asm volatile("" ::: "memory");
    const int c = lane & 7;
#pragma unroll
    for (int j = 0; j < 4; ++j) { const int n = (lane >> 3) + 8 * j; const LAS float* s = scr + (8 * c) * 33 + n;
        v4u o; o.x = pk2(s[0 * 33], s[1 * 33]); o.y = pk2(s[2 * 33], s[3 * 33]); o.z = pk2(s[4 * 33], s[5 * 33]); o.w = pk2(s[6 * 33], s[7 * 33]);
        *(GAS v4u*)(WT + (size_t)(dst_row0 + n) * K + k0 + 8 * c) = o; }
    LDS_WAIT(); asm volatile("" ::: "memory");
}
__device__ __forceinline__ void row_load(const float* xrow, int lane, f32x4 (&v)[4]) {
    const GAS f32x4* xr = (const GAS f32x4*)xrow + lane;
#pragma unroll
    for (int j = 0; j < 4; ++j) v[j] = xr[64 * j];
}
__device__ __forceinline__ float row_to_bf16(bf16* orow, int lane, const f32x4 (&v)[4]) {
    float s = 0.f;
#pragma unroll
    for (int j = 0; j < 4; ++j) s += (v[j][0] * v[j][0] + v[j][1] * v[j][1]) + (v[j][2] * v[j][2] + v[j][3] * v[j][3]);
    GAS unsigned long long* o8 = (GAS unsigned long long*)orow + lane;
#pragma unroll
    for (int j = 0; j < 4; ++j) o8[64 * j] = (unsigned long long)pk2(v[j][0], v[j][1]) | ((unsigned long long)pk2(v[j][2], v[j][3]) << 32);
    return wave_sum(s);
}
typedef float f32x16 __attribute__((ext_vector_type(16)));
typedef short s16x4 __attribute__((ext_vector_type(4)));
__device__ __forceinline__ int crow(int r, int hi) { return (r & 3) + 8 * (r >> 2) + 4 * hi; }
__device__ __forceinline__ unsigned cvtpk(float lo, float hi) { typedef float f2 __attribute__((ext_vector_type(2))); typedef __bf16 b2 __attribute__((ext_vector_type(2))); f2 v = {lo, hi}; b2 b = __builtin_convertvector(v, b2); return __builtin_bit_cast(unsigned, b); }
__device__ __forceinline__ s16x4 ldtr(const LAS unsigned char* p) { typedef short v4i16 __attribute__((ext_vector_type(4))); return __builtin_bit_cast(s16x4, __builtin_amdgcn_ds_read_tr16_b64_v4i16((LAS v4i16*)p)); }
__device__ __forceinline__ bf16x8 pack8(const f32x16& p, int b) { v4u w; w.x = cvtpk(p[b], p[b + 1]); w.y = cvtpk(p[b + 2], p[b + 3]); w.z = cvtpk(p[b + 4], p[b + 5]); w.w = cvtpk(p[b + 6], p[b + 7]); return __builtin_bit_cast(bf16x8, w); }
#define GLDS16(gptr, ldsptr) __builtin_amdgcn_global_load_lds((const unsigned*)(gptr), (LAS unsigned*)(ldsptr), 16, 0, 0)

__device__ __forceinline__ void xattn_unit(Frame& F, int b, int xh, int qb, const bf16* QX, const float* ssq1, const bf16* KVM, bf16* XO) {
    const int lane = F.lane, w = F.wave, r32 = lane & 31, hi = lane >> 5;
    const size_t row = (size_t)b * SEQ + qb * 256 + w * 32 + r32;
    const bf16* Kg = KVM + (size_t)b * MEMLEN * 2048 + xh * 256;
    { const bf16* kp = Kg + (size_t)(2 * w + (lane >> 5)) * 2048 + (lane & 31) * 8;
#pragma unroll
      for (int i = 0; i < 16; ++i) GLDS16(kp + (size_t)i * 16 * 2048, F.lds + (w + 8 * i) * 1040); }
    const bf16* qp = QX + row * D + xh * 256 + hi * 8;
    bf16x8 qa[2], qc[2];
#pragma unroll
    for (int j = 0; j < 2; ++j) qa[j] = *(const bf16x8*)(qp + j * 16);
    const pg8::RsParts rs{ssq1};
    const float sc2 = rs.get((int)row) * (0.0625f * 1.4426950408889634f);
    asm volatile("s_waitcnt vmcnt(0)" ::: "memory"); __syncthreads();
    const LAS unsigned char* kbase = F.lds + (r32 >> 1) * 1040 + (r32 & 1) * 512 + hi * 16;
    f32x16 S[8];
#pragma unroll
    for (int kb = 0; kb < 8; ++kb) S[kb] = (f32x16){0.f, 0.f, 0.f, 0.f, 0.f, 0.f, 0.f, 0.f, 0.f, 0.f, 0.f, 0.f, 0.f, 0.f, 0.f, 0.f};
#define XQK(QF, G) do { _Pragma("unroll") for (int j = 0; j < 2; ++j) _Pragma("unroll") for (int kb = 0; kb < 8; ++kb) { \
            const bf16x8 a = *(const LAS bf16x8*)(kbase + kb * 16640 + (2 * (G) + j) * 32); \
            S[kb] = __builtin_amdgcn_mfma_f32_32x32x16_bf16(a, QF[j], S[kb], 0, 0, 0); } } while (0)
#define XQL(QF, G) do { _Pragma("unroll") for (int j = 0; j < 2; ++j) QF[j] = *(const bf16x8*)(qp + (2 * (G) + j) * 16); } while (0)
    XQL(qc, 1); asm volatile("" ::: "memory"); XQK(qa, 0); asm volatile("" ::: "memory");
    XQL(qa, 2); asm volatile("" ::: "memory"); XQK(qc, 1); asm volatile("" ::: "memory");
    XQL(qc, 3); asm volatile("" ::: "memory"); XQK(qa, 2); asm volatile("" ::: "memory");
    XQL(qa, 4); asm volatile("" ::: "memory"); XQK(qc, 3); asm volatile("" ::: "memory");
    XQL(qc, 5); asm volatile("" ::: "memory"); XQK(qa, 4); asm volatile("" ::: "memory");
    XQL(qa, 6); asm volatile("" ::: "memory"); XQK(qc, 5); asm volatile("" ::: "memory");
    XQL(qc, 7); asm volatile("" ::: "memory"); XQK(qa, 6); asm volatile("" ::: "memory");
    XQK(qc, 7);
#undef XQK
#undef XQL
    float mx = S[0][0];
#pragma unroll
    for (int kb = 0; kb < 8; ++kb)
#pragma unroll
        for (int r = 0; r < 16; ++r) mx = fmaxf(mx, S[kb][r]);
    mx = fmaxf(mx, __shfl_xor(mx, 32));
    const float mo = mx * sc2; float l = 0.f;
#pragma unroll
    for (int kb = 0; kb < 8; ++kb)
#pragma unroll
        for (int r = 0; r < 16; ++r) { const float e = __builtin_amdgcn_exp2f(S[kb][r] * sc2 - mo); S[kb][r] = e; l += e; }
    l += __shfl_xor(l, 32);
    const float inv = 1.0f / l;
    bf16x8 pf[8][2];
#pragma unroll
    for (int kb = 0; kb < 8; ++kb) { pf[kb][0] = pack8(S[kb], 0); pf[kb][1] = pack8(S[kb], 8); }
    __syncthreads();
    { const bf16* vp = KVM + (size_t)b * MEMLEN * 2048 + 1024 + xh * 256 + (size_t)(16 * w + (lane >> 2)) * 2048 + 8 * (lane & 3);
#pragma unroll
      for (int i = 0; i < 16; ++i) GLDS16(vp + (size_t)(i & 1) * 128 * 2048 + (i >> 1) * 32, F.lds + (w + 8 * i) * 1024); }
    asm volatile("s_waitcnt vmcnt(0)" ::: "memory"); __syncthreads();
    bf16* orow = XO + row * D + xh * 256 + 4 * hi;
    const int vbase = (4 * hi + ((lane & 15) >> 2)) * 64 + (16 * ((lane >> 4) & 1) + 4 * (lane & 3)) * 2;
#pragma unroll
    for (int db = 0; db < 8; ++db) {
        f32x16 o = (f32x16){0.f, 0.f, 0.f, 0.f, 0.f, 0.f, 0.f, 0.f, 0.f, 0.f, 0.f, 0.f, 0.f, 0.f, 0.f, 0.f};
#pragma unroll
        for (int kb = 0; kb < 8; ++kb)
#pragma unroll
            for (int s = 0; s < 2; ++s) {
                const LAS unsigned char* vp = F.lds + db * 16384 + (32 * kb + 16 * s) * 64 + vbase;
                const s16x4 lo = ldtr(vp), hh = ldtr(vp + 8 * 64);
                const bf16x8 a = (bf16x8){lo[0], lo[1], lo[2], lo[3], hh[0], hh[1], hh[2], hh[3]};
                o = __builtin_amdgcn_mfma_f32_32x32x16_bf16(a, pf[kb][s], o, 0, 0, 0);
            }
#pragma unroll
        for (int g = 0; g < 4; ++g) { typedef unsigned u2 __attribute__((ext_vector_type(2))); u2 wv; wv.x = cvtpk(o[4 * g] * inv, o[4 * g + 1] * inv); wv.y = cvtpk(o[4 * g + 2] * inv, o[4 * g + 3] * inv);
            *(u2*)(orow + 32 * db + 8 * g) = wv; }
    }
    __syncthreads();
}
__device__ __forceinline__ void p5_xattn(Frame& F, const Args& a) {
    const bf16* QX = (const bf16*)(a.ws + WS_QX); const bf16* KVM = (const bf16*)(a.ws + WS_KVM); bf16* XO = (bf16*)(a.ws + WS_XO); const float* ssq1 = (const float*)(a.ws + WS_SSQ1);
    constexpr int NUNIT = BATCH * 4 * (SEQ / 256);
    for (int u = F.vcu; u < NUNIT; u += F.G) { const int qb = u & 7, xh = (u >> 3) & 3, b = u >> 5; xattn_unit(F, b, xh, qb, QX, ssq1, KVM, XO); }
}
__device__ __forceinline__ void swa_unit(Frame& F, int b, int hk, int n, const bf16* P, const float* sinks, bf16* MIX) {
    const int lane = F.lane, w = F.wave, r32 = lane & 31, hi = lane >> 5, wq = w & 3;
    LAS unsigned char* Kl = F.lds; LAS unsigned char* Vl = F.lds + 32768;
    const int np = n > 0 ? n - 1 : 0;
    {
        const int z = (4 * w + (lane >> 4)) & 7;
        const bf16* kp = P + (size_t)(b * SEQ + 8 * w + (lane >> 3)) * NP + O_AK + hk * 64 + (((lane & 7) ^ z) * 8);
#pragma unroll
        for (int i = 0; i < 4; ++i) GLDS16(kp + (size_t)(128 * (i < 2 ? np : n) + 64 * (i & 1)) * NP, Kl + (w + 8 * i) * 1024);
        const bf16* vp = P + (size_t)(b * SEQ + 16 * w + (lane >> 2)) * NP + O_AV + hk * 64 + 8 * (lane & 3);
#pragma unroll
        for (int i = 0; i < 4; ++i) GLDS16(vp + (size_t)(128 * ((i & 1) ? n : np)) * NP + 32 * (i >> 1), Vl + (w + 8 * i) * 1024);
    }
    const size_t row = (size_t)b * SEQ + n * 128 + wq * 32 + r32;
    bf16x8 qf[2][4];
#pragma unroll
    for (int gi = 0; gi < 2; ++gi) { const bf16* qp = P + row * NP + (hk * 4 + 2 * (w >> 2) + gi) * 64 + hi * 8;
#pragma unroll
        for (int ks = 0; ks < 4; ++ks) qf[gi][ks] = *(const bf16x8*)(qp + ks * 16); }
    asm volatile("s_waitcnt vmcnt(0)" ::: "memory"); __syncthreads();
    const int zk = (r32 >> 1) & 7;
    const LAS unsigned char* krow = Kl + (32 * wq + r32) * 128;
    const int vlane = (4 * hi + ((lane & 15) >> 2)) * 64 + (16 * ((lane >> 4) & 1) + 4 * (lane & 3)) * 2;
    const int dl = r32 - 4 * hi;
#pragma unroll
    for (int gi = 0; gi < 2; ++gi) {
        const int h = hk * 4 + 2 * (w >> 2) + gi;
        const float slope2 = exp2f(-(float)(h + 1)) * 1.4426950408889634f, sink2 = sinks[h] * 1.4426950408889634f;
        constexpr float sc = 0.125f * 1.4426950408889634f;
        f32x16 S[5];
#pragma unroll
        for (int jb = 0; jb < 5; ++jb) S[jb] = (f32x16){0.f, 0.f, 0.f, 0.f, 0.f, 0.f, 0.f, 0.f, 0.f, 0.f, 0.f, 0.f, 0.f, 0.f, 0.f, 0.f};
#pragma unroll
        for (int ks = 0; ks < 4; ++ks) { const int co = ((2 * ks + hi) ^ zk) * 16;
#pragma unroll
            for (int jb = 0; jb < 5; ++jb) { const bf16x8 a = *(const LAS bf16x8*)(krow + jb * 4096 + co); S[jb] = __builtin_amdgcn_mfma_f32_32x32x16_bf16(a, qf[gi][ks], S[jb], 0, 0, 0); } }
        int dlo = dl; float bbase = -slope2 * (float)(dl + 128);
        asm volatile("" : "+v"(dlo), "+v"(bbase));
        float mx = sink2;
#pragma unroll
        for (int jb = 0; jb < 5; ++jb) { const bool dead = (n == 0) && (wq + jb < 4);
#pragma unroll
            for (int r = 0; r < 16; ++r) { const int cr = 32 * jb + (r & 3) + 8 * (r >> 2);
                float v = __builtin_fmaf(S[jb][r], sc, __builtin_fmaf(slope2, (float)cr, bbase));
                if (jb == 0) v = (dlo >= cr) ? -1e30f : v;
                if (jb == 4) v = (dlo < cr - 128) ? -1e30f : v;
                v = dead ? -1e30f : v;
                S[jb][r] = v; mx = fmaxf(mx, v); } }
        mx = fmaxf(mx, __shfl_xor(mx, 32));
        float l = 0.f;
#pragma unroll
        for (int jb = 0; jb < 5; ++jb)
#pragma unroll
            for (int r = 0; r < 16; ++r) { const float e = __builtin_amdgcn_exp2f(S[jb][r] - mx); S[jb][r] = e; l += e; }
        l += __shfl_xor(l, 32);
        const float inv = 1.0f / (l + __builtin_amdgcn_exp2f(sink2 - mx));
        bf16x8 pf[5][2];
#pragma unroll
        for (int jb = 0; jb < 5; ++jb) { pf[jb][0] = pack8(S[jb], 0); pf[jb][1] = pack8(S[jb], 8); }
        bf16* orow = MIX + row * D + h * 64 + 4 * hi;
#pragma unroll
        for (int db = 0; db < 2; ++db) {
            f32x16 o = (f32x16){0.f, 0.f, 0.f, 0.f, 0.f, 0.f, 0.f, 0.f, 0.f, 0.f, 0.f, 0.f, 0.f, 0.f, 0.f, 0.f};
#pragma unroll
            for (int jb = 0; jb < 5; ++jb)
#pragma unroll
                for (int s = 0; s < 2; ++s) { const LAS unsigned char* vp = Vl + db * 16384 + (32 * (wq + jb) + 16 * s) * 64 + vlane;
                    const s16x4 lo = ldtr(vp), hh = ldtr(vp + 8 * 64);
                    const bf16x8 a = (bf16x8){lo[0], lo[1], lo[2], lo[3], hh[0], hh[1], hh[2], hh[3]};
                    o = __builtin_amdgcn_mfma_f32_32x32x16_bf16(a, pf[jb][s], o, 0, 0, 0); }
#pragma unroll
            for (int g4 = 0; g4 < 4; ++g4) { typedef unsigned u2 __attribute__((ext_vector_type(2))); u2 wv; wv.x = cvtpk(o[4 * g4] * inv, o[4 * g4 + 1] * inv); wv.y = cvtpk(o[4 * g4 + 2] * inv, o[4 * g4 + 3] * inv);
                *(u2*)(orow + 32 * db + 8 * g4) = wv; }
        }
        __builtin_amdgcn_sched_barrier(0);
    }
    __syncthreads();
}
namespace ml {
constexpr int QS = 0, KS = 16384, KT = 32768, VS0 = 49152, PS = 65536, GS = 73728, WS = 74752, END1 = 79872;
constexpr int Q0 = 0, Q1 = 16384, CT0 = 32768, CT1 = 32768 + 33280, END2 = 32768 + 2 * 33280 + 8192;
static_assert(END1 <= PH_LDS && END2 <= PH_LDS, "mLSTM LDS maps");
constexpr float L2E = 1.4426950408889634f;
constexpr int NCH = SEQ / 64, NCID = BATCH * 4 * NCH;
constexpr size_t WS_KL = WS_XB;
constexpr size_t WS_HL = WS_QX;
constexpr size_t WS_QG = WS_QX + 32 * MiB;
constexpr size_t WS_SM = WS_XO;
constexpr size_t WS_NL = WS_XO + 2 * MiB;
}
__device__ __forceinline__ float fast_silu(float y) { return y * __builtin_amdgcn_rcpf(1.0f + __builtin_amdgcn_exp2f(-1.4426950408889634f * y)); }
__device__ __forceinline__ float fast_sigmoid(float y) { return __builtin_amdgcn_rcpf(1.0f + __builtin_amdgcn_exp2f(-1.4426950408889634f * y)); }

__device__ __forceinline__ void mlstm_local_unit(Frame& F, int cid, const bf16* P, const float* gpre, const float* bg, const float* cw, const float* cb, unsigned char* ws) {
    using namespace ml;
    const int tid = F.tid, lane = F.lane, w = F.wave, r32 = lane & 31, hi = lane >> 5, vb = w & 3, tb = w >> 2;
    const int c = cid & (NCH - 1), bh = cid >> 5, h = bh & 3, b = bh >> 2;
    LAS unsigned char* L = F.lds;
    const int chg = tid & 31, run = tid >> 5, cc = chg & 15, t0 = 4 * run; const bool isk = chg >= 16;
    const int cch = (isk ? 512 : 0) + h * 128 + 8 * cc;
    const size_t row0 = (size_t)b * SEQ + (size_t)c * 64;
    v4u raw[7];
    { const bf16* rawp = P + O_MQ + cch;
#pragma unroll
      for (int k = 0; k < 7; ++k) { const int t = c * 64 + t0 - 3 + k; raw[k] = (t >= 0) ? *(const v4u*)(rawp + (row0 + t0 - 3 + k) * NP) : (v4u){0u, 0u, 0u, 0u}; } }
    const float gi = gpre[(row0 + lane) * 8 + h] + bg[h], gf = gpre[(row0 + lane) * 8 + 4 + h] + bg[4 + h];
    float wt[4][8], bb[8];
#pragma unroll
    for (int j = 0; j < 4; ++j) { const f32x4 a = *(const f32x4*)(cw + j * 1024 + cch), bq = *(const f32x4*)(cw + j * 1024 + cch + 4);
#pragma unroll
        for (int e = 0; e < 4; ++e) { wt[j][e] = a[e]; wt[j][4 + e] = bq[e]; } }
    { const f32x4 a = *(const f32x4*)(cb + cch), bq = *(const f32x4*)(cb + cch + 4);
#pragma unroll
      for (int e = 0; e < 4; ++e) { bb[e] = a[e]; bb[4 + e] = bq[e]; } }
    { const bf16* vsrc = P + (row0 + (lane >> 2)) * NP + O_MV + h * 128 + 8 * (lane & 3);
#pragma unroll
      for (int i = 0; i < 2; ++i) { const int p = w + 8 * i; GLDS16(vsrc + (size_t)(16 * (p & 3)) * NP + 32 * (p >> 2), L + VS0 + p * 1024); } }
    const float lf = fminf(gf, 0.f) - log1pf(__expf(-fabsf(gf)));
    float bs = lf;
#pragma unroll
    for (int o = 1; o < 64; o <<= 1) { const float v = __shfl_up(bs, o); if (lane >= o) bs += v; }
    const float u = gi - bs; float pm = u;
#pragma unroll
    for (int o = 1; o < 64; o <<= 1) { const float v = __shfl_up(pm, o); if (lane >= o) pm = fmaxf(pm, v); }
    const float pm63 = __shfl(pm, 63);
    const float wsl = __expf(u - pm63);
    if (w == 0) { LAS float* g = (LAS float*)(L + GS); g[lane] = u * L2E; g[64 + lane] = pm * L2E;
        float* sm = (float*)(ws + WS_SM) + (size_t)cid * 192; sm[64 + lane] = pm; sm[128 + lane] = bs; }
    {
        float psum[8];
#pragma unroll
        for (int e = 0; e < 8; ++e) psum[e] = 0.f;
        bf16* qg = (bf16*)(ws + WS_QG) + (size_t)cid * 8192;
#pragma unroll
        for (int i = 0; i < 4; ++i) {
            const int t = t0 + i; const float wsr = __shfl(wsl, t);
            float y[8];
#pragma unroll
            for (int e = 0; e < 8; ++e) y[e] = bb[e];
#pragma unroll
            for (int j = 0; j < 4; ++j)
#pragma unroll
                for (int q = 0; q < 4; ++q) { y[2 * q] += wt[j][2 * q] * bflo(raw[i + j][q]); y[2 * q + 1] += wt[j][2 * q + 1] * bfhi(raw[i + j][q]); }
#pragma unroll
            for (int e = 0; e < 8; ++e) y[e] = fast_silu(y[e]);
            const int sw = (cc ^ (t & 15)) * 16;
            if (!isk) { v4u o;
#pragma unroll
                for (int q = 0; q < 4; ++q) o[q] = cvtpk(y[2 * q] * 0.08838834764831845f, y[2 * q + 1] * 0.08838834764831845f);
                *(LAS v4u*)(L + QS + t * 256 + sw) = o; *(v4u*)((unsigned char*)qg + t * 256 + sw) = o;
            } else { v4u o, o2;
#pragma unroll
                for (int q = 0; q < 4; ++q) { o[q] = cvtpk(y[2 * q], y[2 * q + 1]); o2[q] = cvtpk(y[2 * q] * wsr, y[2 * q + 1] * wsr); }
#pragma unroll
                for (int e = 0; e < 8; ++e) psum[e] += y[e] * wsr;
                *(LAS v4u*)(L + KS + t * 256 + sw) = o;
                *(LAS v4u*)(L + KT + (cc >> 2) * 4096 + t * 64 + (cc & 3) * 16) = o2;
            }
        }
        if (isk) { LAS float* ps = (LAS float*)(L + PS) + run * 128 + 8 * cc; *(LAS f32x4*)ps = (f32x4){psum[0], psum[1], psum[2], psum[3]}; *(LAS f32x4*)(ps + 4) = (f32x4){psum[4], psum[5], psum[6], psum[7]}; }
    }
    asm volatile("s_waitcnt vmcnt(0)" ::: "memory"); __syncthreads();
    const int zsw = (r32 & 15);
    const int vlane = (4 * hi + ((lane & 15) >> 2)) * 64 + (16 * ((lane >> 4) & 1) + 4 * (lane & 3)) * 2;
    const LAS float* g = (const LAS float*)(L + GS);
    const int tl = 32 * tb + r32;
    const float pm2 = g[64 + tl];
    bf16x8 qf[8];
#pragma unroll
    for (int ks = 0; ks < 8; ++ks) qf[ks] = *(const LAS bf16x8*)(L + QS + tl * 256 + (((2 * ks + hi) ^ zsw) * 16));
    bf16x8 vf[4];
#pragma unroll
    for (int s4 = 0; s4 < 4; ++s4) { const LAS unsigned char* vp = L + VS0 + vb * 4096 + (16 * s4) * 64 + vlane; const s16x4 lo = ldtr(vp), hh = ldtr(vp + 8 * 64);
        vf[s4] = (bf16x8){lo[0], lo[1], lo[2], lo[3], hh[0], hh[1], hh[2], hh[3]}; }
    f32x16 o = (f32x16){0.f, 0.f, 0.f, 0.f, 0.f, 0.f, 0.f, 0.f, 0.f, 0.f, 0.f, 0.f, 0.f, 0.f, 0.f, 0.f};
    float dsum = 0.f;
#pragma unroll
    for (int sb = 0; sb < 2; ++sb) if (sb <= tb) {
        f32x16 S = (f32x16){0.f, 0.f, 0.f, 0.f, 0.f, 0.f, 0.f, 0.f, 0.f, 0.f, 0.f, 0.f, 0.f, 0.f, 0.f, 0.f};
#pragma unroll
        for (int ks = 0; ks < 8; ++ks) { const bf16x8 a = *(const LAS bf16x8*)(L + KS + (32 * sb + r32) * 256 + (((2 * ks + hi) ^ zsw) * 16)); S = __builtin_amdgcn_mfma_f32_32x32x16_bf16(a, qf[ks], S, 0, 0, 0); }
#pragma unroll
        for (int g4 = 0; g4 < 4; ++g4) { const f32x4 uu = *(const LAS f32x4*)(g + 32 * sb + 8 * g4 + 4 * hi);
#pragma unroll
            for (int e = 0; e < 4; ++e) { const int r = 4 * g4 + e; const int sl = 32 * sb + 8 * g4 + 4 * hi + e;
                const float gm = (sl <= tl) ? __builtin_amdgcn_exp2f(uu[e] - pm2) : 0.f; const float v = S[r] * gm; S[r] = v; dsum += v; } }
        o = __builtin_amdgcn_mfma_f32_32x32x16_bf16(vf[2 * sb], pack8(S, 0), o, 0, 0, 0);
        o = __builtin_amdgcn_mfma_f32_32x32x16_bf16(vf[2 * sb + 1], pack8(S, 8), o, 0, 0, 0);
    }
    dsum += __shfl_xor(dsum, 32);
    if (vb == 0 && hi == 0) ((float*)(ws + WS_SM) + (size_t)cid * 192)[tl] = dsum;
    { v4u* hp = (v4u*)((bf16*)(ws + WS_HL) + ((size_t)(cid * 8 + w) * 64 + lane) * 16);
      v4u a; a.x = cvtpk(o[0], o[1]); a.y = cvtpk(o[2], o[3]); a.z = cvtpk(o[4], o[5]); a.w = cvtpk(o[6], o[7]); hp[0] = a;
      a.x = cvtpk(o[8], o[9]); a.y = cvtpk(o[10], o[11]); a.z = cvtpk(o[12], o[13]); a.w = cvtpk(o[14], o[15]); hp[1] = a; }
#pragma unroll
    for (int i = 0; i < 2; ++i) {
        f32x16 kacc = (f32x16){0.f, 0.f, 0.f, 0.f, 0.f, 0.f, 0.f, 0.f, 0.f, 0.f, 0.f, 0.f, 0.f, 0.f, 0.f, 0.f};
#pragma unroll
        for (int s4 = 0; s4 < 4; ++s4) { const LAS unsigned char* kp = L + KT + (2 * tb + i) * 4096 + (16 * s4) * 64 + vlane; const s16x4 lo = ldtr(kp), hh = ldtr(kp + 8 * 64);
            const bf16x8 a = (bf16x8){lo[0], lo[1], lo[2], lo[3], hh[0], hh[1], hh[2], hh[3]};
            kacc = __builtin_amdgcn_mfma_f32_32x32x16_bf16(a, vf[s4], kacc, 0, 0, 0); }
        v4u* kp2 = (v4u*)((bf16*)(ws + WS_KL) + (((size_t)(cid * 8 + w) * 2 + i) * 64 + lane) * 16);
        v4u a; a.x = cvtpk(kacc[0], kacc[1]); a.y = cvtpk(kacc[2], kacc[3]); a.z = cvtpk(kacc[4], kacc[5]); a.w = cvtpk(kacc[6], kacc[7]); kp2[0] = a;
        a.x = cvtpk(kacc[8], kacc[9]); a.y = cvtpk(kacc[10], kacc[11]); a.z = cvtpk(kacc[12], kacc[13]); a.w = cvtpk(kacc[14], kacc[15]); kp2[1] = a;
    }
    if (tid < 128) { float s = 0.f; const LAS float* ps = (const LAS float*)(L + PS) + tid;
#pragma unroll
        for (int q = 0; q < 16; ++q) s += ps[q * 128];
        ((float*)(ws + WS_NL))[(size_t)cid * 128 + tid] = s; }
    __syncthreads();
}

__device__ __forceinline__ void mlstm_scan4(Frame& F, int b, int h, int vb, const bf16* P, bf16* MIX, unsigned char* ws, int abl) {
    using namespace ml;
    typedef unsigned u2 __attribute__((ext_vector_type(2)));
    typedef float f4 __attribute__((ext_vector_type(4)));
    constexpr int SQ0 = 0, SQ1 = 16384, SC0 = 32768, SC1 = 32768 + 12288, SF = 32768 + 2 * 12288;
    const int tid = F.tid, lane = F.lane, w = F.wave, li = lane & 15, lq = lane >> 4, tq = w & 3, dvh = w >> 2;
    LAS unsigned char* L = F.lds;
    const int cid0 = (b * 4 + h) * NCH;
    for (int i = tid; i < (2 * 12288) / 16; i += NWAVES * 64) *(LAS v4u*)(L + SC0 + 16 * i) = (v4u){0u, 0u, 0u, 0u};
    const int dkb = tid >> 7, l1 = (tid >> 1) & 63, hf = tid & 1, dvl = l1 & 31;
    const size_t kl_off = (((size_t)(vb + 4 * (dkb >> 1)) * 2 + (dkb & 1)) * 64 + l1) * 32 + hf * 16;
    const int cwr = dvl * 256 + 8 * (l1 >> 5), cA = 4 * dkb + 2 * hf;
    float Cst[8];
#pragma unroll
    for (int e = 0; e < 8; ++e) Cst[e] = 0.f;
    float nreg = 0.f;
    const size_t rowb = (size_t)b * SEQ;
    const int tl = 16 * tq + li;
    const size_t hl_off = ((size_t)(vb + 4 * (tq >> 1)) * 64 + (16 * (tq & 1) + li) + 32 * (lq & 1)) * 32 + (2 * dvh + (lq >> 1)) * 8;
    const int dcol = h * 128 + 32 * vb + 16 * dvh + 4 * lq;
    struct Pre { u2 hl; v4u kl; u2 mo; float nl; v4u q0, q1; };
#define ML_LOAD(X, cc_) do { const int cid_ = cid0 + (cc_); \
        X.hl = *(const u2*)(ws + WS_HL + (size_t)cid_ * (8 * 64 * 32) + hl_off); \
        X.kl = *(const v4u*)(ws + WS_KL + (size_t)cid_ * (8 * 2 * 64 * 32) + kl_off); \
        X.mo = *(const u2*)(P + (rowb + (size_t)(cc_) * 64 + tl) * NP + O_MO + dcol); \
        X.nl = ((const float*)(ws + WS_NL))[(size_t)cid_ * 128 + (tid & 127)]; \
        const v4u* qg_ = (const v4u*)(ws + WS_QG + (size_t)cid_ * 16384); X.q0 = qg_[tid]; X.q1 = qg_[512 + tid]; } while (0)
    {
        const float* smb = (const float*)(ws + WS_SM) + (size_t)cid0 * 192;
        const float pm63v = smb[(size_t)(lane & 31) * 192 + 64 + 63], b63v = smb[(size_t)(lane & 31) * 192 + 128 + 63];
        float dlv[4], pmv[4], bsv[4];
#pragma unroll
        for (int j = 0; j < 4; ++j) { const float* sm_ = smb + (size_t)(4 * w + j) * 192; dlv[j] = sm_[lane]; pmv[j] = sm_[64 + lane]; bsv[j] = sm_[128 + lane]; }
        float mp = 0.f, mpw[4] = {0.f, 0.f, 0.f, 0.f};
#pragma unroll
        for (int c = 0; c < NCH; ++c) { const float pmc = __builtin_bit_cast(float, __builtin_amdgcn_readlane(__builtin_bit_cast(int, pm63v), c)), bc = __builtin_bit_cast(float, __builtin_amdgcn_readlane(__builtin_bit_cast(int, b63v), c));
            if ((c >> 2) == w) mpw[c & 3] = mp;
            mp = bc + fmaxf(mp, pmc); }
        LAS float* sf = (LAS float*)(L + SF);
#pragma unroll
        for (int j = 0; j < 4; ++j) { const int c = 4 * w + j; const float Mt = fmaxf(mpw[j], pmv[j]);
            sf[c * 256 + lane] = __expf(mpw[j] - Mt); sf[c * 256 + 64 + lane] = __expf(pmv[j] - Mt); sf[c * 256 + 128 + lane] = __expf(-(bsv[j] + Mt)); sf[c * 256 + 192 + lane] = dlv[j];
            if (lane == 63) { sf[NCH * 256 + 2 * c] = __expf(mpw[j] - Mt); sf[NCH * 256 + 2 * c + 1] = __expf(pmv[j] - Mt); } }
    }
    Pre s0, s1, s2, s3;
    ML_LOAD(s0, 0);
    *(LAS v4u*)(L + SQ0 + 16 * tid) = s0.q0; *(LAS v4u*)(L + SQ0 + 8192 + 16 * tid) = s0.q1;
    ML_LOAD(s1, 1); ML_LOAD(s2, 2);
#define ML_STEP(CC, CUR, NXT, LD) do { const int c = (CC), par = c & 1; \
        __syncthreads();     \
        ML_LOAD(LD, (c + 3 < NCH ? c + 3 : NCH - 1));     \
        { LAS unsigned char* qn_ = L + (par ? SQ0 : SQ1); *(LAS v4u*)(qn_ + 16 * tid) = NXT.q0; *(LAS v4u*)(qn_ + 8192 + 16 * tid) = NXT.q1; } \
        { \
        const LAS float* sf = (const LAS float*)(L + SF) + c * 256 + tl; \
        const float wi = sf[0], ft = sf[64], ef = sf[128], dlt = sf[192]; \
        const float decay = ((const LAS float*)(L + SF))[NCH * 256 + 2 * c], f2 = ((const LAS float*)(L + SF))[NCH * 256 + 2 * c + 1]; \
        const LAS unsigned char* Ql = L + (par ? SQ1 : SQ0); \
        const LAS unsigned char* Cr = L + (par ? SC1 : SC0); LAS unsigned char* Cw = L + (par ? SC0 : SC1); \
        f4 o = (f4){0.f, 0.f, 0.f, 0.f}, on = (f4){0.f, 0.f, 0.f, 0.f}; \
        _Pragma("unroll") for (int ks = 0; ks < 4; ++ks) { \
            const bf16x8 qf = *(const LAS bf16x8*)(Ql + tl * 256 + (((4 * ks + lq) ^ li) * 16)); \
            const bf16x8 a = *(const LAS bf16x8*)(Cr + (16 * dvh + li) * 256 + (((4 * ks + lq) ^ li) * 16)); \
            const bf16x8 an = *(const LAS bf16x8*)(Cr + 32 * 256 + (4 * ks + lq) * 16);     \
            o = __builtin_amdgcn_mfma_f32_16x16x32_bf16(a, qf, o, 0, 0, 0); \
            on = __builtin_amdgcn_mfma_f32_16x16x32_bf16(an, qf, on, 0, 0, 0); } \
        const float rden = __builtin_amdgcn_rcpf(fmaxf(fabsf(wi * on[0] + ft * dlt), ef)); \
        { const float hv[4] = {bflo(CUR.hl.x), bfhi(CUR.hl.x), bflo(CUR.hl.y), bfhi(CUR.hl.y)}, og[4] = {bflo(CUR.mo.x), bfhi(CUR.mo.x), bflo(CUR.mo.y), bfhi(CUR.mo.y)}; \
          float x[4]; \
          _Pragma("unroll") for (int e = 0; e < 4; ++e) x[e] = (wi * o[e] + ft * hv[e]) * rden * fast_sigmoid(og[e]); \
          u2 wv; wv.x = cvtpk(x[0], x[1]); wv.y = cvtpk(x[2], x[3]); \
          *(u2*)(MIX + (rowb + (size_t)c * 64 + tl) * D + 512 + dcol) = wv; } \
        { const v4u kl = CUR.kl; u2 wa, wb; \
          _Pragma("unroll") for (int e = 0; e < 8; ++e) { const unsigned kw = kl[e >> 1]; Cst[e] = decay * Cst[e] + f2 * ((e & 1) ? bfhi(kw) : bflo(kw)); } \
          wa.x = cvtpk(Cst[0], Cst[1]); wa.y = cvtpk(Cst[2], Cst[3]); wb.x = cvtpk(Cst[4], Cst[5]); wb.y = cvtpk(Cst[6], Cst[7]); \
          *(LAS u2*)(Cw + cwr + ((cA ^ (dvl & 15)) * 16)) = wa; *(LAS u2*)(Cw + cwr + (((cA + 1) ^ (dvl & 15)) * 16)) = wb; } \
        if (tid < 128) { nreg = decay * nreg + f2 * CUR.nl; *(LAS unsigned short*)(Cw + 32 * 256 + tid * 2) = (unsigned short)f2bf(nreg); } \
        } } while (0)
    _Pragma("unroll") for (int c4 = 0; c4 < NCH; c4 += 4) { ML_STEP(c4, s0, s1, s3); ML_STEP(c4 + 1, s1, s2, s0); ML_STEP(c4 + 2, s2, s3, s1); ML_STEP(c4 + 3, s3, s0, s2); }
#undef ML_STEP
    __syncthreads();
#undef ML_LOAD
}
__device__ __forceinline__ void p2a_mix(Frame& F, const Args& a) {
    const bf16* P = (const bf16*)(a.ws + WS_P); bf16* MIX = (bf16*)(a.ws + WS_MIX);
    for (int u = F.vcu; u < ml::NCID; u += F.G) mlstm_local_unit(F, u, P, (const float*)(a.ws + WS_GPRE), a.in[4], a.in[5], a.in[6], a.ws);
    for (int u = F.vcu; u < BATCH * 2 * 16; u += F.G) swa_unit(F, u >> 5, (u >> 4) & 1, u & 15, P, a.in[7], MIX);
}
__device__ __forceinline__ void p2b_mix(Frame& F, const Args& a) {
    const bf16* P = (const bf16*)(a.ws + WS_P); bf16* MIX = (bf16*)(a.ws + WS_MIX);
    for (int u = (int)blockIdx.x; u < BATCH * 16; u += F.G) mlstm_scan4(F, u >> 4, (u >> 2) & 3, u & 3, P, MIX, a.ws, a.pad);
}
__device__ __forceinline__ void p0_prologue(Frame& F, const Args& a) {
    unsigned char* ws = a.ws;
    LAS float* scr = (LAS float*)(F.lds + F.wave * 8448);
    LAS float* wgT = (LAS float*)(F.lds + 73728);
    const int gw = F.vcu * NWAVES + F.wave, NGW = F.G * NWAVES;
    {
        const float* w_in = a.in[3]; const float* gm = a.in[2];
        for (int i = F.tid; i < 8192; i += NWAVES * 64) { const int k = i >> 3, c = i & 7; wgT[c * 1024 + k] = gm[k] * w_in[(size_t)k * IN_COLS + O_G + c]; }
    }
    constexpr int I_IN = 16 * (NP / 32), I_KV = 16 * 64, I_SQ = 16 * 32, I_UP = 16 * (NU / 32), I_DN = (FF / 64) * 32;
    constexpr int NITEMS = I_IN + I_KV + 3 * I_SQ + I_UP + I_DN;
    for (int it = gw; it < NITEMS; it += NGW) {
        int r = it;
        if (r < I_IN) { const int nb = r % (NP / 32), kb = r / (NP / 32); p0_transpose_item(a.in[3], D, IN_COLS, 32 * nb, a.in[2], (bf16*)(ws + WS_WIN), 32 * nb, scr, kb, F.lane); continue; } r -= I_IN;
        if (r < I_KV) { const int nb = r % 64, kb = r / 64; p0_transpose_item(a.in[12], D, 2048, 32 * nb, a.in[10], (bf16*)(ws + WS_WKV), 32 * nb, scr, kb, F.lane); continue; } r -= I_KV;
        if (r < I_SQ) { const int nb = r % 32, kb = r / 32; p0_transpose_item(a.in[8], D, D, 32 * nb, nullptr, (bf16*)(ws + WS_WOUT), 32 * nb, scr, kb, F.lane); continue; } r -= I_SQ;
        if (r < I_SQ) { const int nb = r % 32, kb = r / 32; p0_transpose_item(a.in[11], D, D, 32 * nb, a.in[9], (bf16*)(ws + WS_WQ), 32 * nb, scr, kb, F.lane); continue; } r -= I_SQ;
        if (r < I_SQ) { const int nb = r % 32, kb = r / 32; p0_transpose_item(a.in[13], D, D, 32 * nb, nullptr, (bf16*)(ws + WS_WO), 32 * nb, scr, kb, F.lane); continue; } r -= I_SQ;
        if (r < I_UP) { const int nb = r % (NU / 32), kb = r / (NU / 32); const int c0 = 32 * nb < FF ? 32 * nb : 32 * nb - FF, dr = (c0 >> 7) * 256 + (32 * nb < FF ? 0 : 128) + (c0 & 127);
            p0_transpose_item(a.in[15], D, NU, 32 * nb, a.in[14], (bf16*)(ws + WS_WUP), dr, scr, kb, F.lane); continue; } r -= I_UP;
        { const int nb = r % 32, kb = r / 32; p0_transpose_item(a.in[18], FF, D, 32 * nb, nullptr, (bf16*)(ws + WS_WDN), 32 * nb, scr, kb, F.lane); }
    }
    __syncthreads();
    float* rstd0 = (float*)(ws + WS_RSTD0); float* gpre = (float*)(ws + WS_GPRE); bf16* XB = (bf16*)(ws + WS_XB);
    for (int m = gw; m < M; m += 2 * NGW) {
        f32x4 va[4], vc[4];
        row_load(a.in[0] + (size_t)m * D, F.lane, va); row_load(a.in[0] + (size_t)(m + NGW) * D, F.lane, vc);
#pragma unroll
        for (int hlf = 0; hlf < 2; ++hlf) {
            const int mm = m + hlf * NGW; const f32x4 (&v)[4] = hlf ? vc : va;
            const float ssq = row_to_bf16(XB + (size_t)mm * D, F.lane, v);
            const float rstd = 1.0f / sqrtf(ssq * (1.0f / D) + EPS);
            float ga[8];
#pragma unroll
            for (int c = 0; c < 8; ++c) { float s = 0.f;
#pragma unroll
                for (int j = 0; j < 4; ++j) { const f32x4 w = *(const LAS f32x4*)(wgT + c * 1024 + 256 * j + 4 * F.lane); s += (v[j][0] * w[0] + v[j][1] * w[1]) + (v[j][2] * w[2] + v[j][3] * w[3]); }
                ga[c] = wave_sum(s) * rstd; }
            if (F.lane == 0) { rstd0[mm] = rstd; *(f32x4*)(gpre + (size_t)mm * 8) = (f32x4){ga[0], ga[1], ga[2], ga[3]}; *(f32x4*)(gpre + (size_t)mm * 8 + 4) = (f32x4){ga[4], ga[5], ga[6], ga[7]}; }
        }
    }
    float* rstdm = (float*)(ws + WS_RSTDM); bf16* MEMB = (bf16*)(ws + WS_MEMB);
    for (int m = gw; m < MMEM; m += NGW) {
        f32x4 v[4];
        row_load(a.in[1] + (size_t)m * D, F.lane, v);
        const float ssq = row_to_bf16(MEMB + (size_t)m * D, F.lane, v);
        if (F.lane == 0) rstdm[m] = 1.0f / sqrtf(ssq * (1.0f / D) + EPS);
    }
}
__device__ __forceinline__ void act_fixup_panel(Frame& F, const Args& a, int pm) {
    bf16* ACT = (bf16*)(a.ws + WS_ACT); const float* SB = (const float*)(a.ws + WS_SB); const float* cw = a.in[16]; const float* cb = a.in[17];
    for (int it = F.tid; it < 4 * (FF / 4); it += NWAVES * 64) {
        const int gl = it / (FF / 4), ch = 4 * (it % (FF / 4)), gid = 4 * pm + gl;
        const float* s = SB + (size_t)gid * 6 * FF + ch;
        const f32x4 w0 = *(const f32x4*)(cw + ch), w1 = *(const f32x4*)(cw + FF + ch), w2 = *(const f32x4*)(cw + 2 * FF + ch), bb = *(const f32x4*)(cb + ch);
        f32x4 gm2 = (f32x4){0.f, 0.f, 0.f, 0.f}, gm1 = gm2;
        if ((gid & 31) != 0) { gm2 = *(const f32x4*)(s - 6 * FF); gm1 = *(const f32x4*)(s - 5 * FF); }
        const f32x4 g0 = *(const f32x4*)(s + 2 * FF), g1 = *(const f32x4*)(s + 3 * FF), v0 = *(const f32x4*)(s + 4 * FF), v1 = *(const f32x4*)(s + 5 * FF);
        float r0[4], r1[4];
#pragma unroll
        for (int e = 0; e < 4; ++e) { const float y0 = w2[e] * g0[e] + w1[e] * gm1[e] + w0[e] * gm2[e] + bb[e], y1 = w2[e] * g1[e] + w1[e] * g0[e] + w0[e] * gm1[e] + bb[e];
            r0[e] = y0 * __builtin_amdgcn_rcpf(1.0f + __builtin_amdgcn_exp2f(-1.4426950408889634f * y0)) * v0[e]; r1[e] = y1 * __builtin_amdgcn_rcpf(1.0f + __builtin_amdgcn_exp2f(-1.4426950408889634f * y1)) * v1[e]; }
        typedef unsigned u2 __attribute__((ext_vector_type(2)));
        u2 o0, o1; o0.x = pk2(r0[0], r0[1]); o0.y = pk2(r0[2], r0[3]); o1.x = pk2(r1[0], r1[1]); o1.y = pk2(r1[2], r1[3]);
        *(u2*)(ACT + (size_t)(64 * gid) * FF + ch) = o0; *(u2*)(ACT + (size_t)(64 * gid + 1) * FF + ch) = o1;
    }
}
__device__ __forceinline__ void p10_final(Frame& F, const Args& a) {
    const int gw = F.vcu * NWAVES + F.wave, NGW = F.G * NWAVES;
    const float* gf = a.in[19]; const pg8::RsParts rs{(const float*)(a.ws + WS_SSQ3)};
    f32x4 gv[4];
#pragma unroll
    for (int j = 0; j < 4; ++j) gv[j] = ((const f32x4*)gf)[64 * j + F.lane];
    for (int m = gw; m < M; m += NGW) {
        const float r = rs.get(m);
        GAS f32x4* xr = (GAS f32x4*)(a.out + (size_t)m * D) + F.lane;
#pragma unroll
        for (int j = 0; j < 4; ++j) { const f32x4 v = xr[64 * j]; xr[64 * j] = v * r * gv[j]; }
    }
}

#ifndef PROBE_REP
#define PROBE_REP (-1)
#endif
#ifndef PROBE_SUB
#define PROBE_SUB 0
#endif
#ifndef PG8_SP2
#define PG8_SP2 true
#endif
#ifndef PG8_ALIGN
#define PG8_ALIGN true
#endif
enum { PH_PRO = 0, PH_G1 = 1, PH_MIXA = 2, PH_MIXB = 3, PH_G2 = 4, PH_G3 = 5, PH_XAT = 6, PH_G4 = 7, PH_G5 = 8, PH_G6 = 9, PH_FIN = 10, PH_N = 11 };

__device__ __forceinline__ bool phase_in(Frame& F, int lo, int hi, int k) {
    if (!(lo <= k && k < hi)) return false;
    int t_ = threadIdx.x; asm volatile("" : "+v"(t_)); F.tid = t_; F.lane = t_ & 63; return true;
}
__global__ void __launch_bounds__(NWAVES * 64, 2) mk_fwd(Args args) {
    extern __shared__ __attribute__((aligned(16))) unsigned char lds[];
    Frame F;
    F.lds = (LAS unsigned char*)lds;
    F.MISC = (volatile LAS unsigned*)(F.lds + MISC_OFF);
    F.tid = threadIdx.x; F.lane = F.tid & 63; F.wave = __builtin_amdgcn_readfirstlane(F.tid >> 6);
    F.G = gridDim.x; { const int bx = blockIdx.x; F.vcu = (F.G % 8 == 0) ? (bx % 8) * (F.G / 8) + bx / 8 : bx; }
    unsigned char* ws = args.ws;
    F.ctl = (gu32*)(ws + WS_CTL);
    for (int u = F.tid; u < (LDS_BYTES - LDSCTL_OFF) / 4; u += NWAVES * 64) ((LAS unsigned*)(F.lds + LDSCTL_OFF))[u] = 0u;
    __syncthreads();
    const int lo = args.ph_lo, hi = args.ph_hi;
    XcdBarrier bar = xcd_barrier_post((unsigned*)(F.ctl + CW_BAR) + args.li * XCD_BAR_WORDS, F.MISC + 8);
#define IN(k) (phase_in(F, lo, hi, (k)))
#define SEAM(k) do { if (lo <= (k) && (k) + 1 < hi) xcd_barrier(bar); } while (0)
    bf16* XB = (bf16*)(ws + WS_XB); bf16* P = (bf16*)(ws + WS_P); bf16* MIX = (bf16*)(ws + WS_MIX); bf16* QX = (bf16*)(ws + WS_QX); bf16* XO = (bf16*)(ws + WS_XO);
    const int G = F.G, bx = (int)blockIdx.x;

    if (IN(PH_PRO)) { p0_prologue(F, args); SEAM(PH_PRO); }
    if (IN(PH_G1)) {
        { pg8::Gemm g{XB, D, (const bf16*)(ws + WS_WIN), M, NP, D}; pg8::StaticOrder S; S.init(M, NP, G, bx);
          pg8::EpiScaleBf16<pg8::RsArr> E{P, NP, {(const float*)(ws + WS_RSTD0)}};
          pg8::gemm_phase<pg8::EpiScaleBf16<pg8::RsArr>, pg8::StaticOrder, PG8_ALIGN, PG8_SP2>(F.lds + RING_OFF, g, S, E); }
        { pg8::Gemm g{(const bf16*)(ws + WS_MEMB), D, (const bf16*)(ws + WS_WKV), MMEM, 2048, D}; pg8::StaticOrder S; S.init(MMEM, 2048, G, (bx + G / 2) % G);
          pg8::EpiScaleBf16<pg8::RsArr> E{(bf16*)(ws + WS_KVM), 2048, {(const float*)(ws + WS_RSTDM)}};
          pg8::gemm_phase<pg8::EpiScaleBf16<pg8::RsArr>, pg8::StaticOrder, PG8_ALIGN, PG8_SP2>(F.lds + RING_OFF, g, S, E); }
        SEAM(PH_G1);
    }
    if (IN(PH_MIXA)) { p2a_mix(F, args); SEAM(PH_MIXA); }
    if (IN(PH_MIXB)) { p2b_mix(F, args); SEAM(PH_MIXB); }
    if (IN(PH_G2)) {
        pg8::Gemm g{MIX, D, (const bf16*)(ws + WS_WOUT), M, D, D}; pg8::StaticOrder S; S.init(M, D, G, bx);
        pg8::EpiResid<1> E{XB, args.in[0], nullptr, (float*)(ws + WS_SSQ1), D};
        pg8::gemm_phase<pg8::EpiResid<1>, pg8::StaticOrder, PG8_ALIGN, PG8_SP2>(F.lds + RING_OFF, g, S, E);
        SEAM(PH_G2);
    }
    if (IN(PH_G3)) {
        pg8::Gemm g{XB, D, (const bf16*)(ws + WS_WQ), M, D, D}; pg8::StaticOrder S; S.init(M, D, G, bx);
        pg8::EpiScaleBf16<pg8::RsOne> E{QX, D, {}};
        pg8::gemm_phase<pg8::EpiScaleBf16<pg8::RsOne>, pg8::StaticOrder, PG8_ALIGN, PG8_SP2>(F.lds + RING_OFF, g, S, E);
        SEAM(PH_G3);
    }
    if (IN(PH_XAT)) { p5_xattn(F, args); SEAM(PH_XAT); }
    if (IN(PH_G4)) {
        pg8::Gemm g{XO, D, (const bf16*)(ws + WS_WO), M, D, D}; pg8::StaticOrder S; S.init(M, D, G, bx);
        pg8::EpiResid<0> E{XB, nullptr, nullptr, (float*)(ws + WS_SSQ2), D};
        pg8::gemm_phase<pg8::EpiResid<0>, pg8::StaticOrder, PG8_ALIGN, PG8_SP2>(F.lds + RING_OFF, g, S, E);
        SEAM(PH_G4);
    }
    if (IN(PH_G5)) {
        pg8::Gemm g{XB, D, (const bf16*)(ws + WS_WUP), M, NU, D}; pg8::StaticOrder S; S.init(M, NU, G, bx);
        pg8::EpiGateConv E{(bf16*)(ws + WS_ACT), {(const float*)(ws + WS_SSQ2)}, args.in[16], args.in[17], (float*)(ws + WS_SB)};
        pg8::gemm_phase<pg8::EpiGateConv, pg8::StaticOrder, PG8_ALIGN, PG8_SP2>(F.lds + RING_OFF, g, S, E);
        SEAM(PH_G5);
    }
    if (IN(PH_G6)) {
        pg8::Gemm g{(const bf16*)(ws + WS_ACT), FF, (const bf16*)(ws + WS_WDN), M, D, FF}; pg8::StaticOrder S; S.init(M, D, G, bx);
        { pg8::Unit uu; int last = -1; for (int i = 0; S.next(i, uu); ++i) if (uu.pm != last) { act_fixup_panel(F, args, uu.pm); last = uu.pm; }
          asm volatile("s_waitcnt vmcnt(0)" ::: "memory"); __syncthreads(); if (F.tid == 0) { __builtin_amdgcn_fence(__ATOMIC_ACQUIRE, "agent"); asm volatile("s_waitcnt vmcnt(0)" ::: "memory"); } __syncthreads(); }
        pg8::EpiResid<2> E{XB, nullptr, args.out, (float*)(ws + WS_SSQ3), D};
        pg8::gemm_phase<pg8::EpiResid<2>, pg8::StaticOrder, PG8_ALIGN, PG8_SP2>(F.lds + RING_OFF, g, S, E);
        SEAM(PH_G6);
    }
    if (IN(PH_FIN)) { p10_final(F, args); }
#undef IN
#undef SEAM
}
extern "C" void kernel_launch(void* const* d_in, const int* in_sizes, int n_in, void* d_out, int out_size, void* d_ws, size_t ws_size, hipStream_t stream) {
    static int grid = 0;
    if (grid == 0) {
        if (n_in != 20 || in_sizes[0] != M * D || out_size != M * D || ws_size < WS_END) { fprintf(stderr, "kernel_launch: shape/workspace mismatch: n_in %d in0 %d out %d ws %zu (need %zu)\n", n_in, n_in > 0 ? in_sizes[0] : -1, out_size, ws_size, (size_t)WS_END); grid = -1; return; }
        int dev = 0, cus = 0, per_cu = 0;
        if (hipGetDevice(&dev) != hipSuccess || hipDeviceGetAttribute(&cus, hipDeviceAttributeMultiprocessorCount, dev) != hipSuccess) { fprintf(stderr, "kernel_launch: device query failed\n"); grid = -1; return; }
        if (hipFuncSetAttribute((const void*)mk_fwd, hipFuncAttributeMaxDynamicSharedMemorySize, LDS_BYTES) != hipSuccess) { fprintf(stderr, "kernel_launch: hipFuncSetAttribute failed\n"); grid = -1; return; }
        if (hipOccupancyMaxActiveBlocksPerMultiprocessor(&per_cu, (const void*)mk_fwd, NWAVES * 64, LDS_BYTES) != hipSuccess || per_cu < 1) { fprintf(stderr, "kernel_launch: occupancy query reports %d workgroups per CU\n", per_cu); (void)hipGetLastError(); grid = -1; return; }
        grid = cus;
    }
    if (grid < 0) return;
    (void)hipMemsetAsync((char*)d_ws + WS_CTL, 0, CTL_ZERO_BYTES, stream);
    Args a{};
    for (int i = 0; i < 20; ++i) a.in[i] = (const float*)d_in[i];
    a.out = (float*)d_out; a.ws = (unsigned char*)d_ws;
    unsigned char* ws = (unsigned char*)d_ws;
    auto launch = [&](int lo, int hi, int li) { a.ph_lo = lo; a.ph_hi = hi; a.li = li; hipLaunchKernelGGL(mk_fwd, dim3(grid), dim3(NWAVES * 64), LDS_BYTES, stream, a); };
#if PROBE_REP >= 0
    a.pad = PROBE_SUB; launch(PH_PRO, PROBE_REP + 1, 0); a.pad = 0; launch(PROBE_REP, PH_N, 1);
#else
    launch(PH_PRO, PH_N, 0);
#endif
}
```
